# Optimizing an MI355X kernel written in HIP

```python
import jax, jax.numpy as jnp
from jax import lax
import numpy as np

D_MODEL = 2048
BATCH = 4
SEQ = 8192
DEPTH = 4

HEAD_DIM = 128
D_MIX = D_MODEL
D_FF = 256 * ((8 * D_MODEL // 3 + 255) // 256)
EPS = 1e-6

SG_WIDTH = D_MIX // 4
SG_GROUPS = SG_WIDTH // HEAD_DIM
SG_CHUNK = 128

ATT_WIDTH = 3 * D_MIX // 8
ATT_HEADS = ATT_WIDTH // HEAD_DIM
DILATED_PAIRS = ((128, 1), (512, 4), (2048, 16))
ROPE_THETA = 500000.0
ROPE_DIMS = HEAD_DIM // 4

GLA_WIDTH = D_MIX - SG_WIDTH - ATT_WIDTH
GLA_HEADS = GLA_WIDTH // HEAD_DIM
GLA_DV = HEAD_DIM
GLA_DK = GLA_DV // 2
GLA_CHUNK = 64
GLA_GATE_RANK = 16
GLA_GATE_NORMALIZER = 16.0

SPLIT_SIZES = (SG_WIDTH, SG_WIDTH,
               ATT_WIDTH, ATT_WIDTH, ATT_WIDTH,
               GLA_HEADS * GLA_DK, GLA_HEADS * GLA_DK,
               GLA_WIDTH, GLA_WIDTH,
               GLA_GATE_RANK)
N_IN = sum(SPLIT_SIZES)

kernel_name = "hymba_gmlp_dilated_gla_macaron"


def rms_norm(x, g):
    xf = x.astype(jnp.float32)
    y = xf * lax.rsqrt(jnp.mean(xf * xf, axis=-1, keepdims=True) + EPS)
    return (y * g).astype(x.dtype)


def swiglu(h, w_gate, w_up, w_down):
    return (jax.nn.silu(h @ w_gate) * (h @ w_up)) @ w_down


def rope_tables(seq_len):
    pos = jnp.arange(seq_len, dtype=jnp.float32)
    inv_freq = ROPE_THETA ** (-jnp.arange(0, ROPE_DIMS, 2, dtype=jnp.float32) / ROPE_DIMS)
    ang = pos[:, None] * inv_freq[None, :]
    return jnp.cos(ang), jnp.sin(ang)


def apply_partial_rope(t, cos, sin):
    r = ROPE_DIMS // 2
    c = cos[None, :, None, :]
    s = sin[None, :, None, :]
    t1, t2, rest = t[..., :r], t[..., r:2 * r], t[..., 2 * r:]
    return jnp.concatenate([t1 * c - t2 * s, t2 * c + t1 * s, rest], axis=-1)


def spatial_gating(u, v, norm_g, w_s, b_s):
    B, S, _ = u.shape
    u = jax.nn.gelu(u)
    v = jax.nn.gelu(v)
    v = rms_norm(v.reshape(B, S, SG_GROUPS, HEAD_DIM), norm_g.reshape(SG_GROUPS, HEAD_DIM))
    v = v.reshape(B, S // SG_CHUNK, SG_CHUNK, SG_GROUPS, HEAD_DIM)
    causal = jnp.tril(jnp.ones((SG_CHUNK, SG_CHUNK), dtype=bool))
    w = jnp.where(causal[None], w_s, 0.0)
    sv = jnp.einsum('gts,bnsgc->bntgc', w, v) + b_s.T[:, :, None]
    return u * sv.reshape(B, S, SG_WIDTH)


def dilated_branch(q, k, v, window, dil):
    B, S, H, D = q.shape
    W = window // dil
    span = dil * W
    L = -(-S // span) * span
    nb = L // span

    def to_blocks(t):
        t = jnp.pad(t, ((0, 0), (0, L - S), (0, 0), (0, 0)))
        t = t.reshape(B, L // dil, dil, H, D).transpose(0, 2, 1, 3, 4)
        return t.reshape(B, dil, nb, W, H, D)

    def with_prev(t):
        prev = jnp.pad(t, ((0, 0), (0, 0), (1, 0), (0, 0), (0, 0), (0, 0)))[:, :, :-1]
        return jnp.concatenate([prev, t], axis=3)

    qb = to_blocks(q)
    kk = with_prev(to_blocks(k))
    vv = with_prev(to_blocks(v))
    s = jnp.einsum('brnqhd,brnkhd->brnhqk', qb, kk, preferred_element_type=jnp.float32)
    qi = jnp.arange(W)[:, None]
    kj = jnp.arange(2 * W)[None, :]
    dist = qi + W - kj
    band = (dist >= 0) & (dist <= W)
    blk = jnp.arange(nb)[:, None, None]
    valid = band[None] & ((blk > 0) | (kj[None] >= W))
    s = jnp.where(valid[None, None, :, None], s, -jnp.inf)
    m = jnp.max(s, axis=-1, keepdims=True)
    p = jnp.exp(s - m)
    l = jnp.sum(p, axis=-1, keepdims=True)
    o = jnp.einsum('brnhqk,brnkhd->brnqhd', p / l, vv)
    lse = (m + jnp.log(l))[..., 0]
    o = o.reshape(B, dil, L // dil, H, D).transpose(0, 2, 1, 3, 4).reshape(B, L, H, D)[:, :S]
    lse = lse.transpose(0, 1, 2, 4, 3).reshape(B, dil, L // dil, H)
    lse = lse.transpose(0, 2, 1, 3).reshape(B, L, H)[:, :S]
    return o, lse


def dilated_attention(q, k, v, q_gain, k_gain, cos, sin):
    B, S, _ = q.shape
    shp = (B, S, ATT_HEADS, HEAD_DIM)
    q = apply_partial_rope(rms_norm(q.reshape(shp).astype(jnp.float32), q_gain), cos, sin) * HEAD_DIM ** -0.5
    k = apply_partial_rope(rms_norm(k.reshape(shp).astype(jnp.float32), k_gain), cos, sin)
    v = v.reshape(shp).astype(jnp.float32)
    outs, lses = [], []
    for window, dil in DILATED_PAIRS:
        o, lse = dilated_branch(q, k, v, window, dil)
        outs.append(o)
        lses.append(lse)
    wts = jax.nn.softmax(jnp.stack(lses, axis=0), axis=0)
    o = jnp.einsum('gbsh,gbshd->bshd', wts, jnp.stack(outs, axis=0))
    return o.reshape(B, S, ATT_WIDTH)


def gated_linear_attention(q, k, v, g, r, w_gate, b_gate, out_g):
    B, S, _ = q.shape
    H, dk, dv, C = GLA_HEADS, GLA_DK, GLA_DV, GLA_CHUNK
    nc = S // C
    f32 = jnp.float32
    q = q.astype(f32).reshape(B, nc, C, H, dk) * dk ** -0.5
    k = k.astype(f32).reshape(B, nc, C, H, dk)
    v = v.astype(f32).reshape(B, nc, C, H, dv)
    log_a = jax.nn.log_sigmoid((r @ w_gate + b_gate).astype(f32)) / GLA_GATE_NORMALIZER
    b = jnp.cumsum(log_a.reshape(B, nc, C, H, dk), axis=2)
    q_dec = q * jnp.exp(b)
    A = jnp.einsum('bnihk,bnjhk->bnhij', q_dec, k * jnp.exp(-b))
    causal = jnp.tril(jnp.ones((C, C), dtype=bool))
    A = jnp.where(causal, A, 0.0)
    o = jnp.einsum('bnhij,bnjhv->bnihv', A, v)
    b_last = b[:, :, -1]
    U = jnp.einsum('bnjhk,bnjhv->nbhkv', k * jnp.exp(b_last[:, :, None] - b), v)
    decay = jnp.exp(b_last).transpose(1, 0, 2, 3)

    def step(state, inp):
        dec, u = inp
        return dec[..., None] * state + u, state

    _, states = lax.scan(step, jnp.zeros((B, H, dk, dv), f32), (decay, U))
    o = o + jnp.einsum('bnihk,nbhkv->bnihv', q_dec, states)
    o = rms_norm(o.reshape(B, S, H, dv), out_g) * jax.nn.silu(g.astype(f32).reshape(B, S, H, dv))
    return o.reshape(B, S, GLA_WIDTH)


def hybrid_mixer(h, w_in, sg_norm, sg_w, sg_b, q_norm, k_norm,
                 gla_w_gate, gla_b_gate, gla_out_norm, w_out, cos, sin):
    z = h @ w_in
    (a_u, a_v, b_q, b_k, b_v, c_q, c_k, c_v, c_g, c_r) = jnp.split(
        z, np.cumsum(SPLIT_SIZES)[:-1], axis=-1)
    ya = spatial_gating(a_u, a_v, sg_norm, sg_w, sg_b)
    yb = dilated_attention(b_q, b_k, b_v, q_norm, k_norm, cos, sin)
    yc = gated_linear_attention(c_q, c_k, c_v, c_g, c_r, gla_w_gate, gla_b_gate, gla_out_norm)
    y = jnp.concatenate([ya, yb.astype(h.dtype), yc.astype(h.dtype)], axis=-1)
    return y @ w_out


def setup_inputs(seed: int = 0) -> dict:
    key = jax.random.key(seed)
    ks = jax.random.split(key, 17)
    f32 = jnp.float32

    def nrm(k, shape, scale):
        return jax.random.normal(k, shape, f32) * scale

    def gain(k, shape):
        return 1.0 + 0.02 * jax.random.normal(k, shape, f32)

    return {
        "x": nrm(ks[0], (BATCH, SEQ, D_MODEL), 1.0),
        "ffn_norm": gain(ks[1], (DEPTH, 2, D_MODEL)),
        "ffn_w_gate": nrm(ks[2], (DEPTH, 2, D_MODEL, D_FF), D_MODEL ** -0.5),
        "ffn_w_up": nrm(ks[3], (DEPTH, 2, D_MODEL, D_FF), D_MODEL ** -0.5),
        "ffn_w_down": nrm(ks[4], (DEPTH, 2, D_FF, D_MODEL), D_FF ** -0.5),
        "mix_norm": gain(ks[5], (DEPTH, D_MODEL)),
        "w_in": nrm(ks[6], (DEPTH, D_MODEL, N_IN), D_MODEL ** -0.5),
        "sg_norm": gain(ks[7], (DEPTH, SG_WIDTH)),
        "sg_w": nrm(ks[8], (DEPTH, SG_GROUPS, SG_CHUNK, SG_CHUNK), SG_CHUNK ** -0.5),
        "sg_b": gain(ks[9], (DEPTH, SG_GROUPS, SG_CHUNK)),
        "q_norm": gain(ks[10], (DEPTH, HEAD_DIM)),
        "k_norm": gain(ks[11], (DEPTH, HEAD_DIM)),
        "gla_w_gate": nrm(ks[12], (DEPTH, GLA_GATE_RANK, GLA_HEADS * GLA_DK), GLA_GATE_RANK ** -0.5),
        "gla_b_gate": nrm(ks[13], (DEPTH, GLA_HEADS * GLA_DK), 0.1),
        "gla_out_norm": gain(ks[14], (DEPTH, GLA_DV)),
        "w_out": nrm(ks[15], (DEPTH, D_MIX, D_MODEL), D_MIX ** -0.5),
    }


def reference(x, ffn_norm, ffn_w_gate, ffn_w_up, ffn_w_down, mix_norm, w_in,
              sg_norm, sg_w, sg_b, q_norm, k_norm, gla_w_gate, gla_b_gate,
              gla_out_norm, w_out):
    cos, sin = rope_tables(x.shape[1])
    for l in range(DEPTH):
        x = x + 0.5 * swiglu(rms_norm(x, ffn_norm[l, 0]), ffn_w_gate[l, 0], ffn_w_up[l, 0], ffn_w_down[l, 0])
        x = x + hybrid_mixer(rms_norm(x, mix_norm[l]), w_in[l], sg_norm[l], sg_w[l], sg_b[l],
                             q_norm[l], k_norm[l], gla_w_gate[l], gla_b_gate[l],
                             gla_out_norm[l], w_out[l], cos, sin)
        x = x + 0.5 * swiglu(rms_norm(x, ffn_norm[l, 1]), ffn_w_gate[l, 1], ffn_w_up[l, 1], ffn_w_down[l, 1])
    return x
```

```cpp
#include <hip/hip_runtime.h>
#include <cstdio>
#include <cstdint>
#include <cmath>
namespace pg8 {
#define PG8_LAS __attribute__((address_space(3)))
typedef unsigned short bf16_t;
typedef short bf16x8 __attribute__((ext_vector_type(8)));
typedef float f32x4 __attribute__((ext_vector_type(4)));
typedef unsigned u32x4 __attribute__((ext_vector_type(4)));
constexpr int BM = 256, BK = 64, HALF = 128, HTB = HALF * BK * 2  , STAGE_BYTES = 8 * HTB, NXCD = 8, WGM = 8;

__host__ __device__ __forceinline__ int lds_byte(int r, int c) { const int st = (r >> 4) * 2 + (c >> 5), rr = r & 15, cc = c & 31, ob = rr * 64 + cc * 2; return st * 1024 + (ob ^ (((ob >> 9) & 1) << 5)); }
__host__ __device__ __forceinline__ void stage_rc(int b, int& R, int& C) { const int st = b / 1024, sb = b % 1024, swz = sb ^ (((sb >> 9) & 1) << 5); R = (st >> 1) * 16 + swz / 64; C = (st & 1) * 32 + (swz % 64) / 2; }
__host__ __device__ __forceinline__ int perm32(int rho) { const int n = rho >> 4, i = rho & 15; return 8 * (i >> 2) + 4 * n + (i & 3); }

struct Unit { int pm, pn; };
struct Gemm { const bf16_t* A; const bf16_t* Bt; int M, N, K; };

struct StaticOrder {
    int nM, nN, nwg, G, c;
    __host__ __device__ void init(int M, int N, int G_, int c_) { nM = M / BM; nN = N / BM; nwg = nM * nN; G = G_; c = c_; }
    __host__ __device__ bool next(int i, Unit& u) const {
        const long L = (long)i * G + c; if (L >= nwg) return false;
        int wgid = (int)L; { const int q = nwg / NXCD, r = nwg % NXCD, xcd = wgid % NXCD, off = wgid / NXCD; wgid = (xcd < r ? xcd * (q + 1) : r * (q + 1) + (xcd - r) * q) + off; }
        const int nig = WGM * nN, gid = wgid / nig, fm = gid * WGM, gsz = (nM - fm) < WGM ? (nM - fm) : WGM;
        u.pm = fm + ((wgid % nig) % gsz); u.pn = (wgid % nig) / gsz; return true;
    }
    __device__ __forceinline__ void a_ready(const Unit&) const {}
    __device__ __forceinline__ void done(const Unit&) const {}
};
__device__ __forceinline__ unsigned cvt_pk_bf16(float lo, float hi) { unsigned r; asm volatile("v_cvt_pk_bf16_f32 %0, %1, %2" : "=v"(r) : "v"(lo), "v"(hi)); return r; }
typedef float f32x2 __attribute__((ext_vector_type(2)));
template <class Epi, class Sched, bool ALIGN_EPI = false, bool SP2 = false>
__device__ __forceinline__ void gemm_phase(PG8_LAS unsigned char* lds, const Gemm g, const Sched& S, const Epi& E) {
    int tid_l = threadIdx.x; asm volatile("" : "+v"(tid_l));
    const int tid = tid_l, wid = __builtin_amdgcn_readfirstlane(tid >> 6), lane = tid & 63, wr = wid >> 2, wc = wid & 3, fr = lane & 15, fq = lane >> 4;
    const int K = g.K, nt = K / BK;
    unsigned voffA[2], voffB[2];
#pragma unroll
    for (int i = 0; i < 2; ++i) { int R, C; stage_rc(tid * 16 + i * 8192, R, C); const int Rb = Epi::PERM ? ((R & ~31) + perm32(R & 31)) : R;
        voffA[i] = (unsigned)(R * K + C) * 2u; voffB[i] = (unsigned)(Rb * K + C) * 2u; }
    const size_t kstep = (size_t)(BK * 2);
    const size_t hstep = (size_t)HALF * K * 2;
    const size_t tstep = 2 * hstep;
    const unsigned ldsw = (unsigned)wid * 1024u;
    const int aoff = lds_byte(wr * 64 + fr, fq * 8), boff = lds_byte(wc * 32 + fr, fq * 8);
#define PG8_SA(b, h) (((b) * 2 + (h)) * HTB)
#define PG8_SB(b, h) ((4 + (b) * 2 + (h)) * HTB)
#define PG8_STAGE(bufoff, gbase, voff) do { _Pragma("unroll") for (int _i = 0; _i < 2; ++_i) \
        __builtin_amdgcn_global_load_lds((const unsigned*)((const char*)(gbase) + (voff)[_i]), (PG8_LAS unsigned*)(lds + (bufoff) + ldsw + _i * 8192), 16, 0, 0); } while (0)
#define PG8_LDA(dst, b, h) do { _Pragma("unroll") for (int m = 0; m < 4; ++m) _Pragma("unroll") for (int k = 0; k < 2; ++k) dst[m][k] = *(const PG8_LAS bf16x8*)(lds + PG8_SA(b, h) + aoff + m * 2048 + k * 1024); } while (0)
#define PG8_LDB(dst, b, h) do { _Pragma("unroll") for (int n = 0; n < 2; ++n) _Pragma("unroll") for (int k = 0; k < 2; ++k) dst[n][k] = *(const PG8_LAS bf16x8*)(lds + PG8_SB(b, h) + boff + n * 2048 + k * 1024); } while (0)
#define PG8_MMA(ai, bj, At, Bt) do { __builtin_amdgcn_s_setprio(1); _Pragma("unroll") for (int m = 0; m < 4; ++m) _Pragma("unroll") for (int n = 0; n < 2; ++n) _Pragma("unroll") for (int k = 0; k < 2; ++k) \
        acc[ai][bj][m][n] = __builtin_amdgcn_mfma_f32_16x16x32_bf16(Bt[n][k], At[m][k], acc[ai][bj][m][n], 0, 0, 0); __builtin_amdgcn_s_setprio(0); } while (0)
#define PG8_WAIT_V(n) asm volatile("s_waitcnt vmcnt(" #n ")" ::: "memory")
#define PG8_WAIT_L(n) asm volatile("s_waitcnt lgkmcnt(" #n ")" ::: "memory")
#define PG8_BAR __builtin_amdgcn_s_barrier()
#define PG8_SCHED __builtin_amdgcn_sched_barrier(0)
    Unit cur, nxt; int ui = 0;
    if (!S.next(0, cur)) return;
    f32x4 acc[2][2][4][2];
#pragma unroll
    for (int a = 0; a < 2; ++a)
#pragma unroll
        for (int b = 0; b < 2; ++b)
#pragma unroll
            for (int m = 0; m < 4; ++m)
#pragma unroll
                for (int n = 0; n < 2; ++n) acc[a][b][m][n] = (f32x4){0.f, 0.f, 0.f, 0.f};
    bf16x8 At[4][2], B0[2][2], B1[2][2];
    const char* cA = (const char*)g.A + (size_t)cur.pm * tstep; const char* cB = (const char*)g.Bt + (size_t)cur.pn * tstep;
    S.a_ready(cur);
    if constexpr (SP2) {
        PG8_STAGE(PG8_SB(0, 0), cB, voffB); PG8_STAGE(PG8_SB(0, 1), cB + hstep, voffB); PG8_STAGE(PG8_SA(0, 0), cA, voffA); PG8_STAGE(PG8_SA(0, 1), cA + hstep, voffA);
        if (wr == 1) PG8_BAR;
        PG8_WAIT_V(2); PG8_BAR;
        PG8_STAGE(PG8_SB(1, 0), cB + kstep, voffB); PG8_STAGE(PG8_SA(1, 0), cA + kstep, voffA); PG8_STAGE(PG8_SB(1, 1), cB + hstep + kstep, voffB);
        PG8_WAIT_V(6); PG8_BAR;
    } else {
        PG8_STAGE(PG8_SB(0, 0), cB, voffB); PG8_STAGE(PG8_SA(0, 0), cA, voffA); PG8_STAGE(PG8_SB(0, 1), cB + hstep, voffB); PG8_STAGE(PG8_SA(0, 1), cA + hstep, voffA);
        if (wr == 1) PG8_BAR;
        PG8_WAIT_V(4); PG8_BAR;
        PG8_STAGE(PG8_SB(1, 0), cB + kstep, voffB); PG8_STAGE(PG8_SA(1, 0), cA + kstep, voffA); PG8_STAGE(PG8_SB(1, 1), cB + hstep + kstep, voffB);
        PG8_WAIT_V(6); PG8_BAR;
    }
    for (;;) {
        const bool has_next = S.next(ui + 1, nxt);
        const char* nA = has_next ? (const char*)g.A + (size_t)nxt.pm * tstep : cA; const char* nB = has_next ? (const char*)g.Bt + (size_t)nxt.pn * tstep : cB;
        for (int t = 0; t < nt; t += 2) {
            const bool last = (t == nt - 2);
            const char* a1 = cA + (size_t)(t + 1) * kstep;
            const char* a2 = last ? nA : cA + (size_t)(t + 2) * kstep; const char* b2 = last ? nB : cB + (size_t)(t + 2) * kstep;
            const char* a3 = a2 + kstep; const char* b3 = b2 + kstep;
            if (last && has_next) S.a_ready(nxt);
            if constexpr (SP2) {
            PG8_LDB(B0, 0, 0); PG8_LDB(B1, 0, 1); PG8_SCHED; PG8_LDA(At, 0, 0); PG8_STAGE(PG8_SA(1, 1), a1 + hstep, voffA);
            PG8_WAIT_V(8); PG8_WAIT_L(0); PG8_BAR; PG8_MMA(0, 0, At, B0); PG8_MMA(0, 1, At, B1); PG8_BAR; PG8_SCHED;
            PG8_LDA(At, 0, 1); PG8_STAGE(PG8_SB(0, 0), b2, voffB); PG8_STAGE(PG8_SB(0, 1), b2 + hstep, voffB); PG8_STAGE(PG8_SA(0, 0), a2, voffA);
            PG8_WAIT_V(8); PG8_WAIT_L(0); PG8_BAR; PG8_MMA(1, 0, At, B0); PG8_MMA(1, 1, At, B1); PG8_BAR; PG8_SCHED;
            PG8_LDB(B0, 1, 0); PG8_LDB(B1, 1, 1); PG8_SCHED; PG8_LDA(At, 1, 0); PG8_STAGE(PG8_SA(0, 1), a2 + hstep, voffA);
            PG8_WAIT_V(8); PG8_WAIT_L(0); PG8_BAR; PG8_MMA(0, 0, At, B0); PG8_MMA(0, 1, At, B1); PG8_BAR; PG8_SCHED;
            PG8_LDA(At, 1, 1); PG8_STAGE(PG8_SB(1, 0), b3, voffB); PG8_STAGE(PG8_SB(1, 1), b3 + hstep, voffB); PG8_STAGE(PG8_SA(1, 0), a3, voffA);
            PG8_WAIT_V(8); PG8_WAIT_L(0); PG8_BAR; PG8_MMA(1, 0, At, B0); PG8_MMA(1, 1, At, B1); PG8_BAR; PG8_SCHED;
            } else {
            PG8_LDB(B0, 0, 0); PG8_SCHED; PG8_LDA(At, 0, 0); PG8_STAGE(PG8_SA(1, 1), a1 + hstep, voffA);
            PG8_WAIT_L(8); PG8_BAR; PG8_WAIT_L(0); PG8_MMA(0, 0, At, B0); PG8_BAR; PG8_SCHED;
            PG8_LDB(B1, 0, 1); PG8_STAGE(PG8_SB(0, 0), b2, voffB);
            PG8_BAR; PG8_WAIT_L(0); PG8_MMA(0, 1, At, B1); PG8_BAR;
            PG8_LDA(At, 0, 1); PG8_STAGE(PG8_SA(0, 0), a2, voffA);
            PG8_BAR; PG8_WAIT_L(0); PG8_MMA(1, 0, At, B0); PG8_BAR; PG8_SCHED;
            PG8_STAGE(PG8_SB(0, 1), b2 + hstep, voffB);
            PG8_WAIT_V(6); PG8_BAR; PG8_MMA(1, 1, At, B1); PG8_BAR;
            PG8_LDB(B0, 1, 0); PG8_SCHED; PG8_LDA(At, 1, 0); PG8_STAGE(PG8_SA(0, 1), a2 + hstep, voffA);
            PG8_WAIT_L(8); PG8_BAR; PG8_WAIT_L(0); PG8_MMA(0, 0, At, B0); PG8_BAR; PG8_SCHED;
            PG8_LDB(B1, 1, 1); PG8_STAGE(PG8_SB(1, 0), b3, voffB);
            PG8_BAR; PG8_WAIT_L(0); PG8_MMA(0, 1, At, B1); PG8_BAR;
            PG8_LDA(At, 1, 1); PG8_STAGE(PG8_SA(1, 0), a3, voffA);
            PG8_BAR; PG8_WAIT_L(0); PG8_MMA(1, 0, At, B0); PG8_BAR; PG8_SCHED;
            PG8_STAGE(PG8_SB(1, 1), b3 + hstep, voffB);
            PG8_WAIT_V(6); PG8_BAR; PG8_MMA(1, 1, At, B1); PG8_BAR;
            }
        }
        if constexpr (ALIGN_EPI) { if (wr == 0) PG8_BAR; }
        if constexpr (!Epi::AFTER_DRAIN) { E(acc, cur, wr, wc, fr, fq); S.done(cur); }
        if (!has_next) break;
#pragma unroll
        for (int a = 0; a < 2; ++a)
#pragma unroll
            for (int b = 0; b < 2; ++b)
#pragma unroll
                for (int m = 0; m < 4; ++m)
#pragma unroll
                    for (int n = 0; n < 2; ++n) acc[a][b][m][n] = (f32x4){0.f, 0.f, 0.f, 0.f};
        cur = nxt; cA = nA; cB = nB; ++ui;
        if constexpr (ALIGN_EPI) { if (wr == 1) PG8_BAR; }
    }
    PG8_WAIT_V(0);
    if constexpr (!ALIGN_EPI) { if (wr == 0) PG8_BAR; }
    PG8_BAR;
    if constexpr (Epi::AFTER_DRAIN) { E.fused(acc, cur, wr, wc, fr, fq, lds, wid, lane); S.done(cur); }
#undef PG8_SA
#undef PG8_SB
#undef PG8_STAGE
#undef PG8_LDA
#undef PG8_LDB
#undef PG8_MMA
#undef PG8_WAIT_V
#undef PG8_WAIT_L
#undef PG8_BAR
#undef PG8_SCHED
}
}
namespace pg8 {
struct EpiSwiGLU {
    static constexpr bool PERM = true, AFTER_DRAIN = false;
    bf16_t* O; int ldc;
    __device__ __forceinline__ void operator()(const f32x4 (&acc)[2][2][4][2], const Unit& u, int wr, int wc, int fr, int fq) const {
        const int row0 = u.pm * BM + wr * 64 + fr, col0 = u.pn * HALF + wc * 32 + 8 * fq;
#pragma unroll
        for (int ai = 0; ai < 2; ++ai)
#pragma unroll
            for (int m = 0; m < 4; ++m) { bf16_t* rowp = O + (size_t)(row0 + ai * HALF + m * 16) * ldc + col0;
                float h[8];
#pragma unroll
                for (int n = 0; n < 2; ++n)
#pragma unroll
                    for (int j = 0; j < 4; ++j) { const float g = acc[ai][0][m][n][j], up = acc[ai][1][m][n][j];
                        h[4 * n + j] = g * __builtin_amdgcn_rcpf(1.0f + __expf(-g)) * up; }
                u32x4 w; w.x = cvt_pk_bf16(h[0], h[1]); w.y = cvt_pk_bf16(h[2], h[3]); w.z = cvt_pk_bf16(h[4], h[5]); w.w = cvt_pk_bf16(h[6], h[7]);
                *(u32x4*)rowp = w; }
    }
};
struct EpiResid {
    static constexpr bool PERM = false, AFTER_DRAIN = false;
    const float* base; float* out; int ldc; float scale;
    __device__ __forceinline__ void operator()(const f32x4 (&acc)[2][2][4][2], const Unit& u, int wr, int wc, int fr, int fq) const {
        const int row0 = u.pm * BM + wr * 64 + fr, col0 = u.pn * BM + wc * 32 + 4 * fq;
#pragma unroll
        for (int ai = 0; ai < 2; ++ai)
#pragma unroll
            for (int m = 0; m < 4; ++m) { const size_t off = (size_t)(row0 + ai * HALF + m * 16) * ldc + col0;
                f32x4 bs[2][2];
#pragma unroll
                for (int bj = 0; bj < 2; ++bj)
#pragma unroll
                    for (int n = 0; n < 2; ++n) bs[bj][n] = *(const f32x4*)(base + off + bj * HALF + n * 16);
#pragma unroll
                for (int bj = 0; bj < 2; ++bj)
#pragma unroll
                    for (int n = 0; n < 2; ++n) *(f32x4*)(out + off + bj * HALF + n * 16) = bs[bj][n] + acc[ai][bj][m][n] * scale;
                asm volatile("" ::: "memory"); }
    }
};
struct EpiZ {
    static constexpr bool PERM = true, AFTER_DRAIN = false;
    bf16_t* Z; int ldz; float* R; int nz_tiles;
    __device__ __forceinline__ void operator()(const f32x4 (&acc)[2][2][4][2], const Unit& u, int wr, int wc, int fr, int fq) const {
        const int row0 = u.pm * BM + wr * 64 + fr;
        if (u.pn < nz_tiles) {
            const int col0 = u.pn * BM + wc * 32 + 8 * fq;
#pragma unroll
            for (int ai = 0; ai < 2; ++ai)
#pragma unroll
                for (int m = 0; m < 4; ++m) { bf16_t* rowp = Z + (size_t)(row0 + ai * HALF + m * 16) * ldz + col0;
#pragma unroll
                    for (int bj = 0; bj < 2; ++bj) { const f32x4 v0 = acc[ai][bj][m][0], v1 = acc[ai][bj][m][1];
                        u32x4 w; w.x = cvt_pk_bf16(v0[0], v0[1]); w.y = cvt_pk_bf16(v0[2], v0[3]); w.z = cvt_pk_bf16(v1[0], v1[1]); w.w = cvt_pk_bf16(v1[2], v1[3]);
                        *(u32x4*)(rowp + bj * HALF) = w; } }
        } else if (wc == 0 && fq < 2) {
#pragma unroll
            for (int ai = 0; ai < 2; ++ai)
#pragma unroll
                for (int m = 0; m < 4; ++m) { float* rp = R + (size_t)(row0 + ai * HALF + m * 16) * 16 + 8 * fq;
                    *(f32x4*)rp = acc[ai][0][m][0]; *(f32x4*)(rp + 4) = acc[ai][0][m][1]; }
        }
    }
};
}
constexpr int NWAVES = 8;
constexpr int BATCH = 4, SEQ = 8192, DM = 2048, DFF = 5632, DEPTH = 4;
constexpr int M = BATCH * SEQ;
constexpr int NIN = 5648, NZ = 5632, NINP = 5888;
constexpr int ZLD = NZ;
constexpr int ZC_AU = 0, ZC_AV = 512, ZC_BQ = 1024, ZC_BK = 1792, ZC_BV = 2560, ZC_CQ = 3328, ZC_CK = 3712, ZC_CV = 4096, ZC_CG = 4864;
constexpr int YC_A = 0, YC_B = 512, YC_C = 1280;
constexpr int NCHUNK = M / 64;
constexpr float EPS = 1e-6f;

constexpr size_t MiB = 1u << 20;
constexpr size_t WS_CTL = 0, CTL_ZERO_BYTES = 1 * MiB;
constexpr size_t WS_ROPE = 1 * MiB;
constexpr size_t WS_R = 2 * MiB;
constexpr size_t WS_DEC = 4 * MiB;
constexpr size_t WS_LSE = 5 * MiB;
constexpr size_t WS_W = 8 * MiB;
constexpr size_t W_GU = (size_t)2 * DFF * DM * 2, W_D = (size_t)DM * DFF * 2, W_IN = (size_t)NINP * DM * 2, W_OUT = (size_t)DM * DM * 2;
constexpr size_t WL_GU0 = 0, WL_D0 = WL_GU0 + W_GU, WL_GU1 = WL_D0 + W_D, WL_D1 = WL_GU1 + W_GU, WL_IN = WL_D1 + W_D, WL_OUT = WL_IN + W_IN, W_LAYER = WL_OUT + W_OUT;
constexpr size_t WS_H = WS_W + DEPTH * W_LAYER;
constexpr size_t WS_HZ = WS_H + (size_t)M * DM * 2;
constexpr size_t WS_Y = WS_HZ + (size_t)M * DFF * 2;
constexpr size_t WS_OG = WS_Y + (size_t)M * DM * 2;
constexpr size_t WS_END = WS_OG + (size_t)3 * M * 768 * 2;
static_assert(W_LAYER == 163 * MiB && WS_H == 660 * MiB && (size_t)NCHUNK * 6 * 128 * 64 * 4 <= (size_t)M * DM * 2, "ws map");
constexpr int CW_BAR = 4096;

constexpr int SCR_BYTES = 139264;
constexpr int LDSCTL_OFF = SCR_BYTES;
constexpr int LDS_BYTES = 143360;
static_assert(pg8::STAGE_BYTES <= SCR_BYTES, "lds");

#define GAS __attribute__((address_space(1)))
#define LAS __attribute__((address_space(3)))
typedef unsigned short bf16;
typedef unsigned v4u __attribute__((ext_vector_type(4)));
typedef unsigned v2u __attribute__((ext_vector_type(2)));
typedef float f32x4 __attribute__((ext_vector_type(4)));
typedef short bf16x8 __attribute__((ext_vector_type(8)));
typedef short s16x4 __attribute__((ext_vector_type(4)));
#define LDS_WAIT() asm volatile("s_waitcnt lgkmcnt(0)" ::: "memory")
__device__ __forceinline__ float bflo(unsigned w) { return __uint_as_float(w << 16); }
__device__ __forceinline__ float bfhi(unsigned w) { return __uint_as_float(w & 0xffff0000u); }
__device__ __forceinline__ float bf1(bf16 b) { return __uint_as_float(((unsigned)b) << 16); }
__device__ __forceinline__ unsigned pk2(float lo, float hi) { return pg8::cvt_pk_bf16(lo, hi); }
__device__ __forceinline__ bf16 f2bf(float f) { return (bf16)(pg8::cvt_pk_bf16(f, 0.f) & 0xffffu); }
__device__ __forceinline__ void unpack8(const v4u w, float (&f)[8]) { f[0] = bflo(w.x); f[1] = bfhi(w.x); f[2] = bflo(w.y); f[3] = bfhi(w.y); f[4] = bflo(w.z); f[5] = bfhi(w.z); f[6] = bflo(w.w); f[7] = bfhi(w.w); }
__device__ __forceinline__ v4u pack8(const float (&f)[8]) { v4u w; w.x = pk2(f[0], f[1]); w.y = pk2(f[2], f[3]); w.z = pk2(f[4], f[5]); w.w = pk2(f[6], f[7]); return w; }
__device__ __forceinline__ float gelu_tanh(float x) {
    const float u = 0.7978845608028654f * (x + 0.044715f * x * x * x);
    const float e = __expf(2.0f * u);
    const float th = 1.0f - 2.0f * __builtin_amdgcn_rcpf(1.0f + e);
    return 0.5f * x * (1.0f + th);
}
__device__ __forceinline__ float silu_f(float x) { return x * __builtin_amdgcn_rcpf(1.0f + __expf(-x)); }
__device__ __forceinline__ bf16x8 lds_row8(const LAS unsigned char* p) { return *(const LAS bf16x8*)p; }
typedef short v4i16_t __attribute__((ext_vector_type(4)));
__device__ __forceinline__ s16x4 lds_tr4(const LAS unsigned char* p) { return __builtin_bit_cast(s16x4, __builtin_amdgcn_ds_read_tr16_b64_v4i16((LAS v4i16_t*)p)); }
__device__ __forceinline__ bf16x8 cat8(s16x4 lo, s16x4 hi) { return __builtin_shufflevector(lo, hi, 0, 1, 2, 3, 4, 5, 6, 7); }
#define MFMA16(a, b, c) __builtin_amdgcn_mfma_f32_16x16x32_bf16((a), (b), (c), 0, 0, 0)

#define XB_TMO      128
#define XB_XCNT(j)  (256  + 64 * (j))
#define XB_XSUB(j)  (1280 + 64 * (j))
#define XB_XGEN(j)  (2304 + 64 * (j))
#define XB_TOP      3328
#define XB_TOPGEN   3392
#define XCD_BAR_WORDS 3456
#define XB_SPIN_CAP (1u << 21)

__device__ __forceinline__ unsigned xb_ld(unsigned* p)              { return __hip_atomic_load(p, __ATOMIC_RELAXED, __HIP_MEMORY_SCOPE_AGENT); }
__device__ __forceinline__ unsigned xb_add(unsigned* p, unsigned v) { return __hip_atomic_fetch_add(p, v, __ATOMIC_RELAXED, __HIP_MEMORY_SCOPE_AGENT); }
__device__ __forceinline__ unsigned xb_xcc_id() { return (unsigned)__builtin_amdgcn_s_getreg((3 << 11) | 20) & 0xFu; }
#define XB_SPIN(cond, bar) do { unsigned _sp = 0; while (cond) { __builtin_amdgcn_s_sleep(1); \
    if ((++_sp & 255u) == 0u) { if (xb_ld(&(bar)[XB_TMO])) break; if (_sp > XB_SPIN_CAP) { atomicAdd(&(bar)[XB_TMO], 1u); break; } } } } while (0)

struct XcdBarrier {
    unsigned* bar; unsigned x;
    volatile LAS unsigned* st;
};

__device__ __forceinline__ XcdBarrier xcd_barrier_post(unsigned* bar, volatile LAS unsigned* st) {
    XcdBarrier b; b.bar = bar; b.x = xb_xcc_id(); b.st = st;
    if (threadIdx.x == 0) (void)xb_add(&bar[XB_XCNT(b.x)], 1u);
    return b;
}
__device__ __forceinline__ void xcd_barrier_complete(unsigned* bar, unsigned x, unsigned& nloc, unsigned& nx) {
    const unsigned G = gridDim.x * gridDim.y * gridDim.z;
    unsigned sum, cnt, mine, sp = 0u;
    for (;;) {
        sum = 0u; cnt = 0u; mine = 0u;
#pragma unroll
        for (unsigned j = 0; j < 16; ++j) { const unsigned c = xb_ld(&bar[XB_XCNT(j)]); sum += c; cnt += (c > 0u) ? 1u : 0u; mine = (j == x) ? c : mine; }
        if (sum == G) break;
        __builtin_amdgcn_s_sleep(1);
        if ((++sp & 255u) == 0u) { if (xb_ld(&bar[XB_TMO])) break; if (sp > XB_SPIN_CAP) { atomicAdd(&bar[XB_TMO], 1u); break; } }
    }
    nloc = mine > 0u ? mine : 1u; nx = cnt > 0u ? cnt : 1u;
}

__device__ __forceinline__ void xcd_barrier(const XcdBarrier& b) {
    asm volatile("s_waitcnt vmcnt(0)" ::: "memory");
    __syncthreads();
    if (threadIdx.x == 0) {
        unsigned* bar = b.bar;
        __builtin_amdgcn_s_waitcnt(0);
        unsigned nloc = b.st[0], nx = b.st[1];
        if (nloc == 0u) { xcd_barrier_complete(bar, b.x, nloc, nx); b.st[0] = nloc; b.st[1] = nx; }
        const unsigned old = xb_add(&bar[XB_XSUB(b.x)], 1u);
        const unsigned gen = old / nloc;
        if (old + 1u == (gen + 1u) * nloc) {
            __builtin_amdgcn_fence(__ATOMIC_RELEASE, "agent");
            asm volatile("s_waitcnt vmcnt(0)" ::: "memory");
            const unsigned og = xb_add(&bar[XB_TOP], 1u);
            const unsigned tg = og / nx;
            if (og + 1u == (tg + 1u) * nx) xb_add(&bar[XB_TOPGEN], 1u);
            else XB_SPIN(xb_ld(&bar[XB_TOPGEN]) == tg, bar);
            __builtin_amdgcn_fence(__ATOMIC_ACQUIRE, "agent");
            xb_add(&bar[XB_XGEN(b.x)], 1u);
            asm volatile("s_waitcnt vmcnt(0)" ::: "memory");
        } else {
            XB_SPIN(xb_ld(&bar[XB_XGEN(b.x)]) == gen, bar);
            __builtin_amdgcn_fence(__ATOMIC_ACQUIRE, "agent");
            asm volatile("s_waitcnt vmcnt(0)" ::: "memory");
        }
    }
    __syncthreads();
}

struct Args {
    const float* in[16]; float* out; unsigned char* ws;
    float inv_freq[16];
};

__device__ __forceinline__ void transpose_item(const float* __restrict__ W, int ldw, int nvalid, int k0, int n0, bf16* __restrict__ WT, int ldt, int dst_row0, LAS float* scr, int lane) {
    const int nc = n0 + (lane & 31); const bool okc = nc < nvalid;
#pragma unroll 8
    for (int i = 0; i < 32; ++i) { const int kk = 2 * i + (lane >> 5); scr[kk * 33 + (lane & 31)] = okc ? W[(size_t)(k0 + kk) * ldw + nc] : 0.f; }
    LDS_WAIT(); asm volatile("" ::: "memory");
    const int c = lane & 7;
#pragma unroll
    for (int j = 0; j < 4; ++j) { const int n = (lane >> 3) + 8 * j; const LAS float* s = scr + (8 * c) * 33 + n;
        v4u o; o.x = pk2(s[0 * 33], s[1 * 33]); o.y = pk2(s[2 * 33], s[3 * 33]); o.z = pk2(s[4 * 33], s[5 * 33]); o.w = pk2(s[6 * 33], s[7 * 33]);
        *(v4u*)(WT + (size_t)(dst_row0 + n) * ldt + k0 + 8 * c) = o; }
    LDS_WAIT(); asm volatile("" ::: "memory");
}
constexpr int IT_GU = (DM / 64) * (DFF / 32);
constexpr int IT_D = (DFF / 64) * (DM / 32);
constexpr int IT_IN = (DM / 64) * (NINP / 32);
constexpr int IT_OUT = (DM / 64) * (DM / 32);
constexpr int IT_LAYER = 2 * (2 * IT_GU + IT_D) + IT_IN + IT_OUT;

typedef const __attribute__((address_space(4))) Args* ArgPc;
__device__ __forceinline__ void prologue(ArgPc Ap, unsigned char* ws, LAS unsigned char* lds, int gw, int ngw, int wave, int lane, int gtid, int ngt) {
    LAS float* scr = (LAS float*)(lds + wave * 16384);
    for (int it = gw; it < DEPTH * IT_LAYER; it += ngw) {
        const int l = it / IT_LAYER; int r = it - l * IT_LAYER;
        unsigned char* wl = ws + WS_W + (size_t)l * W_LAYER;
        if (r < 2 * (2 * IT_GU + IT_D)) {
            const int f = r / (2 * IT_GU + IT_D); r -= f * (2 * IT_GU + IT_D);
            const size_t wsel = (size_t)(l * 2 + f);
            if (r < 2 * IT_GU) {
                const int up = r / IT_GU; r -= up * IT_GU;
                const float* W = (up ? Ap->in[3] : Ap->in[2]) + wsel * DM * DFF;
                const int kb = r / (DFF / 32), nb = r % (DFF / 32), n0 = nb * 32;
                bf16* WT = (bf16*)(wl + (f ? WL_GU1 : WL_GU0));
                transpose_item(W, DFF, DFF, kb * 64, n0, WT, DM, 256 * (n0 >> 7) + (n0 & 127) + 128 * up, scr, lane);
            } else {
                r -= 2 * IT_GU;
                const float* W = Ap->in[4] + wsel * DFF * DM;
                const int kb = r / (DM / 32), nb = r % (DM / 32);
                bf16* WT = (bf16*)(wl + (f ? WL_D1 : WL_D0));
                transpose_item(W, DM, DM, kb * 64, nb * 32, WT, DFF, nb * 32, scr, lane);
            }
        } else {
            r -= 2 * (2 * IT_GU + IT_D);
            if (r < IT_IN) {
                const float* W = Ap->in[6] + (size_t)l * DM * NIN;
                const int kb = r / (NINP / 32), nb = r % (NINP / 32);
                transpose_item(W, NIN, NIN, kb * 64, nb * 32, (bf16*)(wl + WL_IN), DM, nb * 32, scr, lane);
            } else {
                r -= IT_IN;
                const float* W = Ap->in[15] + (size_t)l * DM * DM;
                const int kb = r / (DM / 32), nb = r % (DM / 32);
                transpose_item(W, DM, DM, kb * 64, nb * 32, (bf16*)(wl + WL_OUT), DM, nb * 32, scr, lane);
            }
        }
    }
    float* rc = (float*)(ws + WS_ROPE); float* rs = rc + SEQ * 16;
    for (int i = gtid; i < SEQ * 16; i += ngt) {
        const int pos = i >> 4, k = i & 15;
        const float angf = (float)pos * Ap->inv_freq[k];
        const double a = (double)angf;
        const double q = __builtin_rint(a * 0.63661977236758134308);
        double x = __builtin_fma(-q, 1.57079632679489655800e+00, a); x = __builtin_fma(-q, 6.12323399573676603587e-17, x);
        const double x2 = x * x;
        double sp = 1.0 / 6227020800.0; sp = sp * x2 - 1.0 / 39916800.0; sp = sp * x2 + 1.0 / 362880.0; sp = sp * x2 - 1.0 / 5040.0; sp = sp * x2 + 1.0 / 120.0; sp = sp * x2 - 1.0 / 6.0; sp = sp * x2 + 1.0; sp *= x;
        double cp = 1.0 / 87178291200.0; cp = -cp; cp = cp * x2 + 1.0 / 479001600.0; cp = cp * x2 - 1.0 / 3628800.0; cp = cp * x2 + 1.0 / 40320.0; cp = cp * x2 - 1.0 / 720.0; cp = cp * x2 + 1.0 / 24.0; cp = cp * x2 - 0.5; cp = cp * x2 + 1.0;
        const int qi = ((int)q) & 3;
        const double sv = (qi == 0) ? sp : (qi == 1) ? cp : (qi == 2) ? -sp : -cp;
        const double cv = (qi == 0) ? cp : (qi == 1) ? -sp : (qi == 2) ? -cp : sp;
        rc[i] = (float)cv; rs[i] = (float)sv;
    }
}

__device__ __forceinline__ float wave_sum(float v) {
#pragma unroll
    for (int o = 1; o < 64; o <<= 1) v += __shfl_xor(v, o);
    return v;
}
__device__ __forceinline__ void norm_phase(const float* __restrict__ x, const float* __restrict__ g, bf16* __restrict__ h, int gw, int ngw, int lane) {
    f32x4 gv[8];
#pragma unroll
    for (int j = 0; j < 8; ++j) gv[j] = *((const f32x4*)g + lane + 64 * j);
    for (int m = gw; m < M; m += ngw) {
        const f32x4* xr = (const f32x4*)(x + (size_t)m * DM) + lane;
        f32x4 v[8]; float s = 0.f;
#pragma unroll
        for (int j = 0; j < 8; ++j) { v[j] = xr[64 * j]; s += (v[j].x * v[j].x + v[j].y * v[j].y) + (v[j].z * v[j].z + v[j].w * v[j].w); }
        const float rstd = rsqrtf(wave_sum(s) * (1.f / DM) + EPS);
        v2u* o = (v2u*)(h + (size_t)m * DM) + lane;
#pragma unroll
        for (int j = 0; j < 8; ++j) { v2u w; w.x = pk2(v[j].x * rstd * gv[j].x, v[j].y * rstd * gv[j].y); w.y = pk2(v[j].z * rstd * gv[j].z, v[j].w * rstd * gv[j].w); o[64 * j] = w; }
    }
}

constexpr int LD128 = 272;
constexpr int LD64 = 144;
__device__ __forceinline__ void gmlp_unit(LAS unsigned char* lds, const bf16* __restrict__ z, const float* __restrict__ sgw, const float* __restrict__ sgb, const float* __restrict__ sgn,
                                          bf16* __restrict__ y, int um, int tid, int w, int lane) {
    const int g = um & 3, cn = um >> 2; const size_t R0 = (size_t)cn * 128;
    const int c16 = lane & 15, g4 = lane >> 4, q4 = c16 >> 2, p4 = lane & 3;
    LAS unsigned char* WM = lds; LAS unsigned char* VN = lds + 128 * LD128;
#pragma unroll
    for (int it = 0; it < 4; ++it) {
        const int c = tid + 512 * it, t = c >> 4, ch = c & 15;
        const float* wp = sgw + ((size_t)(g * 128 + t)) * 128 + 8 * ch;
        const f32x4 w0 = *(const f32x4*)wp, w1 = *(const f32x4*)(wp + 4);
        float f[8] = {w0.x, w0.y, w0.z, w0.w, w1.x, w1.y, w1.z, w1.w};
#pragma unroll
        for (int e = 0; e < 8; ++e) f[e] = (8 * ch + e <= t) ? f[e] : 0.f;
        *(LAS v4u*)(WM + t * LD128 + ch * 16) = pack8(f);
        const v4u vw = *(const v4u*)(z + (R0 + t) * ZLD + ZC_AV + 128 * g + 8 * ch);
        float v[8]; unpack8(vw, v); float ss = 0.f;
#pragma unroll
        for (int e = 0; e < 8; ++e) { v[e] = gelu_tanh(v[e]); ss += v[e] * v[e]; }
        ss += __shfl_xor(ss, 1); ss += __shfl_xor(ss, 2); ss += __shfl_xor(ss, 4); ss += __shfl_xor(ss, 8);
        const float rstd = rsqrtf(ss * (1.f / 128.f) + EPS);
        const float* gp = sgn + 128 * g + 8 * ch;
        const f32x4 g0 = *(const f32x4*)gp, g1 = *(const f32x4*)(gp + 4);
        const float gg[8] = {g0.x, g0.y, g0.z, g0.w, g1.x, g1.y, g1.z, g1.w};
#pragma unroll
        for (int e = 0; e < 8; ++e) v[e] = v[e] * rstd * gg[e];
        *(LAS v4u*)(VN + t * LD128 + ch * 16) = pack8(v);
    }
    __syncthreads();
    f32x4 acc[8];
#pragma unroll
    for (int ct = 0; ct < 8; ++ct) acc[ct] = (f32x4){0.f, 0.f, 0.f, 0.f};
    const int nks = (w >> 1) + 1;
#pragma unroll
    for (int ks = 0; ks < 4; ++ks) {
        if (ks < nks) {
            const bf16x8 af = lds_row8(WM + (16 * w + c16) * LD128 + (32 * ks + 8 * g4) * 2);
            const LAS unsigned char* vb = VN + (32 * ks + 8 * g4 + q4) * LD128 + (4 * p4) * 2;
#pragma unroll
            for (int ct = 0; ct < 8; ++ct) {
                const bf16x8 bfr = cat8(lds_tr4(vb + ct * 32), lds_tr4(vb + 4 * LD128 + ct * 32));
                acc[ct] = MFMA16(bfr, af, acc[ct]);
            }
        }
    }
    const int t = 16 * w + c16; const float bias = sgb[g * 128 + t];
    const bf16* up = z + (R0 + t) * ZLD + ZC_AU + 128 * g + 4 * g4;
    bf16* yp = y + (R0 + t) * DM + YC_A + 128 * g + 4 * g4;
#pragma unroll
    for (int ct = 0; ct < 8; ++ct) {
        const v2u uw = *(const v2u*)(up + 16 * ct);
        const float u0 = gelu_tanh(bflo(uw.x)), u1 = gelu_tanh(bfhi(uw.x)), u2 = gelu_tanh(bflo(uw.y)), u3 = gelu_tanh(bfhi(uw.y));
        v2u o; o.x = pk2(u0 * (acc[ct][0] + bias), u1 * (acc[ct][1] + bias)); o.y = pk2(u2 * (acc[ct][2] + bias), u3 * (acc[ct][3] + bias));
        *(v2u*)(yp + 16 * ct) = o;
    }
    __syncthreads();
}

__device__ __forceinline__ void attn_unit(LAS unsigned char* lds, const bf16* __restrict__ z, const float* __restrict__ qgain, const float* __restrict__ kgain,
                                          const float* __restrict__ ropec, const float* __restrict__ ropes, bf16* __restrict__ og, float* __restrict__ lse,
                                          int ua, int tid, int w, int lane) {
    const int gi = ua / 1536; int rem = ua - gi * 1536;
    const int dil = (gi == 0) ? 1 : (gi == 1) ? 4 : 16, nblk = 64 / dil;
    const int b = rem / 384; rem -= b * 384; const int h = rem >> 6; rem &= 63;
    const int r = rem / nblk, nb = rem - r * nblk;
    const size_t rowbase = (size_t)b * SEQ;
    const int c16 = lane & 15, g4 = lane >> 4, q4 = c16 >> 2, p4 = lane & 3;
    LAS unsigned char* KS = lds; LAS unsigned char* VS = lds + 256 * LD128;
#pragma unroll 2
    for (int it = 0; it < 8; ++it) {
        const int c = tid + 512 * it, row = c >> 4, ch = c & 15;
        const int si = 128 * (nb - 1) + row; const bool ok = si >= 0;
        const int t = ok ? si * dil + r : 0;
        const bf16* zr = z + (rowbase + t) * ZLD + 128 * h + 8 * ch;
        v4u kw = *(const v4u*)(zr + ZC_BK), vw = *(const v4u*)(zr + ZC_BV);
        if (!ok) { kw = (v4u){0u, 0u, 0u, 0u}; vw = kw; }
        float kf[8]; unpack8(kw, kf); float ss = 0.f;
#pragma unroll
        for (int e = 0; e < 8; ++e) ss += kf[e] * kf[e];
        ss += __shfl_xor(ss, 1); ss += __shfl_xor(ss, 2); ss += __shfl_xor(ss, 4); ss += __shfl_xor(ss, 8);
        const float rstd = rsqrtf(ss * (1.f / 128.f) + EPS);
        const f32x4 g0 = *(const f32x4*)(kgain + 8 * ch), g1 = *(const f32x4*)(kgain + 8 * ch + 4);
        const float gg[8] = {g0.x, g0.y, g0.z, g0.w, g1.x, g1.y, g1.z, g1.w};
#pragma unroll
        for (int e = 0; e < 8; ++e) kf[e] = kf[e] * rstd * gg[e];
        float pr[8];
#pragma unroll
        for (int e = 0; e < 8; ++e) pr[e] = __shfl_xor(kf[e], 2);
        if (ch < 4) {
            const float* cp = ropec + t * 16 + 8 * (ch & 1); const float* sp = ropes + t * 16 + 8 * (ch & 1);
            const f32x4 c0 = *(const f32x4*)cp, c1 = *(const f32x4*)(cp + 4), s0 = *(const f32x4*)sp, s1 = *(const f32x4*)(sp + 4);
            const float cc[8] = {c0.x, c0.y, c0.z, c0.w, c1.x, c1.y, c1.z, c1.w}, sn[8] = {s0.x, s0.y, s0.z, s0.w, s1.x, s1.y, s1.z, s1.w};
            const float sg = (ch < 2) ? -1.f : 1.f;
#pragma unroll
            for (int e = 0; e < 8; ++e) kf[e] = kf[e] * cc[e] + sg * pr[e] * sn[e];
        }
        *(LAS v4u*)(KS + row * LD128 + ch * 16) = pack8(kf);
        *(LAS v4u*)(VS + row * LD128 + ch * 16) = vw;
    }
    const int qi = 16 * w + c16; const int tq = (128 * nb + qi) * dil + r;
    bf16x8 qf[4];
    {
        const bf16* zq = z + (rowbase + tq) * ZLD + ZC_BQ + 128 * h + 8 * g4;
        float qv[4][8]; float ss = 0.f;
#pragma unroll
        for (int ks = 0; ks < 4; ++ks) { const v4u qw = *(const v4u*)(zq + 32 * ks); unpack8(qw, qv[ks]);
#pragma unroll
            for (int e = 0; e < 8; ++e) ss += qv[ks][e] * qv[ks][e]; }
        ss += __shfl_xor(ss, 16); ss += __shfl_xor(ss, 32);
        const float rstd = rsqrtf(ss * (1.f / 128.f) + EPS);
#pragma unroll
        for (int ks = 0; ks < 4; ++ks) { const float* gp = qgain + 32 * ks + 8 * g4; const f32x4 g0 = *(const f32x4*)gp, g1 = *(const f32x4*)(gp + 4);
            const float gg[8] = {g0.x, g0.y, g0.z, g0.w, g1.x, g1.y, g1.z, g1.w};
#pragma unroll
            for (int e = 0; e < 8; ++e) qv[ks][e] = qv[ks][e] * rstd * gg[e]; }
        {
            const float* cp = ropec + tq * 16 + 8 * (g4 & 1); const float* sp = ropes + tq * 16 + 8 * (g4 & 1);
            const f32x4 c0 = *(const f32x4*)cp, c1 = *(const f32x4*)(cp + 4), s0 = *(const f32x4*)sp, s1 = *(const f32x4*)(sp + 4);
            const float cc[8] = {c0.x, c0.y, c0.z, c0.w, c1.x, c1.y, c1.z, c1.w}, sn[8] = {s0.x, s0.y, s0.z, s0.w, s1.x, s1.y, s1.z, s1.w};
            const float sg = (g4 < 2) ? -1.f : 1.f;
#pragma unroll
            for (int e = 0; e < 8; ++e) { const float pr = __shfl_xor(qv[0][e], 32); qv[0][e] = qv[0][e] * cc[e] + sg * pr * sn[e]; }
        }
#pragma unroll
        for (int ks = 0; ks < 4; ++ks) {
#pragma unroll
            for (int e = 0; e < 8; ++e) qv[ks][e] *= 0.08838834764831845f;
            qf[ks] = __builtin_bit_cast(bf16x8, pack8(qv[ks])); }
    }
    __syncthreads();
    f32x4 sc[9];
#pragma unroll
    for (int j = 0; j < 9; ++j) {
        sc[j] = (f32x4){0.f, 0.f, 0.f, 0.f};
        const LAS unsigned char* kp = KS + (16 * (w + j) + c16) * LD128 + 16 * g4;
#pragma unroll
        for (int ks = 0; ks < 4; ++ks) sc[j] = MFMA16(lds_row8(kp + 64 * ks), qf[ks], sc[j]);
    }
    float mx = -1e30f;
#pragma unroll
    for (int j = 0; j < 9; ++j)
#pragma unroll
        for (int e = 0; e < 4; ++e) { const int kj = 16 * (w + j) + 4 * g4 + e; const int dist = qi + 128 - kj;
            const bool valid = (dist >= 0) && (dist <= 128) && (nb > 0 || kj >= 128);
            sc[j][e] = valid ? sc[j][e] : -1e30f; mx = fmaxf(mx, sc[j][e]); }
    mx = fmaxf(mx, __shfl_xor(mx, 16)); mx = fmaxf(mx, __shfl_xor(mx, 32));
    float l = 0.f;
#pragma unroll
    for (int j = 0; j < 9; ++j)
#pragma unroll
        for (int e = 0; e < 4; ++e) { const float p = __expf(sc[j][e] - mx); sc[j][e] = p; l += p; }
    l += __shfl_xor(l, 16); l += __shfl_xor(l, 32);
    f32x4 oa[8];
#pragma unroll
    for (int ct = 0; ct < 8; ++ct) oa[ct] = (f32x4){0.f, 0.f, 0.f, 0.f};
#pragma unroll
    for (int s = 0; s < 5; ++s) {
        v4u pw; pw.x = pk2(sc[2 * s][0], sc[2 * s][1]); pw.y = pk2(sc[2 * s][2], sc[2 * s][3]);
        if (s < 4) { pw.z = pk2(sc[2 * s + 1][0], sc[2 * s + 1][1]); pw.w = pk2(sc[2 * s + 1][2], sc[2 * s + 1][3]); } else { pw.z = 0u; pw.w = 0u; }
        const bf16x8 pf = __builtin_bit_cast(bf16x8, pw);
        const int kt0 = w + 2 * s, kt1 = (w + 2 * s + 1 > 15) ? 15 : (w + 2 * s + 1);
        const LAS unsigned char* v0 = VS + (16 * kt0 + 4 * g4 + q4) * LD128 + 8 * p4;
        const LAS unsigned char* v1 = VS + (16 * kt1 + 4 * g4 + q4) * LD128 + 8 * p4;
#pragma unroll
        for (int ct = 0; ct < 8; ++ct) oa[ct] = MFMA16(cat8(lds_tr4(v0 + 32 * ct), lds_tr4(v1 + 32 * ct)), pf, oa[ct]);
    }
    const float inv = 1.0f / l;
    const size_t orow = (size_t)gi * M + rowbase + tq;
    bf16* op = og + orow * 768 + 128 * h + 4 * g4;
#pragma unroll
    for (int ct = 0; ct < 8; ++ct) { v2u o; o.x = pk2(oa[ct][0] * inv, oa[ct][1] * inv); o.y = pk2(oa[ct][2] * inv, oa[ct][3] * inv); *(v2u*)(op + 16 * ct) = o; }
    if (g4 == 0) lse[orow * 6 + h] = mx + __logf(l);
    __syncthreads();
}

__device__ __forceinline__ void gla_gates(LAS unsigned char* lds, const float* __restrict__ rb, const float* __restrict__ wg, const float* __restrict__ bg, int h, int w, int lane,
                                          float (&bl)[8], float& blast) {
    float wcol[16];
#pragma unroll
    for (int i = 0; i < 16; ++i) wcol[i] = wg[i * 384 + 64 * h + lane];
    const float bias = bg[64 * h + lane];
    const float r0 = rb[(8 * w) * 16 + lane], r1 = rb[(8 * w + 4) * 16 + lane];
    float run = 0.f;
#pragma unroll
    for (int it = 0; it < 8; ++it) {
        float x = bias;
#pragma unroll
        for (int i = 0; i < 16; ++i) x += __int_as_float(__builtin_amdgcn_readlane(__float_as_int(it < 4 ? r0 : r1), (it & 3) * 16 + i)) * wcol[i];
        const float la = (fminf(x, 0.f) - __logf(1.0f + __expf(-fabsf(x)))) * (1.f / 16.f);
        run += la; bl[it] = run;
    }
    LAS float* T = (LAS float*)lds;
    T[w * 64 + lane] = run;
    __syncthreads();
    float off = 0.f, tot = 0.f;
#pragma unroll
    for (int ww = 0; ww < 8; ++ww) { const float tv = T[ww * 64 + lane]; tot += tv; off += (ww < w) ? tv : 0.f; }
#pragma unroll
    for (int it = 0; it < 8; ++it) bl[it] += off;
    blast = tot;
}
__device__ __forceinline__ void gla_g1_unit(LAS unsigned char* lds, const bf16* __restrict__ z, const float* __restrict__ rbuf, const float* __restrict__ wg, const float* __restrict__ bg,
                                            float* __restrict__ UT, float* __restrict__ dec, int u1, int tid, int w, int lane) {
    const int h = u1 % 6, chunk = u1 / 6; const size_t R0 = (size_t)chunk * 64;
    const int c16 = lane & 15, g4 = lane >> 4, q4 = c16 >> 2, p4 = lane & 3;
    LAS unsigned char* KT = lds + 2048; LAS unsigned char* VS = KT + 64 * LD64;
    float bl[8], blast;
    gla_gates(lds, rbuf + R0 * 16, wg, bg, h, w, lane, bl, blast);
#pragma unroll
    for (int it = 0; it < 8; ++it) { const int j = 8 * w + it;
        const float kv = bf1(z[(R0 + j) * ZLD + ZC_CK + 64 * h + lane]);
        *(LAS bf16*)(KT + j * LD64 + lane * 2) = f2bf(kv * __expf(blast - bl[it])); }
    if (w == 0) dec[((size_t)chunk * 6 + h) * 64 + lane] = __expf(blast);
#pragma unroll
    for (int it = 0; it < 2; ++it) { const int c = tid + 512 * it, row = c >> 4, ch = c & 15;
        *(LAS v4u*)(VS + row * LD128 + ch * 16) = *(const v4u*)(z + (R0 + row) * ZLD + ZC_CV + 128 * h + 8 * ch); }
    __syncthreads();
    f32x4 acc[4];
#pragma unroll
    for (int kt = 0; kt < 4; ++kt) acc[kt] = (f32x4){0.f, 0.f, 0.f, 0.f};
#pragma unroll
    for (int ks = 0; ks < 2; ++ks) {
        const LAS unsigned char* vb = VS + (32 * ks + 8 * g4 + q4) * LD128 + (16 * w + 4 * p4) * 2;
        const bf16x8 af = cat8(lds_tr4(vb), lds_tr4(vb + 4 * LD128));
        const LAS unsigned char* kb = KT + (32 * ks + 8 * g4 + q4) * LD64 + (4 * p4) * 2;
#pragma unroll
        for (int kt = 0; kt < 4; ++kt) { const bf16x8 bfr = cat8(lds_tr4(kb + 32 * kt), lds_tr4(kb + 4 * LD64 + 32 * kt));
            acc[kt] = MFMA16(bfr, af, acc[kt]); }
    }
    float* up = UT + ((size_t)chunk * 6 + h) * 8192 + (16 * w + c16) * 64 + 4 * g4;
#pragma unroll
    for (int kt = 0; kt < 4; ++kt) *(f32x4*)(up + 16 * kt) = acc[kt];
    __syncthreads();
}
__device__ __forceinline__ void gla_scan(float* __restrict__ UT, const float* __restrict__ dec, int gtid, int ngt) {
    for (int e = gtid; e < BATCH * 6 * 8192; e += ngt) {
        const int kk = e & 63, hv = e >> 6; const int b = hv / (6 * 128), hvr = hv - b * (6 * 128); const int h = hvr >> 7;
        float* up = UT + (size_t)b * 128 * 6 * 8192 + (size_t)hvr * 64 + kk;
        const float* dp = dec + (size_t)b * 128 * 384 + h * 64 + kk;
        float st = 0.f;
        for (int n0 = 0; n0 < 128; n0 += 16) {
            float uv[16], dv[16];
#pragma unroll
            for (int i = 0; i < 16; ++i) { uv[i] = up[(size_t)(n0 + i) * 6 * 8192]; dv[i] = dp[(size_t)(n0 + i) * 384]; }
#pragma unroll
            for (int i = 0; i < 16; ++i) { up[(size_t)(n0 + i) * 6 * 8192] = st; st = dv[i] * st + uv[i]; }
        }
    }
}
__device__ __forceinline__ void gla_g3_unit(LAS unsigned char* lds, const bf16* __restrict__ z, const float* __restrict__ rbuf, const float* __restrict__ wg, const float* __restrict__ bg,
                                            const float* __restrict__ outg, const float* __restrict__ UT, bf16* __restrict__ y, int u3, int tid, int w, int lane) {
    const int h = u3 % 6, chunk = u3 / 6; const size_t R0 = (size_t)chunk * 64;
    const int c16 = lane & 15, g4 = lane >> 4, q4 = c16 >> 2, p4 = lane & 3;
    LAS unsigned char* QD = lds + 2048; LAS unsigned char* KD = QD + 64 * LD64; LAS unsigned char* VS = KD + 64 * LD64;
    LAS unsigned char* ST = VS + 64 * LD128; LAS unsigned char* AM = ST + 128 * LD64; LAS float* RS = (LAS float*)(AM + 64 * LD64);
    float bl[8], blast;
    gla_gates(lds, rbuf + R0 * 16, wg, bg, h, w, lane, bl, blast);
#pragma unroll
    for (int it = 0; it < 8; ++it) { const int j = 8 * w + it;
        const bf16* zr = z + (R0 + j) * ZLD + 64 * h + lane;
        const float qv = bf1(zr[ZC_CQ]), kv = bf1(zr[ZC_CK]);
        *(LAS bf16*)(QD + j * LD64 + lane * 2) = f2bf(qv * 0.125f * __expf(bl[it]));
        *(LAS bf16*)(KD + j * LD64 + lane * 2) = f2bf(kv * __expf(-bl[it])); }
#pragma unroll
    for (int it = 0; it < 2; ++it) { const int c = tid + 512 * it, row = c >> 4, ch = c & 15;
        *(LAS v4u*)(VS + row * LD128 + ch * 16) = *(const v4u*)(z + (R0 + row) * ZLD + ZC_CV + 128 * h + 8 * ch); }
    const float* sp = UT + ((size_t)chunk * 6 + h) * 8192;
#pragma unroll
    for (int it = 0; it < 4; ++it) { const int c = tid + 512 * it, v = c >> 4, kc = c & 15;
        const f32x4 s4 = *(const f32x4*)(sp + v * 64 + 4 * kc);
        v2u o; o.x = pk2(s4.x, s4.y); o.y = pk2(s4.z, s4.w);
        *(LAS v2u*)(ST + v * LD64 + kc * 8) = o; }
    __syncthreads();
    {
        const int it = w >> 1;
#pragma unroll
        for (int jj = 0; jj < 2; ++jj) { const int jt = 2 * (w & 1) + jj;
            f32x4 a = (f32x4){0.f, 0.f, 0.f, 0.f};
            if (jt <= it) {
#pragma unroll
                for (int ks = 0; ks < 2; ++ks) a = MFMA16(lds_row8(KD + (16 * jt + c16) * LD64 + (32 * ks + 8 * g4) * 2), lds_row8(QD + (16 * it + c16) * LD64 + (32 * ks + 8 * g4) * 2), a);
            }
            const int i = 16 * it + c16, j0 = 16 * jt + 4 * g4;
            v2u o; o.x = pk2(j0 <= i ? a[0] : 0.f, j0 + 1 <= i ? a[1] : 0.f); o.y = pk2(j0 + 2 <= i ? a[2] : 0.f, j0 + 3 <= i ? a[3] : 0.f);
            *(LAS v2u*)(AM + i * LD64 + j0 * 2) = o; }
    }
    __syncthreads();
    const int it = w & 3, vh = w >> 2;
    f32x4 acc[4];
#pragma unroll
    for (int c4 = 0; c4 < 4; ++c4) acc[c4] = (f32x4){0.f, 0.f, 0.f, 0.f};
#pragma unroll
    for (int ks = 0; ks < 2; ++ks) {
        if (ks == 0 || it >= 2) {
            const bf16x8 af = lds_row8(AM + (16 * it + c16) * LD64 + (32 * ks + 8 * g4) * 2);
            const LAS unsigned char* vb = VS + (32 * ks + 8 * g4 + q4) * LD128 + (64 * vh + 4 * p4) * 2;
#pragma unroll
            for (int c4 = 0; c4 < 4; ++c4) acc[c4] = MFMA16(cat8(lds_tr4(vb + 32 * c4), lds_tr4(vb + 4 * LD128 + 32 * c4)), af, acc[c4]);
        }
    }
#pragma unroll
    for (int ks = 0; ks < 2; ++ks) {
        const bf16x8 af = lds_row8(QD + (16 * it + c16) * LD64 + (32 * ks + 8 * g4) * 2);
#pragma unroll
        for (int c4 = 0; c4 < 4; ++c4) acc[c4] = MFMA16(lds_row8(ST + (64 * vh + 16 * c4 + c16) * LD64 + (32 * ks + 8 * g4) * 2), af, acc[c4]);
    }
    float ss = 0.f;
#pragma unroll
    for (int c4 = 0; c4 < 4; ++c4) ss += (acc[c4][0] * acc[c4][0] + acc[c4][1] * acc[c4][1]) + (acc[c4][2] * acc[c4][2] + acc[c4][3] * acc[c4][3]);
    ss += __shfl_xor(ss, 16); ss += __shfl_xor(ss, 32);
    const int i = 16 * it + c16;
    if (g4 == 0) RS[i * 2 + vh] = ss;
    __syncthreads();
    const float rstd = rsqrtf((RS[i * 2] + RS[i * 2 + 1]) * (1.f / 128.f) + EPS);
    const bf16* gp = z + (R0 + i) * ZLD + ZC_CG + 128 * h + 64 * vh + 4 * g4;
    bf16* yp = y + (R0 + i) * DM + YC_C + 128 * h + 64 * vh + 4 * g4;
    const float* ogp = outg + 64 * vh + 4 * g4;
#pragma unroll
    for (int c4 = 0; c4 < 4; ++c4) {
        const v2u gw = *(const v2u*)(gp + 16 * c4); const f32x4 og4 = *(const f32x4*)(ogp + 16 * c4);
        v2u o; o.x = pk2(acc[c4][0] * rstd * og4.x * silu_f(bflo(gw.x)), acc[c4][1] * rstd * og4.y * silu_f(bfhi(gw.x)));
        o.y = pk2(acc[c4][2] * rstd * og4.z * silu_f(bflo(gw.y)), acc[c4][3] * rstd * og4.w * silu_f(bfhi(gw.y)));
        *(v2u*)(yp + 16 * c4) = o;
    }
    __syncthreads();
}
__device__ __forceinline__ void attn_merge(const bf16* __restrict__ og, const float* __restrict__ lse, bf16* __restrict__ y, int gtid, int ngt) {
    for (int idx = gtid; idx < M * 96; idx += ngt) {
        const int row = idx / 96, cc = idx - row * 96, h = cc >> 4;
        const float l0 = lse[(size_t)row * 6 + h], l1 = lse[((size_t)M + row) * 6 + h], l2 = lse[((size_t)2 * M + row) * 6 + h];
        const float mx = fmaxf(l0, fmaxf(l1, l2));
        float w0 = __expf(l0 - mx), w1 = __expf(l1 - mx), w2 = __expf(l2 - mx);
        const float inv = 1.0f / (w0 + w1 + w2); w0 *= inv; w1 *= inv; w2 *= inv;
        float a[8], b[8], c[8];
        unpack8(*(const v4u*)(og + (size_t)row * 768 + 8 * cc), a);
        unpack8(*(const v4u*)(og + ((size_t)M + row) * 768 + 8 * cc), b);
        unpack8(*(const v4u*)(og + ((size_t)2 * M + row) * 768 + 8 * cc), c);
#pragma unroll
        for (int e = 0; e < 8; ++e) a[e] = w0 * a[e] + w1 * b[e] + w2 * c[e];
        *(v4u*)(y + (size_t)row * DM + YC_B + 8 * cc) = pack8(a);
    }
}

#ifndef DBG_MASK
#define DBG_MASK 0xFFFF
#endif
#define PH(b) if constexpr ((DBG_MASK >> (b)) & 1)
typedef const __attribute__((address_space(4))) Args* ArgP;
#define PHASE_BEGIN() ArgP ap = (ArgP)__builtin_amdgcn_kernarg_segment_ptr(); asm volatile("" : "+s"(ap)); \
    unsigned char* const ws = ap->ws; int tid = threadIdx.x; asm volatile("" : "+v"(tid)); \
    const int lane = tid & 63, wave = __builtin_amdgcn_readfirstlane(tid >> 6), G = gridDim.x, bx = blockIdx.x; \
    const int gw = bx * NWAVES + wave, ngw = G * NWAVES, gtid = bx * (NWAVES * 64) + tid, ngt = G * NWAVES * 64; \
    (void)ws; (void)lane; (void)wave; (void)gw; (void)ngw; (void)gtid; (void)ngt; \
    LAS unsigned char* lds = (LAS unsigned char*)lds_raw

__global__ void __launch_bounds__(NWAVES * 64, 2) hymba_fwd(Args args) {
    extern __shared__ __attribute__((aligned(16))) unsigned char lds_raw[];
    {
        LAS unsigned char* lds0 = (LAS unsigned char*)lds_raw;
        for (int u = threadIdx.x; u < (LDS_BYTES - LDSCTL_OFF) / 4; u += NWAVES * 64) ((LAS unsigned*)(lds0 + LDSCTL_OFF))[u] = 0u;
    }
    __syncthreads();
    XcdBarrier bar = xcd_barrier_post((unsigned*)(args.ws + WS_CTL) + CW_BAR, (volatile LAS unsigned*)((LAS unsigned char*)lds_raw + LDSCTL_OFF) + 8);
#define GRID_BAR() xcd_barrier(bar)

    PH(0) { PHASE_BEGIN(); prologue(ap, ws, lds, gw, ngw, wave, lane, gtid, ngt); }
    GRID_BAR();

    for (int s = 0; s < 3 * DEPTH; ++s) {
        const int l = s / 3, k = s - 3 * l, f = k >> 1;
        PH(1) { PHASE_BEGIN();
            const float* xin = (s == 0) ? ap->in[0] : ap->out;
            const float* gain = (k == 1) ? ap->in[5] + (size_t)l * DM : ap->in[1] + (size_t)(l * 2 + f) * DM;
            norm_phase(xin, gain, (bf16*)(ws + WS_H), gw, ngw, lane); }
        GRID_BAR();
        if (k != 1) {
            PH(2) { PHASE_BEGIN();
                const bf16* Bt = (const bf16*)(ws + WS_W + (size_t)l * W_LAYER + (f ? WL_GU1 : WL_GU0));
                pg8::Gemm g{(const bf16*)(ws + WS_H), Bt, M, 2 * DFF, DM}; pg8::StaticOrder S; S.init(M, 2 * DFF, G, bx);
                pg8::EpiSwiGLU E{(bf16*)(ws + WS_HZ), DFF};
                pg8::gemm_phase<pg8::EpiSwiGLU, pg8::StaticOrder, true, true>(lds, g, S, E); }
        } else {
            PH(4) { PHASE_BEGIN();
                const bf16* Bt = (const bf16*)(ws + WS_W + (size_t)l * W_LAYER + WL_IN);
                pg8::Gemm g{(const bf16*)(ws + WS_H), Bt, M, NINP, DM}; pg8::StaticOrder S; S.init(M, NINP, G, bx);
                pg8::EpiZ E{(bf16*)(ws + WS_HZ), ZLD, (float*)(ws + WS_R), NZ / 256};
                pg8::gemm_phase<pg8::EpiZ, pg8::StaticOrder, true, true>(lds, g, S, E); }
            GRID_BAR();
            for (int u = blockIdx.x; u < 4608 + 3072 + 1024; u += gridDim.x) {
                if (u < 4608) { PH(5) { PHASE_BEGIN();
                    const float* ropec = (const float*)(ws + WS_ROPE);
                    attn_unit(lds, (const bf16*)(ws + WS_HZ), ap->in[10] + (size_t)l * 128, ap->in[11] + (size_t)l * 128, ropec, ropec + SEQ * 16, (bf16*)(ws + WS_OG), (float*)(ws + WS_LSE), u, tid, wave, lane); } }
                else if (u < 4608 + 3072) { PH(6) { PHASE_BEGIN();
                    gla_g1_unit(lds, (const bf16*)(ws + WS_HZ), (const float*)(ws + WS_R), ap->in[12] + (size_t)l * 16 * 384, ap->in[13] + (size_t)l * 384, (float*)(ws + WS_H), (float*)(ws + WS_DEC), u - 4608, tid, wave, lane); } }
                else { PH(7) { PHASE_BEGIN();
                    gmlp_unit(lds, (const bf16*)(ws + WS_HZ), ap->in[8] + (size_t)l * 4 * 128 * 128, ap->in[9] + (size_t)l * 512, ap->in[7] + (size_t)l * 512, (bf16*)(ws + WS_Y), u - (4608 + 3072), tid, wave, lane); } }
            }
            GRID_BAR();
            PH(8) { PHASE_BEGIN(); gla_scan((float*)(ws + WS_H), (const float*)(ws + WS_DEC), gtid, ngt); }
            GRID_BAR();
            for (int u = blockIdx.x; u < 3072; u += gridDim.x) { PH(9) { PHASE_BEGIN();
                gla_g3_unit(lds, (const bf16*)(ws + WS_HZ), (const float*)(ws + WS_R), ap->in[12] + (size_t)l * 16 * 384, ap->in[13] + (size_t)l * 384, ap->in[14] + (size_t)l * 128,
                            (const float*)(ws + WS_H), (bf16*)(ws + WS_Y), u, tid, wave, lane); } }
            PH(10) { PHASE_BEGIN(); attn_merge((const bf16*)(ws + WS_OG), (const float*)(ws + WS_LSE), (bf16*)(ws + WS_Y), gtid, ngt); }
        }
        GRID_BAR();
        PH(3) { PHASE_BEGIN();
            const float* xin = (s == 0) ? ap->in[0] : ap->out;
            const unsigned char* wl = ws + WS_W + (size_t)l * W_LAYER;
            const bf16* A = (k == 1) ? (const bf16*)(ws + WS_Y) : (const bf16*)(ws + WS_HZ);
            const bf16* Bt = (const bf16*)(wl + ((k == 1) ? WL_OUT : (f ? WL_D1 : WL_D0)));
            pg8::Gemm g{A, Bt, M, DM, (k == 1) ? DM : DFF}; pg8::StaticOrder S; S.init(M, DM, G, bx);
            pg8::EpiResid E{xin, ap->out, DM, (k == 1) ? 1.0f : 0.5f};
            pg8::gemm_phase<pg8::EpiResid, pg8::StaticOrder, true, true>(lds, g, S, E); }
        GRID_BAR();
    }
}

extern "C" void kernel_launch(void* const* d_in, const int* in_sizes, int n_in, void* d_out, int out_size, void* d_ws, size_t ws_size, hipStream_t stream) {
    static int grid = 0;
    if (grid == 0) {
        if (n_in != 16 || in_sizes[0] != M * DM || out_size != M * DM || ws_size < WS_END) { fprintf(stderr, "kernel_launch: shape/workspace mismatch (n_in %d, ws %zu, need %zu)\n", n_in, ws_size, (size_t)WS_END); grid = -1; return; }
        int dev = 0, cus = 0, per_cu = 0;
        if (hipGetDevice(&dev) != hipSuccess || hipDeviceGetAttribute(&cus, hipDeviceAttributeMultiprocessorCount, dev) != hipSuccess) { grid = -1; return; }
        if (hipFuncSetAttribute((const void*)hymba_fwd, hipFuncAttributeMaxDynamicSharedMemorySize, LDS_BYTES) != hipSuccess) { fprintf(stderr, "kernel_launch: hipFuncSetAttribute failed\n"); grid = -1; return; }
        if (hipOccupancyMaxActiveBlocksPerMultiprocessor(&per_cu, (const void*)hymba_fwd, NWAVES * 64, LDS_BYTES) != hipSuccess || per_cu < 1) fprintf(stderr, "kernel_launch: occupancy query says %d\n", per_cu);
        (void)hipGetLastError();
        grid = cus;
    }
    if (grid < 0) return;
    if (hipMemsetAsync((char*)d_ws + WS_CTL, 0, CTL_ZERO_BYTES, stream) != hipSuccess) return;
    Args a{};
    for (int i = 0; i < 16; ++i) a.in[i] = (const float*)d_in[i];
    a.out = (float*)d_out; a.ws = (unsigned char*)d_ws;
    for (int i = 0; i < 16; ++i) a.inv_freq[i] = (float)std::pow(500000.0, -(double)i / 16.0);
    hipLaunchKernelGGL(hymba_fwd, dim3(grid), dim3(NWAVES * 64), LDS_BYTES, stream, a);
}
```

```cpp
#include <hip/hip_runtime.h>
#include <cstdio>
#include <cstdint>
#include <cmath>
namespace pg8 {
#define PG8_LAS __attribute__((address_space(3)))
typedef unsigned short bf16_t;
typedef short bf16x8 __attribute__((ext_vector_type(8)));
typedef float f32x4 __attribute__((ext_vector_type(4)));
typedef unsigned u32x4 __attribute__((ext_vector_type(4)));
constexpr int BM = 256, BK = 64, HALF = 128, HTB = HALF * BK * 2  , STAGE_BYTES = 8 * HTB, NXCD = 8, WGM = 8;

__host__ __device__ __forceinline__ int lds_byte(int r, int c) { const int st = (r >> 4) * 2 + (c >> 5), rr = r & 15, cc = c & 31, ob = rr * 64 + cc * 2; return st * 1024 + (ob ^ (((ob >> 9) & 1) << 5)); }
__host__ __device__ __forceinline__ void stage_rc(int b, int& R, int& C) { const int st = b / 1024, sb = b % 1024, swz = sb ^ (((sb >> 9) & 1) << 5); R = (st >> 1) * 16 + swz / 64; C = (st & 1) * 32 + (swz % 64) / 2; }
__host__ __device__ __forceinline__ int perm32(int rho) { const int n = rho >> 4, i = rho & 15; return 8 * (i >> 2) + 4 * n + (i & 3); }

struct Unit { int pm, pn; };
struct Gemm { const bf16_t* A; const bf16_t* Bt; int M, N, K; };

struct StaticOrder {
    int nM, nN, nwg, G, c;
    __host__ __device__ void init(int M, int N, int G_, int c_) { nM = M / BM; nN = N / BM; nwg = nM * nN; G = G_; c = c_; }
    __host__ __device__ bool next(int i, Unit& u) const {
        const long L = (long)i * G + c; if (L >= nwg) return false;
        int wgid = (int)L; { const int q = nwg / NXCD, r = nwg % NXCD, xcd = wgid % NXCD, off = wgid / NXCD; wgid = (xcd < r ? xcd * (q + 1) : r * (q + 1) + (xcd - r) * q) + off; }
        const int nig = WGM * nN, gid = wgid / nig, fm = gid * WGM, gsz = (nM - fm) < WGM ? (nM - fm) : WGM;
        u.pm = fm + ((wgid % nig) % gsz); u.pn = (wgid % nig) / gsz; return true;
    }
    __device__ __forceinline__ void a_ready(const Unit&) const {}
    __device__ __forceinline__ void done(const Unit&) const {}
};
__device__ __forceinline__ unsigned cvt_pk_bf16(float lo, float hi) { unsigned r; asm volatile("v_cvt_pk_bf16_f32 %0, %1, %2" : "=v"(r) : "v"(lo), "v"(hi)); return r; }
typedef float f32x2 __attribute__((ext_vector_type(2)));
template <class Epi, class Sched, bool ALIGN_EPI = false, bool SP2 = false>
__device__ __forceinline__ void gemm_phase(PG8_LAS unsigned char* lds, const Gemm g, const Sched& S, const Epi& E) {
    int tid_l = threadIdx.x; asm volatile("" : "+v"(tid_l));
    const int tid = tid_l, wid = __builtin_amdgcn_readfirstlane(tid >> 6), lane = tid & 63, wr = wid >> 2, wc = wid & 3, fr = lane & 15, fq = lane >> 4;
    const int K = g.K, nt = K / BK;
    unsigned voffA[2], voffB[2];
#pragma unroll
    for (int i = 0; i < 2; ++i) { int R, C; stage_rc(tid * 16 + i * 8192, R, C); const int Rb = Epi::PERM ? ((R & ~31) + perm32(R & 31)) : R;
        voffA[i] = (unsigned)(R * K + C) * 2u; voffB[i] = (unsigned)(Rb * K + C) * 2u; }
    const size_t kstep = (size_t)(BK * 2);
    const size_t hstep = (size_t)HALF * K * 2;
    const size_t tstep = 2 * hstep;
    const unsigned ldsw = (unsigned)wid * 1024u;
    const int aoff = lds_byte(wr * 64 + fr, fq * 8), boff = lds_byte(wc * 32 + fr, fq * 8);
#define PG8_SA(b, h) (((b) * 2 + (h)) * HTB)
#define PG8_SB(b, h) ((4 + (b) * 2 + (h)) * HTB)
#define PG8_STAGE(bufoff, gbase, voff) do { _Pragma("unroll") for (int _i = 0; _i < 2; ++_i) \
        __builtin_amdgcn_global_load_lds((const unsigned*)((const char*)(gbase) + (voff)[_i]), (PG8_LAS unsigned*)(lds + (bufoff) + ldsw + _i * 8192), 16, 0, 0); } while (0)
#define PG8_LDA(dst, b, h) do { _Pragma("unroll") for (int m = 0; m < 4; ++m) _Pragma("unroll") for (int k = 0; k < 2; ++k) dst[m][k] = *(const PG8_LAS bf16x8*)(lds + PG8_SA(b, h) + aoff + m * 2048 + k * 1024); } while (0)
#define PG8_LDB(dst, b, h) do { _Pragma("unroll") for (int n = 0; n < 2; ++n) _Pragma("unroll") for (int k = 0; k < 2; ++k) dst[n][k] = *(const PG8_LAS bf16x8*)(lds + PG8_SB(b, h) + boff + n * 2048 + k * 1024); } while (0)
#define PG8_MMA(ai, bj, At, Bt) do { __builtin_amdgcn_s_setprio(1); _Pragma("unroll") for (int m = 0; m < 4; ++m) _Pragma("unroll") for (int n = 0; n < 2; ++n) _Pragma("unroll") for (int k = 0; k < 2; ++k) \
        acc[ai][bj][m][n] = __builtin_amdgcn_mfma_f32_16x16x32_bf16(Bt[n][k], At[m][k], acc[ai][bj][m][n], 0, 0, 0); __builtin_amdgcn_s_setprio(0); } while (0)
#define PG8_WAIT_V(n) asm volatile("s_waitcnt vmcnt(" #n ")" ::: "memory")
#define PG8_WAIT_L(n) asm volatile("s_waitcnt lgkmcnt(" #n ")" ::: "memory")
#define PG8_BAR __builtin_amdgcn_s_barrier()
#define PG8_SCHED __builtin_amdgcn_sched_barrier(0)
    Unit cur, nxt; int ui = 0;
    if (!S.next(0, cur)) return;
    f32x4 acc[2][2][4][2];
#pragma unroll
    for (int a = 0; a < 2; ++a)
#pragma unroll
        for (int b = 0; b < 2; ++b)
#pragma unroll
            for (int m = 0; m < 4; ++m)
#pragma unroll
                for (int n = 0; n < 2; ++n) acc[a][b][m][n] = (f32x4){0.f, 0.f, 0.f, 0.f};
    bf16x8 At[4][2], B0[2][2], B1[2][2];
    const char* cA = (const char*)g.A + (size_t)cur.pm * tstep; const char* cB = (const char*)g.Bt + (size_t)cur.pn * tstep;
    S.a_ready(cur);
    if constexpr (SP2) {
        PG8_STAGE(PG8_SB(0, 0), cB, voffB); PG8_STAGE(PG8_SB(0, 1), cB + hstep, voffB); PG8_STAGE(PG8_SA(0, 0), cA, voffA); PG8_STAGE(PG8_SA(0, 1), cA + hstep, voffA);
        if (wr == 1) PG8_BAR;
        PG8_WAIT_V(2); PG8_BAR;
        PG8_STAGE(PG8_SB(1, 0), cB + kstep, voffB); PG8_STAGE(PG8_SA(1, 0), cA + kstep, voffA); PG8_STAGE(PG8_SB(1, 1), cB + hstep + kstep, voffB);
        PG8_WAIT_V(6); PG8_BAR;
    } else {
        PG8_STAGE(PG8_SB(0, 0), cB, voffB); PG8_STAGE(PG8_SA(0, 0), cA, voffA); PG8_STAGE(PG8_SB(0, 1), cB + hstep, voffB); PG8_STAGE(PG8_SA(0, 1), cA + hstep, voffA);
        if (wr == 1) PG8_BAR;
        PG8_WAIT_V(4); PG8_BAR;
        PG8_STAGE(PG8_SB(1, 0), cB + kstep, voffB); PG8_STAGE(PG8_SA(1, 0), cA + kstep, voffA); PG8_STAGE(PG8_SB(1, 1), cB + hstep + kstep, voffB);
        PG8_WAIT_V(6); PG8_BAR;
    }
    for (;;) {
        const bool has_next = S.next(ui + 1, nxt);
        const char* nA = has_next ? (const char*)g.A + (size_t)nxt.pm * tstep : cA; const char* nB = has_next ? (const char*)g.Bt + (size_t)nxt.pn * tstep : cB;
        for (int t = 0; t < nt; t += 2) {
            const bool last = (t == nt - 2);
            const char* a1 = cA + (size_t)(t + 1) * kstep;
            const char* a2 = last ? nA : cA + (size_t)(t + 2) * kstep; const char* b2 = last ? nB : cB + (size_t)(t + 2) * kstep;
            const char* a3 = a2 + kstep; const char* b3 = b2 + kstep;
            if (last && has_next) S.a_ready(nxt);
            if constexpr (SP2) {
            PG8_LDB(B0, 0, 0); PG8_LDB(B1, 0, 1); PG8_SCHED; PG8_LDA(At, 0, 0); PG8_STAGE(PG8_SA(1, 1), a1 + hstep, voffA);
            PG8_WAIT_V(8); PG8_WAIT_L(0); PG8_BAR; PG8_MMA(0, 0, At, B0); PG8_MMA(0, 1, At, B1); PG8_BAR; PG8_SCHED;
            PG8_LDA(At, 0, 1); PG8_STAGE(PG8_SB(0, 0), b2, voffB); PG8_STAGE(PG8_SB(0, 1), b2 + hstep, voffB); PG8_STAGE(PG8_SA(0, 0), a2, voffA);
            PG8_WAIT_V(8); PG8_WAIT_L(0); PG8_BAR; PG8_MMA(1, 0, At, B0); PG8_MMA(1, 1, At, B1); PG8_BAR; PG8_SCHED;
            PG8_LDB(B0, 1, 0); PG8_LDB(B1, 1, 1); PG8_SCHED; PG8_LDA(At, 1, 0); PG8_STAGE(PG8_SA(0, 1), a2 + hstep, voffA);
            PG8_WAIT_V(8); PG8_WAIT_L(0); PG8_BAR; PG8_MMA(0, 0, At, B0); PG8_MMA(0, 1, At, B1); PG8_BAR; PG8_SCHED;
            PG8_LDA(At, 1, 1); PG8_STAGE(PG8_SB(1, 0), b3, voffB); PG8_STAGE(PG8_SB(1, 1), b3 + hstep, voffB); PG8_STAGE(PG8_SA(1, 0), a3, voffA);
            PG8_WAIT_V(8); PG8_WAIT_L(0); PG8_BAR; PG8_MMA(1, 0, At, B0); PG8_MMA(1, 1, At, B1); PG8_BAR; PG8_SCHED;
            } else {
            PG8_LDB(B0, 0, 0); PG8_SCHED; PG8_LDA(At, 0, 0); PG8_STAGE(PG8_SA(1, 1), a1 + hstep, voffA);
            PG8_WAIT_L(8); PG8_BAR; PG8_WAIT_L(0); PG8_MMA(0, 0, At, B0); PG8_BAR; PG8_SCHED;
            PG8_LDB(B1, 0, 1); PG8_STAGE(PG8_SB(0, 0), b2, voffB);
            PG8_BAR; PG8_WAIT_L(0); PG8_MMA(0, 1, At, B1); PG8_BAR;
            PG8_LDA(At, 0, 1); PG8_STAGE(PG8_SA(0, 0), a2, voffA);
            PG8_BAR; PG8_WAIT_L(0); PG8_MMA(1, 0, At, B0); PG8_BAR; PG8_SCHED;
            PG8_STAGE(PG8_SB(0, 1), b2 + hstep, voffB);
            PG8_WAIT_V(6); PG8_BAR; PG8_MMA(1, 1, At, B1); PG8_BAR;
            PG8_LDB(B0, 1, 0); PG8_SCHED; PG8_LDA(At, 1, 0); PG8_STAGE(PG8_SA(0, 1), a2 + hstep, voffA);
            PG8_WAIT_L(8); PG8_BAR; PG8_WAIT_L(0); PG8_MMA(0, 0, At, B0); PG8_BAR; PG8_SCHED;
            PG8_LDB(B1, 1, 1); PG8_STAGE(PG8_SB(1, 0), b3, voffB);
            PG8_BAR; PG8_WAIT_L(0); PG8_MMA(0, 1, At, B1); PG8_BAR;
            PG8_LDA(At, 1, 1); PG8_STAGE(PG8_SA(1, 0), a3, voffA);
            PG8_BAR; PG8_WAIT_L(0); PG8_MMA(1, 0, At, B0); PG8_BAR; PG8_SCHED;
            PG8_STAGE(PG8_SB(1, 1), b3 + hstep, voffB);
            PG8_WAIT_V(6); PG8_BAR; PG8_MMA(1, 1, At, B1); PG8_BAR;
            }
        }
        if constexpr (ALIGN_EPI) { if (wr == 0) PG8_BAR; }
        if constexpr (!Epi::AFTER_DRAIN) { E(acc, cur, wr, wc, fr, fq); S.done(cur); }
        if (!has_next) break;
#pragma unroll
        for (int a = 0; a < 2; ++a)
#pragma unroll
            for (int b = 0; b < 2; ++b)
#pragma unroll
                for (int m = 0; m < 4; ++m)
#pragma unroll
                    for (int n = 0; n < 2; ++n) acc[a][b][m][n] = (f32x4){0.f, 0.f, 0.f, 0.f};
        cur = nxt; cA = nA; cB = nB; ++ui;
        if constexpr (ALIGN_EPI) { if (wr == 1) PG8_BAR; }
    }
    PG8_WAIT_V(0);
    if constexpr (!ALIGN_EPI) { if (wr == 0) PG8_BAR; }
    PG8_BAR;
    if constexpr (Epi::AFTER_DRAIN) { E.fused(acc, cur, wr, wc, fr, fq, lds, wid, lane); S.done(cur); }
#undef PG8_SA
#undef PG8_SB
#undef PG8_STAGE
#undef PG8_LDA
#undef PG8_LDB
#undef PG8_MMA
#undef PG8_WAIT_V
#undef PG8_WAIT_L
#undef PG8_BAR
#undef PG8_SCHED
}
}
namespace pg8 {
struct EpiSwiGLU {
    static constexpr bool PERM = true, AFTER_DRAIN = false;
    bf16_t* O; int ldc;
    __device__ __forceinline__ void operator()(const f32x4 (&acc)[2][2][4][2], const Unit& u, int wr, int wc, int fr, int fq) const {
        const int row0 = u.pm * BM + wr * 64 + fr, col0 = u.pn * HALF + wc * 32 + 8 * fq;
#pragma unroll
        for (int ai = 0; ai < 2; ++ai)
#pragma unroll
            for (int m = 0; m < 4; ++m) { bf16_t* rowp = O + (size_t)(row0 + ai * HALF + m * 16) * ldc + col0;
                float h[8];
#pragma unroll
                for (int n = 0; n < 2; ++n)
#pragma unroll
                    for (int j = 0; j < 4; ++j) { const float g = acc[ai][0][m][n][j], up = acc[ai][1][m][n][j];
                        h[4 * n + j] = g * __builtin_amdgcn_rcpf(1.0f + __expf(-g)) * up; }
                u32x4 w; w.x = cvt_pk_bf16(h[0], h[1]); w.y = cvt_pk_bf16(h[2], h[3]); w.z = cvt_pk_bf16(h[4], h[5]); w.w = cvt_pk_bf16(h[6], h[7]);
                *(u32x4*)rowp = w; }
    }
};
struct EpiResid {
    static constexpr bool PERM = false, AFTER_DRAIN = false;
    const float* base; float* out; int ldc; float scale;
    __device__ __forceinline__ void operator()(const f32x4 (&acc)[2][2][4][2], const Unit& u, int wr, int wc, int fr, int fq) const {
        const int row0 = u.pm * BM + wr * 64 + fr, col0 = u.pn * BM + wc * 32 + 4 * fq;
#pragma unroll
        for (int ai = 0; ai < 2; ++ai) {
            f32x4 bs[4][2][2];
#pragma unroll
            for (int m = 0; m < 4; ++m) { const size_t off = (size_t)(row0 + ai * HALF + m * 16) * ldc + col0;
#pragma unroll
                for (int bj = 0; bj < 2; ++bj)
#pragma unroll
                    for (int n = 0; n < 2; ++n) bs[m][bj][n] = *(const f32x4*)(base + off + bj * HALF + n * 16); }
#pragma unroll
            for (int m = 0; m < 4; ++m) { const size_t off = (size_t)(row0 + ai * HALF + m * 16) * ldc + col0;
#pragma unroll
                for (int bj = 0; bj < 2; ++bj)
#pragma unroll
                    for (int n = 0; n < 2; ++n) *(f32x4*)(out + off + bj * HALF + n * 16) = bs[m][bj][n] + acc[ai][bj][m][n] * scale; }
            asm volatile("" ::: "memory");
        }
    }
};
struct EpiZ {
    static constexpr bool PERM = true, AFTER_DRAIN = false;
    bf16_t* Z; int ldz; float* R; int nz_tiles;
    __device__ __forceinline__ void operator()(const f32x4 (&acc)[2][2][4][2], const Unit& u, int wr, int wc, int fr, int fq) const {
        const int row0 = u.pm * BM + wr * 64 + fr;
        if (u.pn < nz_tiles) {
            const int col0 = u.pn * BM + wc * 32 + 8 * fq;
#pragma unroll
            for (int ai = 0; ai < 2; ++ai)
#pragma unroll
                for (int m = 0; m < 4; ++m) { bf16_t* rowp = Z + (size_t)(row0 + ai * HALF + m * 16) * ldz + col0;
#pragma unroll
                    for (int bj = 0; bj < 2; ++bj) { const f32x4 v0 = acc[ai][bj][m][0], v1 = acc[ai][bj][m][1];
                        u32x4 w; w.x = cvt_pk_bf16(v0[0], v0[1]); w.y = cvt_pk_bf16(v0[2], v0[3]); w.z = cvt_pk_bf16(v1[0], v1[1]); w.w = cvt_pk_bf16(v1[2], v1[3]);
                        *(u32x4*)(rowp + bj * HALF) = w; } }
        } else if (wc == 0 && fq < 2) {
#pragma unroll
            for (int ai = 0; ai < 2; ++ai)
#pragma unroll
                for (int m = 0; m < 4; ++m) { float* rp = R + (size_t)(row0 + ai * HALF + m * 16) * 16 + 8 * fq;
                    *(f32x4*)rp = acc[ai][0][m][0]; *(f32x4*)(rp + 4) = acc[ai][0][m][1]; }
        }
    }
};
}
constexpr int NWAVES = 8;
constexpr int BATCH = 4, SEQ = 8192, DM = 2048, DFF = 5632, DEPTH = 4;
constexpr int M = BATCH * SEQ;
constexpr int NIN = 5648, NZ = 5632, NINP = 5888;
constexpr int ZLD = NZ;
constexpr int ZC_AU = 0, ZC_AV = 512, ZC_BQ = 1024, ZC_BK = 1792, ZC_BV = 2560, ZC_CQ = 3328, ZC_CK = 3712, ZC_CV = 4096, ZC_CG = 4864;
constexpr int YC_A = 0, YC_B = 512, YC_C = 1280;
constexpr int NCHUNK = M / 64;
constexpr float EPS = 1e-6f;

constexpr size_t MiB = 1u << 20;
constexpr size_t WS_CTL = 0, CTL_ZERO_BYTES = 1 * MiB;
constexpr size_t WS_ROPE = 1 * MiB;
constexpr size_t WS_R = 2 * MiB;
constexpr size_t WS_DEC = 4 * MiB;
constexpr size_t WS_LSE = 5 * MiB;
constexpr size_t WS_W = 8 * MiB;
constexpr size_t W_GU = (size_t)2 * DFF * DM * 2, W_D = (size_t)DM * DFF * 2, W_IN = (size_t)NINP * DM * 2, W_OUT = (size_t)DM * DM * 2;
constexpr size_t WL_GU0 = 0, WL_D0 = WL_GU0 + W_GU, WL_GU1 = WL_D0 + W_D, WL_D1 = WL_GU1 + W_GU, WL_IN = WL_D1 + W_D, WL_OUT = WL_IN + W_IN, W_LAYER = WL_OUT + W_OUT;
constexpr size_t WS_H = WS_W + DEPTH * W_LAYER;
constexpr size_t WS_HZ = WS_H + (size_t)M * DM * 2;
constexpr size_t WS_Y = WS_HZ + (size_t)M * DFF * 2;
constexpr size_t WS_OG = WS_Y + (size_t)M * DM * 2;
constexpr size_t WS_END = WS_OG + (size_t)3 * M * 768 * 2;
static_assert(W_LAYER == 163 * MiB && WS_H == 660 * MiB && (size_t)NCHUNK * 6 * 128 * 64 * 4 <= (size_t)M * DM * 2, "ws map");
constexpr int CW_BAR = 4096;

constexpr int SCR_BYTES = 139264;
constexpr int LDSCTL_OFF = SCR_BYTES;
constexpr int LDS_BYTES = 143360;
static_assert(pg8::STAGE_BYTES <= SCR_BYTES, "lds");

#define GAS __attribute__((address_space(1)))
#define LAS __attribute__((address_space(3)))
typedef unsigned short bf16;
typedef unsigned v4u __attribute__((ext_vector_type(4)));
typedef unsigned v2u __attribute__((ext_vector_type(2)));
typedef float f32x4 __attribute__((ext_vector_type(4)));
typedef short bf16x8 __attribute__((ext_vector_type(8)));
typedef short s16x4 __attribute__((ext_vector_type(4)));
#define LDS_WAIT() asm volatile("s_waitcnt lgkmcnt(0)" ::: "memory")
__device__ __forceinline__ float bflo(unsigned w) { return __uint_as_float(w << 16); }
__device__ __forceinline__ float bfhi(unsigned w) { return __uint_as_float(w & 0xffff0000u); }
__device__ __forceinline__ float bf1(bf16 b) { return __uint_as_float(((unsigned)b) << 16); }
__device__ __forceinline__ unsigned pk2(float lo, float hi) { return pg8::cvt_pk_bf16(lo, hi); }
__device__ __forceinline__ bf16 f2bf(float f) { return (bf16)(pg8::cvt_pk_bf16(f, 0.f) & 0xffffu); }
__device__ __forceinline__ void unpack8(const v4u w, float (&f)[8]) { f[0] = bflo(w.x); f[1] = bfhi(w.x); f[2] = bflo(w.y); f[3] = bfhi(w.y); f[4] = bflo(w.z); f[5] = bfhi(w.z); f[6] = bflo(w.w); f[7] = bfhi(w.w); }
__device__ __forceinline__ v4u pack8(const float (&f)[8]) { v4u w; w.x = pk2(f[0], f[1]); w.y = pk2(f[2], f[3]); w.z = pk2(f[4], f[5]); w.w = pk2(f[6], f[7]); return w; }
__device__ __forceinline__ float gelu_tanh(float x) {
    const float u = 0.7978845608028654f * (x + 0.044715f * x * x * x);
    const float e = __expf(2.0f * u);
    const float th = 1.0f - 2.0f * __builtin_amdgcn_rcpf(1.0f + e);
    return 0.5f * x * (1.0f + th);
}
__device__ __forceinline__ float silu_f(float x) { return x * __builtin_amdgcn_rcpf(1.0f + __expf(-x)); }
__device__ __forceinline__ bf16x8 lds_row8(const LAS unsigned char* p) { return *(const LAS bf16x8*)p; }
typedef short v4i16_t __attribute__((ext_vector_type(4)));
__device__ __forceinline__ s16x4 lds_tr4(const LAS unsigned char* p) { return __builtin_bit_cast(s16x4, __builtin_amdgcn_ds_read_tr16_b64_v4i16((LAS v4i16_t*)p)); }
__device__ __forceinline__ bf16x8 cat8(s16x4 lo, s16x4 hi) { return __builtin_shufflevector(lo, hi, 0, 1, 2, 3, 4, 5, 6, 7); }
#define MFMA16(a, b, c) __builtin_amdgcn_mfma_f32_16x16x32_bf16((a), (b), (c), 0, 0, 0)

#define XB_TMO      128
#define XB_XCNT(j)  (256  + 64 * (j))
#define XB_XSUB(j)  (1280 + 64 * (j))
#define XB_XGEN(j)  (2304 + 64 * (j))
#define XB_TOP      3328
#define XB_TOPGEN   3392
#define XCD_BAR_WORDS 3456
#define XB_SPIN_CAP (1u << 21)

__device__ __forceinline__ unsigned xb_ld(unsigned* p)              { return __hip_atomic_load(p, __ATOMIC_RELAXED, __HIP_MEMORY_SCOPE_AGENT); }
__device__ __forceinline__ unsigned xb_add(unsigned* p, unsigned v) { return __hip_atomic_fetch_add(p, v, __ATOMIC_RELAXED, __HIP_MEMORY_SCOPE_AGENT); }
__device__ __forceinline__ unsigned xb_xcc_id() { return (unsigned)__builtin_amdgcn_s_getreg((3 << 11) | 20) & 0xFu; }
#define XB_SPIN(cond, bar) do { unsigned _sp = 0; while (cond) { __builtin_amdgcn_s_sleep(1); \
    if ((++_sp & 255u) == 0u) { if (xb_ld(&(bar)[XB_TMO])) break; if (_sp > XB_SPIN_CAP) { atomicAdd(&(bar)[XB_TMO], 1u); break; } } } } while (0)

struct XcdBarrier {
    unsigned* bar; unsigned x;
    volatile LAS unsigned* st;
};

__device__ __forceinline__ XcdBarrier xcd_barrier_post(unsigned* bar, volatile LAS unsigned* st) {
    XcdBarrier b; b.bar = bar; b.x = xb_xcc_id(); b.st = st;
    if (threadIdx.x == 0) (void)xb_add(&bar[XB_XCNT(b.x)], 1u);
    return b;
}
__device__ __forceinline__ void xcd_barrier_complete(unsigned* bar, unsigned x, unsigned& nloc, unsigned& nx) {
    const unsigned G = gridDim.x * gridDim.y * gridDim.z;
    unsigned sum, cnt, mine, sp = 0u;
    for (;;) {
        sum = 0u; cnt = 0u; mine = 0u;
#pragma unroll
        for (unsigned j = 0; j < 16; ++j) { const unsigned c = xb_ld(&bar[XB_XCNT(j)]); sum += c; cnt += (c > 0u) ? 1u : 0u; mine = (j == x) ? c : mine; }
        if (sum == G) break;
        __builtin_amdgcn_s_sleep(1);
        if ((++sp & 255u) == 0u) { if (xb_ld(&bar[XB_TMO])) break; if (sp > XB_SPIN_CAP) { atomicAdd(&bar[XB_TMO], 1u); break; } }
    }
    nloc = mine > 0u ? mine : 1u; nx = cnt > 0u ? cnt : 1u;
}

__device__ __forceinline__ void xcd_barrier(const XcdBarrier& b) {
    asm volatile("s_waitcnt vmcnt(0)" ::: "memory");
    __syncthreads();
    if (threadIdx.x == 0) {
        unsigned* bar = b.bar;
        __builtin_amdgcn_s_waitcnt(0);
        unsigned nloc = b.st[0], nx = b.st[1];
        if (nloc == 0u) { xcd_barrier_complete(bar, b.x, nloc, nx); b.st[0] = nloc; b.st[1] = nx; }
        const unsigned old = xb_add(&bar[XB_XSUB(b.x)], 1u);
        const unsigned gen = old / nloc;
        if (old + 1u == (gen + 1u) * nloc) {
            __builtin_amdgcn_fence(__ATOMIC_RELEASE, "agent");
            asm volatile("s_waitcnt vmcnt(0)" ::: "memory");
            const unsigned og = xb_add(&bar[XB_TOP], 1u);
            const unsigned tg = og / nx;
            if (og + 1u == (tg + 1u) * nx) xb_add(&bar[XB_TOPGEN], 1u);
            else XB_SPIN(xb_ld(&bar[XB_TOPGEN]) == tg, bar);
            __builtin_amdgcn_fence(__ATOMIC_ACQUIRE, "agent");
            xb_add(&bar[XB_XGEN(b.x)], 1u);
            asm volatile("s_waitcnt vmcnt(0)" ::: "memory");
        } else {
            XB_SPIN(xb_ld(&bar[XB_XGEN(b.x)]) == gen, bar);
            __builtin_amdgcn_fence(__ATOMIC_ACQUIRE, "agent");
            asm volatile("s_waitcnt vmcnt(0)" ::: "memory");
        }
    }
    __syncthreads();
}

struct Args {
    const float* in[16]; float* out; unsigned char* ws;
    float inv_freq[16];
};

__device__ __forceinline__ void transpose_item(const float* __restrict__ W, int ldw, int nvalid, int k0, int n0, bf16* __restrict__ WT, int ldt, int dst_row0, LAS float* scr, int lane) {
    const int nc = n0 + (lane & 31); const bool okc = nc < nvalid;
#pragma unroll 8
    for (int i = 0; i < 32; ++i) { const int kk = 2 * i + (lane >> 5); scr[kk * 33 + (lane & 31)] = okc ? W[(size_t)(k0 + kk) * ldw + nc] : 0.f; }
    LDS_WAIT(); asm volatile("" ::: "memory");
    const int c = lane & 7;
#pragma unroll
    for (int j = 0; j < 4; ++j) { const int n = (lane >> 3) + 8 * j; const LAS float* s = scr + (8 * c) * 33 + n;
        v4u o; o.x = pk2(s[0 * 33], s[1 * 33]); o.y = pk2(s[2 * 33], s[3 * 33]); o.z = pk2(s[4 * 33], s[5 * 33]); o.w = pk2(s[6 * 33], s[7 * 33]);
        *(v4u*)(WT + (size_t)(dst_row0 + n) * ldt + k0 + 8 * c) = o; }
    LDS_WAIT(); asm volatile("" ::: "memory");
}
constexpr int IT_GU = (DM / 64) * (DFF / 32);
constexpr int IT_D = (DFF / 64) * (DM / 32);
constexpr int IT_IN = (DM / 64) * (NINP / 32);
constexpr int IT_OUT = (DM / 64) * (DM / 32);
constexpr int IT_LAYER = 2 * (2 * IT_GU + IT_D) + IT_IN + IT_OUT;

typedef const __attribute__((address_space(4))) Args* ArgPc;
__device__ __forceinline__ void prologue(ArgPc Ap, unsigned char* ws, LAS unsigned char* lds, int gw, int ngw, int wave, int lane, int gtid, int ngt) {
    LAS float* scr = (LAS float*)(lds + wave * 16384);
    for (int it = gw; it < DEPTH * IT_LAYER; it += ngw) {
        const int l = it / IT_LAYER; int r = it - l * IT_LAYER;
        unsigned char* wl = ws + WS_W + (size_t)l * W_LAYER;
        if (r < 2 * (2 * IT_GU + IT_D)) {
            const int f = r / (2 * IT_GU + IT_D); r -= f * (2 * IT_GU + IT_D);
            const size_t wsel = (size_t)(l * 2 + f);
            if (r < 2 * IT_GU) {
                const int up = r / IT_GU; r -= up * IT_GU;
                const float* W = (up ? Ap->in[3] : Ap->in[2]) + wsel * DM * DFF;
                const int kb = r / (DFF / 32), nb = r % (DFF / 32), n0 = nb * 32;
                bf16* WT = (bf16*)(wl + (f ? WL_GU1 : WL_GU0));
                transpose_item(W, DFF, DFF, kb * 64, n0, WT, DM, 256 * (n0 >> 7) + (n0 & 127) + 128 * up, scr, lane);
            } else {
                r -= 2 * IT_GU;
                const float* W = Ap->in[4] + wsel * DFF * DM;
                const int kb = r / (DM / 32), nb = r % (DM / 32);
                bf16* WT = (bf16*)(wl + (f ? WL_D1 : WL_D0));
                transpose_item(W, DM, DM, kb * 64, nb * 32, WT, DFF, nb * 32, scr, lane);
            }
        } else {
            r -= 2 * (2 * IT_GU + IT_D);
            if (r < IT_IN) {
                const float* W = Ap->in[6] + (size_t)l * DM * NIN;
                const int kb = r / (NINP / 32), nb = r % (NINP / 32);
                transpose_item(W, NIN, NIN, kb * 64, nb * 32, (bf16*)(wl + WL_IN), DM, nb * 32, scr, lane);
            } else {
                r -= IT_IN;
                const float* W = Ap->in[15] + (size_t)l * DM * DM;
                const int kb = r / (DM / 32), nb = r % (DM / 32);
                transpose_item(W, DM, DM, kb * 64, nb * 32, (bf16*)(wl + WL_OUT), DM, nb * 32, scr, lane);
            }
        }
    }
    float* rc = (float*)(ws + WS_ROPE); float* rs = rc + SEQ * 16;
    for (int i = gtid; i < SEQ * 16; i += ngt) {
        const int pos = i >> 4, k = i & 15;
        const float angf = (float)pos * Ap->inv_freq[k];
        const double a = (double)angf;
        const double q = __builtin_rint(a * 0.63661977236758134308);
        double x = __builtin_fma(-q, 1.57079632679489655800e+00, a); x = __builtin_fma(-q, 6.12323399573676603587e-17, x);
        const double x2 = x * x;
        double sp = 1.0 / 6227020800.0; sp = sp * x2 - 1.0 / 39916800.0; sp = sp * x2 + 1.0 / 362880.0; sp = sp * x2 - 1.0 / 5040.0; sp = sp * x2 + 1.0 / 120.0; sp = sp * x2 - 1.0 / 6.0; sp = sp * x2 + 1.0; sp *= x;
        double cp = 1.0 / 87178291200.0; cp = -cp; cp = cp * x2 + 1.0 / 479001600.0; cp = cp * x2 - 1.0 / 3628800.0; cp = cp * x2 + 1.0 / 40320.0; cp = cp * x2 - 1.0 / 720.0; cp = cp * x2 + 1.0 / 24.0; cp = cp * x2 - 0.5; cp = cp * x2 + 1.0;
        const int qi = ((int)q) & 3;
        const double sv = (qi == 0) ? sp : (qi == 1) ? cp : (qi == 2) ? -sp : -cp;
        const double cv = (qi == 0) ? cp : (qi == 1) ? -sp : (qi == 2) ? -cp : sp;
        rc[i] = (float)cv; rs[i] = (float)sv;
    }
}

__device__ __forceinline__ float wave_sum(float v) {
#pragma unroll
    for (int o = 1; o < 64; o <<= 1) v += __shfl_xor(v, o);
    return v;
}
__device__ __forceinline__ void norm_phase(const float* __restrict__ x, const float* __restrict__ g, bf16* __restrict__ h, int gw, int ngw, int lane) {
    f32x4 gv[8];
#pragma unroll
    for (int j = 0; j < 8; ++j) gv[j] = *((const f32x4*)g + lane + 64 * j);
    for (int m = gw; m < M; m += ngw) {
        const f32x4* xr = (const f32x4*)(x + (size_t)m * DM) + lane;
        f32x4 v[8]; float s = 0.f;
#pragma unroll
        for (int j = 0; j < 8; ++j) { v[j] = xr[64 * j]; s += (v[j].x * v[j].x + v[j].y * v[j].y) + (v[j].z * v[j].z + v[j].w * v[j].w); }
        const float rstd = rsqrtf(wave_sum(s) * (1.f / DM) + EPS);
        v2u* o = (v2u*)(h + (size_t)m * DM) + lane;
#pragma unroll
        for (int j = 0; j < 8; ++j) { v2u w; w.x = pk2(v[j].x * rstd * gv[j].x, v[j].y * rstd * gv[j].y); w.y = pk2(v[j].z * rstd * gv[j].z, v[j].w * rstd * gv[j].w); o[64 * j] = w; }
    }
}

constexpr int LD128 = 272;
constexpr int LD64 = 144;
__device__ __forceinline__ void gmlp_unit(LAS unsigned char* lds, const bf16* __restrict__ z, const float* __restrict__ sgw, const float* __restrict__ sgb, const float* __restrict__ sgn,
                                          bf16* __restrict__ y, int um, int tid, int w, int lane) {
    const int g = um & 3, cn = um >> 2; const size_t R0 = (size_t)cn * 128;
    const int c16 = lane & 15, g4 = lane >> 4, q4 = c16 >> 2, p4 = lane & 3;
    LAS unsigned char* WM = lds; LAS unsigned char* VN = lds + 128 * LD128;
#pragma unroll
    for (int it = 0; it < 4; ++it) {
        const int c = tid + 512 * it, t = c >> 4, ch = c & 15;
        const float* wp = sgw + ((size_t)(g * 128 + t)) * 128 + 8 * ch;
        const f32x4 w0 = *(const f32x4*)wp, w1 = *(const f32x4*)(wp + 4);
        float f[8] = {w0.x, w0.y, w0.z, w0.w, w1.x, w1.y, w1.z, w1.w};
#pragma unroll
        for (int e = 0; e < 8; ++e) f[e] = (8 * ch + e <= t) ? f[e] : 0.f;
        *(LAS v4u*)(WM + t * LD128 + ch * 16) = pack8(f);
        const v4u vw = *(const v4u*)(z + (R0 + t) * ZLD + ZC_AV + 128 * g + 8 * ch);
        float v[8]; unpack8(vw, v); float ss = 0.f;
#pragma unroll
        for (int e = 0; e < 8; ++e) { v[e] = gelu_tanh(v[e]); ss += v[e] * v[e]; }
        ss += __shfl_xor(ss, 1); ss += __shfl_xor(ss, 2); ss += __shfl_xor(ss, 4); ss += __shfl_xor(ss, 8);
        const float rstd = rsqrtf(ss * (1.f / 128.f) + EPS);
        const float* gp = sgn + 128 * g + 8 * ch;
        const f32x4 g0 = *(const f32x4*)gp, g1 = *(const f32x4*)(gp + 4);
        const float gg[8] = {g0.x, g0.y, g0.z, g0.w, g1.x, g1.y, g1.z, g1.w};
#pragma unroll
        for (int e = 0; e < 8; ++e) v[e] = v[e] * rstd * gg[e];
        *(LAS v4u*)(VN + t * LD128 + ch * 16) = pack8(v);
    }
    __syncthreads();
    f32x4 acc[8];
#pragma unroll
    for (int ct = 0; ct < 8; ++ct) acc[ct] = (f32x4){0.f, 0.f, 0.f, 0.f};
    const int nks = (w >> 1) + 1;
#pragma unroll
    for (int ks = 0; ks < 4; ++ks) {
        if (ks < nks) {
            const bf16x8 af = lds_row8(WM + (16 * w + c16) * LD128 + (32 * ks + 8 * g4) * 2);
            const LAS unsigned char* vb = VN + (32 * ks + 8 * g4 + q4) * LD128 + (4 * p4) * 2;
#pragma unroll
            for (int ct = 0; ct < 8; ++ct) {
                const bf16x8 bfr = cat8(lds_tr4(vb + ct * 32), lds_tr4(vb + 4 * LD128 + ct * 32));
                acc[ct] = MFMA16(bfr, af, acc[ct]);
            }
        }
    }
    const int t = 16 * w + c16; const float bias = sgb[g * 128 + t];
    const bf16* up = z + (R0 + t) * ZLD + ZC_AU + 128 * g + 4 * g4;
    bf16* yp = y + (R0 + t) * DM + YC_A + 128 * g + 4 * g4;
#pragma unroll
    for (int ct = 0; ct < 8; ++ct) {
        const v2u uw = *(const v2u*)(up + 16 * ct);
        const float u0 = gelu_tanh(bflo(uw.x)), u1 = gelu_tanh(bfhi(uw.x)), u2 = gelu_tanh(bflo(uw.y)), u3 = gelu_tanh(bfhi(uw.y));
        v2u o; o.x = pk2(u0 * (acc[ct][0] + bias), u1 * (acc[ct][1] + bias)); o.y = pk2(u2 * (acc[ct][2] + bias), u3 * (acc[ct][3] + bias));
        *(v2u*)(yp + 16 * ct) = o;
    }
    __syncthreads();
}

__device__ __forceinline__ void qk_prepass(bf16* __restrict__ z, const float* __restrict__ qgain, const float* __restrict__ kgain, const float* __restrict__ ropec, const float* __restrict__ ropes,
                                           int gw, int ngw, int lane) {
    const int ch = lane & 15;
    const f32x4 q0 = *(const f32x4*)(qgain + 8 * ch), q1 = *(const f32x4*)(qgain + 8 * ch + 4), k0 = *(const f32x4*)(kgain + 8 * ch), k1 = *(const f32x4*)(kgain + 8 * ch + 4);
    const float qg[8] = {q0.x, q0.y, q0.z, q0.w, q1.x, q1.y, q1.z, q1.w}, kg[8] = {k0.x, k0.y, k0.z, k0.w, k1.x, k1.y, k1.z, k1.w};
    const float sg = (ch < 2) ? -1.f : 1.f;
    for (int m = gw; m < M; m += ngw) {
        bf16* zr = z + (size_t)m * ZLD + ZC_BQ + 8 * lane;
        const int t = m & (SEQ - 1);
        v4u w[3];
#pragma unroll
        for (int it = 0; it < 3; ++it) w[it] = *(const v4u*)(zr + 512 * it);
        float cc[8], sn[8];
        {
            const float* cp = ropec + t * 16 + 8 * (ch & 1); const float* sp = ropes + t * 16 + 8 * (ch & 1);
            const f32x4 c0 = *(const f32x4*)cp, c1 = *(const f32x4*)(cp + 4), s0 = *(const f32x4*)sp, s1 = *(const f32x4*)(sp + 4);
            cc[0] = c0.x; cc[1] = c0.y; cc[2] = c0.z; cc[3] = c0.w; cc[4] = c1.x; cc[5] = c1.y; cc[6] = c1.z; cc[7] = c1.w;
            sn[0] = s0.x; sn[1] = s0.y; sn[2] = s0.z; sn[3] = s0.w; sn[4] = s1.x; sn[5] = s1.y; sn[6] = s1.z; sn[7] = s1.w;
        }
#pragma unroll
        for (int it = 0; it < 3; ++it) {
            const bool isq = (4 * it + (lane >> 4)) < 6;
            float f[8]; unpack8(w[it], f); float ss = 0.f;
#pragma unroll
            for (int e = 0; e < 8; ++e) ss += f[e] * f[e];
            ss += __shfl_xor(ss, 1); ss += __shfl_xor(ss, 2); ss += __shfl_xor(ss, 4); ss += __shfl_xor(ss, 8);
            const float rstd = rsqrtf(ss * (1.f / 128.f) + EPS);
#pragma unroll
            for (int e = 0; e < 8; ++e) f[e] = f[e] * rstd * (isq ? qg[e] : kg[e]);
            float pr[8];
#pragma unroll
            for (int e = 0; e < 8; ++e) pr[e] = __shfl_xor(f[e], 2);
            if (ch < 4) {
#pragma unroll
                for (int e = 0; e < 8; ++e) f[e] = f[e] * cc[e] + sg * pr[e] * sn[e];
            }
            const float sc = isq ? 0.08838834764831845f : 1.0f;
#pragma unroll
            for (int e = 0; e < 8; ++e) f[e] *= sc;
            *(v4u*)(zr + 512 * it) = pack8(f);
        }
    }
}
struct AttnDesc { int gi, dil, h, r, nb; size_t rowbase; };
__device__ __forceinline__ AttnDesc attn_decode(int ua) {
    AttnDesc d; d.gi = ua / 1536; int rem = ua - d.gi * 1536;
    d.dil = (d.gi == 0) ? 1 : (d.gi == 1) ? 4 : 16; const int nblk = 64 / d.dil;
    const int b = rem / 384; rem -= b * 384; d.h = rem >> 6; rem &= 63;
    d.r = rem / nblk; d.nb = rem - d.r * nblk; d.rowbase = (size_t)b * SEQ; return d;
}
struct AttnRegs { v4u k[8], v[8], q[4]; };
__device__ __forceinline__ void attn_issue(const bf16* __restrict__ z, const AttnDesc& d, AttnRegs& R, int tid, int w, int lane) {
#pragma unroll
    for (int it = 0; it < 8; ++it) {
        const int c = tid + 512 * it, row = c >> 4, ch = c & 15;
        const int si = 128 * (d.nb - 1) + row; const bool ok = si >= 0;
        const int t = ok ? si * d.dil + d.r : 0;
        const bf16* zr = z + (d.rowbase + t) * ZLD + 128 * d.h + 8 * ch;
        v4u kw = *(const v4u*)(zr + ZC_BK), vw = *(const v4u*)(zr + ZC_BV);
        if (!ok) { kw = (v4u){0u, 0u, 0u, 0u}; vw = kw; }
        R.k[it] = kw; R.v[it] = vw;
    }
    const int tq = (128 * d.nb + 16 * w + (lane & 15)) * d.dil + d.r;
    const bf16* zq = z + (d.rowbase + tq) * ZLD + ZC_BQ + 128 * d.h + 8 * (lane >> 4);
#pragma unroll
    for (int ks = 0; ks < 4; ++ks) R.q[ks] = *(const v4u*)(zq + 32 * ks);
}
__device__ __forceinline__ void attn_stage(LAS unsigned char* lds, const AttnRegs& R, int tid) {
    LAS unsigned char* KS = lds; LAS unsigned char* VS = lds + 256 * LD128;
#pragma unroll
    for (int it = 0; it < 8; ++it) {
        const int c = tid + 512 * it, row = c >> 4, ch = c & 15;
        *(LAS v4u*)(KS + row * LD128 + ch * 16) = R.k[it];
        *(LAS v4u*)(VS + row * LD128 + ch * 16) = R.v[it];
    }
}
__device__ __forceinline__ void attn_compute(LAS unsigned char* lds, const AttnDesc& d, const bf16x8 (&qf)[4], bf16* __restrict__ og, float* __restrict__ lse, int w, int lane) {
    const int c16 = lane & 15, g4 = lane >> 4, q4 = c16 >> 2, p4 = lane & 3;
    const LAS unsigned char* KS = lds; const LAS unsigned char* VS = lds + 256 * LD128;
    const int qi = 16 * w + c16; const int tq = (128 * d.nb + qi) * d.dil + d.r;
    f32x4 sc[9];
#pragma unroll
    for (int j = 0; j < 9; ++j) {
        sc[j] = (f32x4){0.f, 0.f, 0.f, 0.f};
        const LAS unsigned char* kp = KS + (16 * (w + j) + c16) * LD128 + 16 * g4;
#pragma unroll
        for (int ks = 0; ks < 4; ++ks) sc[j] = MFMA16(lds_row8(kp + 64 * ks), qf[ks], sc[j]);
    }
    float mx = -1e30f;
#pragma unroll
    for (int j = 0; j < 9; ++j)
#pragma unroll
        for (int e = 0; e < 4; ++e) { const int kj = 16 * (w + j) + 4 * g4 + e; const int dist = qi + 128 - kj;
            const bool valid = (dist >= 0) && (dist <= 128) && (d.nb > 0 || kj >= 128);
            sc[j][e] = valid ? sc[j][e] : -1e30f; mx = fmaxf(mx, sc[j][e]); }
    mx = fmaxf(mx, __shfl_xor(mx, 16)); mx = fmaxf(mx, __shfl_xor(mx, 32));
    float l = 0.f;
#pragma unroll
    for (int j = 0; j < 9; ++j)
#pragma unroll
        for (int e = 0; e < 4; ++e) { const float p = __expf(sc[j][e] - mx); sc[j][e] = p; l += p; }
    l += __shfl_xor(l, 16); l += __shfl_xor(l, 32);
    f32x4 oa[8];
#pragma unroll
    for (int ct = 0; ct < 8; ++ct) oa[ct] = (f32x4){0.f, 0.f, 0.f, 0.f};
#pragma unroll
    for (int s = 0; s < 5; ++s) {
        v4u pw; pw.x = pk2(sc[2 * s][0], sc[2 * s][1]); pw.y = pk2(sc[2 * s][2], sc[2 * s][3]);
        if (s < 4) { pw.z = pk2(sc[2 * s + 1][0], sc[2 * s + 1][1]); pw.w = pk2(sc[2 * s + 1][2], sc[2 * s + 1][3]); } else { pw.z = 0u; pw.w = 0u; }
        const bf16x8 pf = __builtin_bit_cast(bf16x8, pw);
        const int kt0 = w + 2 * s, kt1 = (w + 2 * s + 1 > 15) ? 15 : (w + 2 * s + 1);
        const LAS unsigned char* v0 = VS + (16 * kt0 + 4 * g4 + q4) * LD128 + 8 * p4;
        const LAS unsigned char* v1 = VS + (16 * kt1 + 4 * g4 + q4) * LD128 + 8 * p4;
#pragma unroll
        for (int ct = 0; ct < 8; ++ct) oa[ct] = MFMA16(cat8(lds_tr4(v0 + 32 * ct), lds_tr4(v1 + 32 * ct)), pf, oa[ct]);
    }
    const float inv = 1.0f / l;
    const size_t orow = (size_t)d.gi * M + d.rowbase + tq;
    bf16* op = og + orow * 768 + 128 * d.h + 4 * g4;
#pragma unroll
    for (int ct = 0; ct < 8; ++ct) { v2u o; o.x = pk2(oa[ct][0] * inv, oa[ct][1] * inv); o.y = pk2(oa[ct][2] * inv, oa[ct][3] * inv); *(v2u*)(op + 16 * ct) = o; }
    if (g4 == 0) lse[orow * 6 + d.h] = mx + __logf(l);
}
__device__ __forceinline__ void attn_phase(LAS unsigned char* lds, const bf16* __restrict__ z, bf16* __restrict__ og, float* __restrict__ lse, int vc, int G, int tid, int w, int lane) {
    AttnRegs R; AttnDesc d = attn_decode(vc < 4608 ? vc : 0);
    attn_issue(z, d, R, tid, w, lane);
    for (int ua = vc; ua < 4608; ua += G) {
        asm volatile("" : "+s"(w), "+v"(tid));
        lane = tid & 63;
        attn_stage(lds, R, tid);
        bf16x8 qf[4];
#pragma unroll
        for (int ks = 0; ks < 4; ++ks) qf[ks] = __builtin_bit_cast(bf16x8, R.q[ks]);
        const AttnDesc dc = d;
        __syncthreads();
        if (ua + G < 4608) { d = attn_decode(ua + G); attn_issue(z, d, R, tid, w, lane); }
        attn_compute(lds, dc, qf, og, lse, w, lane);
        __syncthreads();
    }
}

__device__ __forceinline__ void gla_gates(LAS unsigned char* lds, const float* __restrict__ rb, const float* __restrict__ wg, const float* __restrict__ bg, int h, int w, int lane,
                                          float (&bl)[8], float& blast) {
    float wcol[16];
#pragma unroll
    for (int i = 0; i < 16; ++i) wcol[i] = wg[i * 384 + 64 * h + lane];
    const float bias = bg[64 * h + lane];
    const float r0 = rb[(8 * w) * 16 + lane], r1 = rb[(8 * w + 4) * 16 + lane];
    float run = 0.f;
#pragma unroll
    for (int it = 0; it < 8; ++it) {
        float x = bias;
#pragma unroll
        for (int i = 0; i < 16; ++i) x += __int_as_float(__builtin_amdgcn_readlane(__float_as_int(it < 4 ? r0 : r1), (it & 3) * 16 + i)) * wcol[i];
        const float la = (fminf(x, 0.f) - __logf(1.0f + __expf(-fabsf(x)))) * (1.f / 16.f);
        run += la; bl[it] = run;
    }
    LAS float* T = (LAS float*)lds;
    T[w * 64 + lane] = run;
    __syncthreads();
    float off = 0.f, tot = 0.f;
#pragma unroll
    for (int ww = 0; ww < 8; ++ww) { const float tv = T[ww * 64 + lane]; tot += tv; off += (ww < w) ? tv : 0.f; }
#pragma unroll
    for (int it = 0; it < 8; ++it) bl[it] += off;
    blast = tot;
}
__device__ __forceinline__ void gla_g1_unit(LAS unsigned char* lds, const bf16* __restrict__ z, const float* __restrict__ rbuf, const float* __restrict__ wg, const float* __restrict__ bg,
                                            float* __restrict__ UT, float* __restrict__ dec, int u1, int tid, int w, int lane) {
    const int h = u1 % 6, chunk = u1 / 6; const size_t R0 = (size_t)chunk * 64;
    const int c16 = lane & 15, g4 = lane >> 4, q4 = c16 >> 2, p4 = lane & 3;
    LAS unsigned char* KT = lds + 2048; LAS unsigned char* VS = KT + 64 * LD64;
    float bl[8], blast;
    gla_gates(lds, rbuf + R0 * 16, wg, bg, h, w, lane, bl, blast);
#pragma unroll
    for (int it = 0; it < 8; ++it) { const int j = 8 * w + it;
        const float kv = bf1(z[(R0 + j) * ZLD + ZC_CK + 64 * h + lane]);
        *(LAS bf16*)(KT + j * LD64 + lane * 2) = f2bf(kv * __expf(blast - bl[it])); }
    if (w == 0) dec[((size_t)chunk * 6 + h) * 64 + lane] = __expf(blast);
#pragma unroll
    for (int it = 0; it < 2; ++it) { const int c = tid + 512 * it, row = c >> 4, ch = c & 15;
        *(LAS v4u*)(VS + row * LD128 + ch * 16) = *(const v4u*)(z + (R0 + row) * ZLD + ZC_CV + 128 * h + 8 * ch); }
    __syncthreads();
    f32x4 acc[4];
#pragma unroll
    for (int kt = 0; kt < 4; ++kt) acc[kt] = (f32x4){0.f, 0.f, 0.f, 0.f};
#pragma unroll
    for (int ks = 0; ks < 2; ++ks) {
        const LAS unsigned char* vb = VS + (32 * ks + 8 * g4 + q4) * LD128 + (16 * w + 4 * p4) * 2;
        const bf16x8 af = cat8(lds_tr4(vb), lds_tr4(vb + 4 * LD128));
        const LAS unsigned char* kb = KT + (32 * ks + 8 * g4 + q4) * LD64 + (4 * p4) * 2;
#pragma unroll
        for (int kt = 0; kt < 4; ++kt) { const bf16x8 bfr = cat8(lds_tr4(kb + 32 * kt), lds_tr4(kb + 4 * LD64 + 32 * kt));
            acc[kt] = MFMA16(bfr, af, acc[kt]); }
    }
    float* up = UT + ((size_t)chunk * 6 + h) * 8192 + (16 * w + c16) * 64 + 4 * g4;
#pragma unroll
    for (int kt = 0; kt < 4; ++kt) *(f32x4*)(up + 16 * kt) = acc[kt];
    __syncthreads();
}
__device__ __forceinline__ void gla_scan(float* __restrict__ UT, const float* __restrict__ dec, int gtid, int ngt) {
    for (int e = gtid; e < BATCH * 6 * 8192; e += ngt) {
        const int kk = e & 63, hv = e >> 6; const int b = hv / (6 * 128), hvr = hv - b * (6 * 128); const int h = hvr >> 7;
        float* up = UT + (size_t)b * 128 * 6 * 8192 + (size_t)hvr * 64 + kk;
        const float* dp = dec + (size_t)b * 128 * 384 + h * 64 + kk;
        float st = 0.f;
        for (int n0 = 0; n0 < 128; n0 += 16) {
            float uv[16], dv[16];
#pragma unroll
            for (int i = 0; i < 16; ++i) { uv[i] = up[(size_t)(n0 + i) * 6 * 8192]; dv[i] = dp[(size_t)(n0 + i) * 384]; }
#pragma unroll
            for (int i = 0; i < 16; ++i) { up[(size_t)(n0 + i) * 6 * 8192] = st; st = dv[i] * st + uv[i]; }
        }
    }
}
__device__ __forceinline__ void gla_g3_unit(LAS unsigned char* lds, const bf16* __restrict__ z, const float* __restrict__ rbuf, const float* __restrict__ wg, const float* __restrict__ bg,
                                            const float* __restrict__ outg, const float* __restrict__ UT, bf16* __restrict__ y, int u3, int tid, int w, int lane) {
    const int h = u3 % 6, chunk = u3 / 6; const size_t R0 = (size_t)chunk * 64;
    const int c16 = lane & 15, g4 = lane >> 4, q4 = c16 >> 2, p4 = lane & 3;
    LAS unsigned char* QD = lds + 2048; LAS unsigned char* KD = QD + 64 * LD64; LAS unsigned char* VS = KD + 64 * LD64;
    LAS unsigned char* ST = VS + 64 * LD128; LAS unsigned char* AM = ST + 128 * LD64; LAS float* RS = (LAS float*)(AM + 64 * LD64);
    float bl[8], blast;
    gla_gates(lds, rbuf + R0 * 16, wg, bg, h, w, lane, bl, blast);
#pragma unroll
    for (int it = 0; it < 8; ++it) { const int j = 8 * w + it;
        const bf16* zr = z + (R0 + j) * ZLD + 64 * h + lane;
        const float qv = bf1(zr[ZC_CQ]), kv = bf1(zr[ZC_CK]);
        *(LAS bf16*)(QD + j * LD64 + lane * 2) = f2bf(qv * 0.125f * __expf(bl[it]));
        *(LAS bf16*)(KD + j * LD64 + lane * 2) = f2bf(kv * __expf(-bl[it])); }
#pragma unroll
    for (int it = 0; it < 2; ++it) { const int c = tid + 512 * it, row = c >> 4, ch = c & 15;
        *(LAS v4u*)(VS + row * LD128 + ch * 16) = *(const v4u*)(z + (R0 + row) * ZLD + ZC_CV + 128 * h + 8 * ch); }
    const float* sp = UT + ((size_t)chunk * 6 + h) * 8192;
#pragma unroll
    for (int it = 0; it < 4; ++it) { const int c = tid + 512 * it, v = c >> 4, kc = c & 15;
        const f32x4 s4 = *(const f32x4*)(sp + v * 64 + 4 * kc);
        v2u o; o.x = pk2(s4.x, s4.y); o.y = pk2(s4.z, s4.w);
        *(LAS v2u*)(ST + v * LD64 + kc * 8) = o; }
    __syncthreads();
    {
        const int it = w >> 1;
#pragma unroll
        for (int jj = 0; jj < 2; ++jj) { const int jt = 2 * (w & 1) + jj;
            f32x4 a = (f32x4){0.f, 0.f, 0.f, 0.f};
            if (jt <= it) {
#pragma unroll
                for (int ks = 0; ks < 2; ++ks) a = MFMA16(lds_row8(KD + (16 * jt + c16) * LD64 + (32 * ks + 8 * g4) * 2), lds_row8(QD + (16 * it + c16) * LD64 + (32 * ks + 8 * g4) * 2), a);
            }
            const int i = 16 * it + c16, j0 = 16 * jt + 4 * g4;
            v2u o; o.x = pk2(j0 <= i ? a[0] : 0.f, j0 + 1 <= i ? a[1] : 0.f); o.y = pk2(j0 + 2 <= i ? a[2] : 0.f, j0 + 3 <= i ? a[3] : 0.f);
            *(LAS v2u*)(AM + i * LD64 + j0 * 2) = o; }
    }
    __syncthreads();
    const int it = w & 3, vh = w >> 2;
    f32x4 acc[4];
#pragma unroll
    for (int c4 = 0; c4 < 4; ++c4) acc[c4] = (f32x4){0.f, 0.f, 0.f, 0.f};
#pragma unroll
    for (int ks = 0; ks < 2; ++ks) {
        if (ks == 0 || it >= 2) {
            const bf16x8 af = lds_row8(AM + (16 * it + c16) * LD64 + (32 * ks + 8 * g4) * 2);
            const LAS unsigned char* vb = VS + (32 * ks + 8 * g4 + q4) * LD128 + (64 * vh + 4 * p4) * 2;
#pragma unroll
            for (int c4 = 0; c4 < 4; ++c4) acc[c4] = MFMA16(cat8(lds_tr4(vb + 32 * c4), lds_tr4(vb + 4 * LD128 + 32 * c4)), af, acc[c4]);
        }
    }
#pragma unroll
    for (int ks = 0; ks < 2; ++ks) {
        const bf16x8 af = lds_row8(QD + (16 * it + c16) * LD64 + (32 * ks + 8 * g4) * 2);
#pragma unroll
        for (int c4 = 0; c4 < 4; ++c4) acc[c4] = MFMA16(lds_row8(ST + (64 * vh + 16 * c4 + c16) * LD64 + (32 * ks + 8 * g4) * 2), af, acc[c4]);
    }
    float ss = 0.f;
#pragma unroll
    for (int c4 = 0; c4 < 4; ++c4) ss += (acc[c4][0] * acc[c4][0] + acc[c4][1] * acc[c4][1]) + (acc[c4][2] * acc[c4][2] + acc[c4][3] * acc[c4][3]);
    ss += __shfl_xor(ss, 16); ss += __shfl_xor(ss, 32);
    const int i = 16 * it + c16;
    if (g4 == 0) RS[i * 2 + vh] = ss;
    __syncthreads();
    const float rstd = rsqrtf((RS[i * 2] + RS[i * 2 + 1]) * (1.f / 128.f) + EPS);
    const bf16* gp = z + (R0 + i) * ZLD + ZC_CG + 128 * h + 64 * vh + 4 * g4;
    bf16* yp = y + (R0 + i) * DM + YC_C + 128 * h + 64 * vh + 4 * g4;
    const float* ogp = outg + 64 * vh + 4 * g4;
#pragma unroll
    for (int c4 = 0; c4 < 4; ++c4) {
        const v2u gw = *(const v2u*)(gp + 16 * c4); const f32x4 og4 = *(const f32x4*)(ogp + 16 * c4);
        v2u o; o.x = pk2(acc[c4][0] * rstd * og4.x * silu_f(bflo(gw.x)), acc[c4][1] * rstd * og4.y * silu_f(bfhi(gw.x)));
        o.y = pk2(acc[c4][2] * rstd * og4.z * silu_f(bflo(gw.y)), acc[c4][3] * rstd * og4.w * silu_f(bfhi(gw.y)));
        *(v2u*)(yp + 16 * c4) = o;
    }
    __syncthreads();
}
__device__ __forceinline__ void attn_merge(const bf16* __restrict__ og, const float* __restrict__ lse, bf16* __restrict__ y, int gtid, int ngt) {
    for (int idx = gtid; idx < M * 96; idx += ngt) {
        const int row = idx / 96, cc = idx - row * 96, h = cc >> 4;
        const float l0 = lse[(size_t)row * 6 + h], l1 = lse[((size_t)M + row) * 6 + h], l2 = lse[((size_t)2 * M + row) * 6 + h];
        const float mx = fmaxf(l0, fmaxf(l1, l2));
        float w0 = __expf(l0 - mx), w1 = __expf(l1 - mx), w2 = __expf(l2 - mx);
        const float inv = 1.0f / (w0 + w1 + w2); w0 *= inv; w1 *= inv; w2 *= inv;
        float a[8], b[8], c[8];
        unpack8(*(const v4u*)(og + (size_t)row * 768 + 8 * cc), a);
        unpack8(*(const v4u*)(og + ((size_t)M + row) * 768 + 8 * cc), b);
        unpack8(*(const v4u*)(og + ((size_t)2 * M + row) * 768 + 8 * cc), c);
#pragma unroll
        for (int e = 0; e < 8; ++e) a[e] = w0 * a[e] + w1 * b[e] + w2 * c[e];
        *(v4u*)(y + (size_t)row * DM + YC_B + 8 * cc) = pack8(a);
    }
}

#ifndef DBG_MASK
#define DBG_MASK 0xFFFF
#endif
#define PH(b) if constexpr ((DBG_MASK >> (b)) & 1)
#ifndef PROBE_MASK
#define PROBE_MASK 0
#endif
#if PROBE_MASK
#define REP(b) int nrep_##b = 1 + ((PROBE_MASK >> (b)) & 1); asm volatile("" : "+s"(nrep_##b)); _Pragma("unroll 1") for (int rep_ = 0; rep_ < nrep_##b; ++rep_)
#else
#define REP(b) for (int rep_ = 0; rep_ < 1; ++rep_)
#endif
typedef const __attribute__((address_space(4))) Args* ArgP;
#define PHASE_BEGIN() ArgP ap = (ArgP)__builtin_amdgcn_kernarg_segment_ptr(); asm volatile("" : "+s"(ap)); \
    unsigned char* const ws = ap->ws; int tid = threadIdx.x; asm volatile("" : "+v"(tid)); \
    const int lane = tid & 63, wave = __builtin_amdgcn_readfirstlane(tid >> 6), G = gridDim.x, bx = blockIdx.x; \
    const int gw = bx * NWAVES + wave, ngw = G * NWAVES, gtid = bx * (NWAVES * 64) + tid, ngt = G * NWAVES * 64; \
    (void)ws; (void)lane; (void)wave; (void)gw; (void)ngw; (void)gtid; (void)ngt; \
    LAS unsigned char* lds = (LAS unsigned char*)lds_raw

__global__ void __launch_bounds__(NWAVES * 64, 2) hymba_fwd(Args args) {
    extern __shared__ __attribute__((aligned(16))) unsigned char lds_raw[];
    {
        LAS unsigned char* lds0 = (LAS unsigned char*)lds_raw;
        for (int u = threadIdx.x; u < (LDS_BYTES - LDSCTL_OFF) / 4; u += NWAVES * 64) ((LAS unsigned*)(lds0 + LDSCTL_OFF))[u] = 0u;
    }
    __syncthreads();
    XcdBarrier bar = xcd_barrier_post((unsigned*)(args.ws + WS_CTL) + CW_BAR, (volatile LAS unsigned*)((LAS unsigned char*)lds_raw + LDSCTL_OFF) + 8);
#define GRID_BAR() xcd_barrier(bar)

    REP(0) PH(0) { PHASE_BEGIN(); prologue(ap, ws, lds, gw, ngw, wave, lane, gtid, ngt); }
    GRID_BAR();

    for (int s = 0; s < 3 * DEPTH; ++s) {
        const int l = s / 3, k = s - 3 * l, f = k >> 1;
        REP(1) PH(1) { PHASE_BEGIN();
            const float* xin = (s == 0) ? ap->in[0] : ap->out;
            const float* gain = (k == 1) ? ap->in[5] + (size_t)l * DM : ap->in[1] + (size_t)(l * 2 + f) * DM;
            norm_phase(xin, gain, (bf16*)(ws + WS_H), gw, ngw, lane); }
        GRID_BAR();
        if (k != 1) {
            REP(2) PH(2) { PHASE_BEGIN();
                const bf16* Bt = (const bf16*)(ws + WS_W + (size_t)l * W_LAYER + (f ? WL_GU1 : WL_GU0));
                pg8::Gemm g{(const bf16*)(ws + WS_H), Bt, M, 2 * DFF, DM}; pg8::StaticOrder S; S.init(M, 2 * DFF, G, bx);
                pg8::EpiSwiGLU E{(bf16*)(ws + WS_HZ), DFF};
                pg8::gemm_phase<pg8::EpiSwiGLU, pg8::StaticOrder, true, true>(lds, g, S, E); }
        } else {
            REP(4) PH(4) { PHASE_BEGIN();
                const bf16* Bt = (const bf16*)(ws + WS_W + (size_t)l * W_LAYER + WL_IN);
                pg8::Gemm g{(const bf16*)(ws + WS_H), Bt, M, NINP, DM}; pg8::StaticOrder S; S.init(M, NINP, G, bx);
                pg8::EpiZ E{(bf16*)(ws + WS_HZ), ZLD, (float*)(ws + WS_R), NZ / 256};
                pg8::gemm_phase<pg8::EpiZ, pg8::StaticOrder, true, true>(lds, g, S, E); }
            GRID_BAR();
            REP(5) { PH(5) { PHASE_BEGIN();
                const float* ropec = (const float*)(ws + WS_ROPE);
                qk_prepass((bf16*)(ws + WS_HZ), ap->in[10] + (size_t)l * 128, ap->in[11] + (size_t)l * 128, ropec, ropec + SEQ * 16, gw, ngw, lane); }
              for (int u = blockIdx.x; u < 3072 + 1024; u += gridDim.x) {
                if (u < 3072) { PH(6) { PHASE_BEGIN();
                    gla_g1_unit(lds, (const bf16*)(ws + WS_HZ), (const float*)(ws + WS_R), ap->in[12] + (size_t)l * 16 * 384, ap->in[13] + (size_t)l * 384, (float*)(ws + WS_H), (float*)(ws + WS_DEC), u, tid, wave, lane); } }
                else { PH(7) { PHASE_BEGIN();
                    gmlp_unit(lds, (const bf16*)(ws + WS_HZ), ap->in[8] + (size_t)l * 4 * 128 * 128, ap->in[9] + (size_t)l * 512, ap->in[7] + (size_t)l * 512, (bf16*)(ws + WS_Y), u - 3072, tid, wave, lane); } }
              } }
            GRID_BAR();
            PH(8) { PHASE_BEGIN(); gla_scan((float*)(ws + WS_H), (const float*)(ws + WS_DEC), gtid, ngt); }
            REP(12) { PH(12) { PHASE_BEGIN();
                const int vc = (G % 8 == 0) ? (bx % 8) * (G / 8) + bx / 8 : bx;
                attn_phase(lds, (const bf16*)(ws + WS_HZ), (bf16*)(ws + WS_OG), (float*)(ws + WS_LSE), vc, G, tid, wave, lane); } }
            GRID_BAR();
            REP(9) for (int u = blockIdx.x; u < 3072; u += gridDim.x) { PH(9) { PHASE_BEGIN();
                gla_g3_unit(lds, (const bf16*)(ws + WS_HZ), (const float*)(ws + WS_R), ap->in[12] + (size_t)l * 16 * 384, ap->in[13] + (size_t)l * 384, ap->in[14] + (size_t)l * 128,
                            (const float*)(ws + WS_H), (bf16*)(ws + WS_Y), u, tid, wave, lane); } }
            REP(10) PH(10) { PHASE_BEGIN(); attn_merge((const bf16*)(ws + WS_OG), (const float*)(ws + WS_LSE), (bf16*)(ws + WS_Y), gtid, ngt); }
        }
        GRID_BAR();
        REP(3) PH(3) { PHASE_BEGIN();
            const float* xin = (s == 0 && rep_ == 0) ? ap->in[0] : ap->out;
            const unsigned char* wl = ws + WS_W + (size_t)l * W_LAYER;
            const bf16* A = (k == 1) ? (const bf16*)(ws + WS_Y) : (const bf16*)(ws + WS_HZ);
            const bf16* Bt = (const bf16*)(wl + ((k == 1) ? WL_OUT : (f ? WL_D1 : WL_D0)));
            pg8::Gemm g{A, Bt, M, DM, (k == 1) ? DM : DFF}; pg8::StaticOrder S; S.init(M, DM, G, bx);
            pg8::EpiResid E{xin, ap->out, DM, (rep_ != 0) ? 0.0f : (k == 1) ? 1.0f : 0.5f};
            pg8::gemm_phase<pg8::EpiResid, pg8::StaticOrder, true, true>(lds, g, S, E); }
        GRID_BAR();
    }
}

extern "C" void kernel_launch(void* const* d_in, const int* in_sizes, int n_in, void* d_out, int out_size, void* d_ws, size_t ws_size, hipStream_t stream) {
    static int grid = 0;
    if (grid == 0) {
        if (n_in != 16 || in_sizes[0] != M * DM || out_size != M * DM || ws_size < WS_END) { fprintf(stderr, "kernel_launch: shape/workspace mismatch (n_in %d, ws %zu, need %zu)\n", n_in, ws_size, (size_t)WS_END); grid = -1; return; }
        int dev = 0, cus = 0, per_cu = 0;
        if (hipGetDevice(&dev) != hipSuccess || hipDeviceGetAttribute(&cus, hipDeviceAttributeMultiprocessorCount, dev) != hipSuccess) { grid = -1; return; }
        if (hipFuncSetAttribute((const void*)hymba_fwd, hipFuncAttributeMaxDynamicSharedMemorySize, LDS_BYTES) != hipSuccess) { fprintf(stderr, "kernel_launch: hipFuncSetAttribute failed\n"); grid = -1; return; }
        if (hipOccupancyMaxActiveBlocksPerMultiprocessor(&per_cu, (const void*)hymba_fwd, NWAVES * 64, LDS_BYTES) != hipSuccess || per_cu < 1) fprintf(stderr, "kernel_launch: occupancy query says %d\n", per_cu);
        (void)hipGetLastError();
        grid = cus;
    }
    if (grid < 0) return;
    if (hipMemsetAsync((char*)d_ws + WS_CTL, 0, CTL_ZERO_BYTES, stream) != hipSuccess) return;
    Args a{};
    for (int i = 0; i < 16; ++i) a.in[i] = (const float*)d_in[i];
    a.out = (float*)d_out; a.ws = (unsigned char*)d_ws;
    for (int i = 0; i < 16; ++i) a.inv_freq[i] = (float)std::pow(500000.0, -(double)i / 16.0);
    hipLaunchKernelGGL(hymba_fwd, dim3(grid), dim3(NWAVES * 64), LDS_BYTES, stream, a);
}
```

```cpp
#include <hip/hip_runtime.h>
#include <cstdio>
#include <cstdint>
#include <cmath>
namespace pg8 {
#define PG8_LAS __attribute__((address_space(3)))
typedef unsigned short bf16_t;
typedef short bf16x8 __attribute__((ext_vector_type(8)));
typedef float f32x4 __attribute__((ext_vector_type(4)));
typedef unsigned u32x4 __attribute__((ext_vector_type(4)));
constexpr int BM = 256, BK = 64, HALF = 128, HTB = HALF * BK * 2  , STAGE_BYTES = 8 * HTB, NXCD = 8, WGM = 8;
constexpr int XCH_OFF = 143360;

__host__ __device__ __forceinline__ int lds_byte(int r, int c) { const int st = (r >> 4) * 2 + (c >> 5), rr = r & 15, cc = c & 31, ob = rr * 64 + cc * 2; return st * 1024 + (ob ^ (((ob >> 9) & 1) << 5)); }
__host__ __device__ __forceinline__ void stage_rc(int b, int& R, int& C) { const int st = b / 1024, sb = b % 1024, swz = sb ^ (((sb >> 9) & 1) << 5); R = (st >> 1) * 16 + swz / 64; C = (st & 1) * 32 + (swz % 64) / 2; }
__host__ __device__ __forceinline__ int perm32(int rho) { const int n = rho >> 4, i = rho & 15; return 8 * (i >> 2) + 4 * n + (i & 3); }

struct Unit { int pm, pn; };
struct Gemm { const bf16_t* A; const bf16_t* Bt; int M, N, K; };

struct StaticOrder {
    int nM, nN, nwg, G, c, wgm;
    __host__ __device__ void init(int M, int N, int G_, int c_, int wgm_ = WGM) { nM = M / BM; nN = N / BM; nwg = nM * nN; G = G_; c = c_; wgm = wgm_; }
    __host__ __device__ bool next(int i, Unit& u) const {
        const long L = (long)i * G + c; if (L >= nwg) return false;
        int wgid = (int)L; { const int q = nwg / NXCD, r = nwg % NXCD, xcd = wgid % NXCD, off = wgid / NXCD; wgid = (xcd < r ? xcd * (q + 1) : r * (q + 1) + (xcd - r) * q) + off; }
        const int nig = wgm * nN, gid = wgid / nig, fm = gid * wgm, gsz = (nM - fm) < wgm ? (nM - fm) : wgm;
        u.pm = fm + ((wgid % nig) % gsz); u.pn = (wgid % nig) / gsz; return true;
    }
    __device__ __forceinline__ void a_ready(const Unit&) const {}
    __device__ __forceinline__ void done(const Unit&) const {}
};
typedef __bf16 bf16x2_t __attribute__((ext_vector_type(2)));
typedef float f32x2_t __attribute__((ext_vector_type(2)));
__device__ __forceinline__ unsigned cvt_pk_bf16(float lo, float hi) { f32x2_t v = {lo, hi}; bf16x2_t b = __builtin_convertvector(v, bf16x2_t); return __builtin_bit_cast(unsigned, b); }
typedef float f32x2 __attribute__((ext_vector_type(2)));
#ifndef RS_ASM
#define RS_ASM 0
#endif
template <class Epi, class Sched, bool ALIGN_EPI = false, bool SP2 = false>
__device__ __forceinline__ void gemm_phase(PG8_LAS unsigned char* lds, const Gemm g, const Sched& S, const Epi& E) {
    int tid_l = threadIdx.x; asm volatile("" : "+v"(tid_l));
    const int tid = tid_l, wid = __builtin_amdgcn_readfirstlane(tid >> 6), lane = tid & 63, wr = wid >> 2, wc = wid & 3, fr = lane & 15, fq = lane >> 4;
    const int K = g.K, nt = K / BK;
    unsigned voffA[2], voffB[2];
#pragma unroll
    for (int i = 0; i < 2; ++i) { int R, C; stage_rc(tid * 16 + i * 8192, R, C); const int Rb = Epi::PERM ? ((R & ~31) + perm32(R & 31)) : R;
        voffA[i] = (unsigned)(R * K + C) * 2u; voffB[i] = (unsigned)(Rb * K + C) * 2u; }
    const size_t kstep = (size_t)(BK * 2);
    const size_t hstep = (size_t)HALF * K * 2;
    const size_t tstep = 2 * hstep;
    const unsigned ldsw = (unsigned)wid * 1024u;
    const int aoff = lds_byte(wr * 64 + fr, fq * 8), boff = lds_byte(wc * 32 + fr, fq * 8);
#define PG8_SA(b, h) (((b) * 2 + (h)) * HTB)
#define PG8_SB(b, h) ((4 + (b) * 2 + (h)) * HTB)
#define PG8_STAGE(bufoff, gbase, voff) do { _Pragma("unroll") for (int _i = 0; _i < 2; ++_i) \
        __builtin_amdgcn_global_load_lds((const unsigned*)((const char*)(gbase) + (voff)[_i]), (PG8_LAS unsigned*)(lds + (bufoff) + ldsw + _i * 8192), 16, 0, 0); } while (0)
#define PG8_LDA(dst, b, h) do { _Pragma("unroll") for (int m = 0; m < 4; ++m) _Pragma("unroll") for (int k = 0; k < 2; ++k) dst[m][k] = *(const PG8_LAS bf16x8*)(lds + PG8_SA(b, h) + aoff + m * 2048 + k * 1024); } while (0)
#define PG8_LDB(dst, b, h) do { _Pragma("unroll") for (int n = 0; n < 2; ++n) _Pragma("unroll") for (int k = 0; k < 2; ++k) dst[n][k] = *(const PG8_LAS bf16x8*)(lds + PG8_SB(b, h) + boff + n * 2048 + k * 1024); } while (0)
#define PG8_MMA(ai, bj, At, Bt) do { __builtin_amdgcn_s_setprio(1); _Pragma("unroll") for (int k = 0; k < 2; ++k) _Pragma("unroll") for (int m = 0; m < 4; ++m) _Pragma("unroll") for (int n = 0; n < 2; ++n) \
        acc[ai][bj][m][n] = __builtin_amdgcn_mfma_f32_16x16x32_bf16(Bt[n][k], At[m][k], acc[ai][bj][m][n], 0, 0, 0); __builtin_amdgcn_s_setprio(0); } while (0)
#define PG8_WAIT_V(n) asm volatile("s_waitcnt vmcnt(" #n ")" ::: "memory")
#define PG8_WAIT_L(n) asm volatile("s_waitcnt lgkmcnt(" #n ")" ::: "memory")
#define PG8_BAR __builtin_amdgcn_s_barrier()
#define PG8_SCHED __builtin_amdgcn_sched_barrier(0)
    Unit cur, nxt; int ui = 0;
    if (!S.next(0, cur)) return;
    f32x4 acc[2][2][4][2];
#pragma unroll
    for (int a = 0; a < 2; ++a)
#pragma unroll
        for (int b = 0; b < 2; ++b)
#pragma unroll
            for (int m = 0; m < 4; ++m)
#pragma unroll
                for (int n = 0; n < 2; ++n) acc[a][b][m][n] = (f32x4){0.f, 0.f, 0.f, 0.f};
    bf16x8 At[4][2], B0[2][2], B1[2][2];
    unsigned long long rsq64 = 0ull;
    PG8_LAS float* const rstab = (PG8_LAS float*)(lds + STAGE_BYTES);
    const char* cA = (const char*)g.A + (size_t)cur.pm * tstep; const char* cB = (const char*)g.Bt + (size_t)cur.pn * tstep;
    S.a_ready(cur);
    if constexpr (SP2) {
        PG8_STAGE(PG8_SB(0, 0), cB, voffB); PG8_STAGE(PG8_SB(0, 1), cB + hstep, voffB); PG8_STAGE(PG8_SA(0, 0), cA, voffA); PG8_STAGE(PG8_SA(0, 1), cA + hstep, voffA);
        if (wr == 1) PG8_BAR;
        PG8_WAIT_V(2); PG8_BAR;
        PG8_STAGE(PG8_SB(1, 0), cB + kstep, voffB); PG8_STAGE(PG8_SA(1, 0), cA + kstep, voffA); PG8_STAGE(PG8_SB(1, 1), cB + hstep + kstep, voffB);
        PG8_WAIT_V(6); PG8_BAR;
    } else {
        PG8_STAGE(PG8_SB(0, 0), cB, voffB); PG8_STAGE(PG8_SA(0, 0), cA, voffA); PG8_STAGE(PG8_SB(0, 1), cB + hstep, voffB); PG8_STAGE(PG8_SA(0, 1), cA + hstep, voffA);
        if (wr == 1) PG8_BAR;
        PG8_WAIT_V(4); PG8_BAR;
        PG8_STAGE(PG8_SB(1, 0), cB + kstep, voffB); PG8_STAGE(PG8_SA(1, 0), cA + kstep, voffA); PG8_STAGE(PG8_SB(1, 1), cB + hstep + kstep, voffB);
        PG8_WAIT_V(6); PG8_BAR;
    }
    for (;;) {
        const bool has_next = S.next(ui + 1, nxt);
        const char* nA = has_next ? (const char*)g.A + (size_t)nxt.pm * tstep : cA; const char* nB = has_next ? (const char*)g.Bt + (size_t)nxt.pn * tstep : cB;
        for (int t = 0; t < nt; t += 2) {
            const bool last = (t == nt - 2);
            const char* a1 = cA + (size_t)(t + 1) * kstep;
            const char* a2 = last ? nA : cA + (size_t)(t + 2) * kstep; const char* b2 = last ? nB : cB + (size_t)(t + 2) * kstep;
            const char* a3 = a2 + kstep; const char* b3 = b2 + kstep;
            if (last && has_next) S.a_ready(nxt);
            if constexpr (Epi::ROWSCALE) { if (last && wr == 0) { const unsigned long long* rp = E.ss + cur.pm * BM + tid;
                asm volatile("global_load_dwordx2 %0, %1, off" : "+v"(rsq64) : "v"(rp) : "memory"); } }
            if constexpr (SP2) {
            PG8_LDB(B0, 0, 0); PG8_LDB(B1, 0, 1); PG8_SCHED; PG8_LDA(At, 0, 0); PG8_STAGE(PG8_SA(1, 1), a1 + hstep, voffA);
            PG8_WAIT_V(8); PG8_WAIT_L(0); PG8_BAR; PG8_MMA(0, 0, At, B0); PG8_MMA(0, 1, At, B1); PG8_BAR; PG8_SCHED;
            PG8_LDA(At, 0, 1); PG8_STAGE(PG8_SB(0, 0), b2, voffB); PG8_STAGE(PG8_SB(0, 1), b2 + hstep, voffB); PG8_STAGE(PG8_SA(0, 0), a2, voffA);
            PG8_WAIT_V(8); PG8_WAIT_L(0); PG8_BAR; PG8_MMA(1, 0, At, B0); PG8_MMA(1, 1, At, B1); PG8_BAR; PG8_SCHED;
            PG8_LDB(B0, 1, 0); PG8_LDB(B1, 1, 1); PG8_SCHED; PG8_LDA(At, 1, 0); PG8_STAGE(PG8_SA(0, 1), a2 + hstep, voffA);
            PG8_WAIT_V(8); PG8_WAIT_L(0); PG8_BAR; PG8_MMA(0, 0, At, B0); PG8_MMA(0, 1, At, B1); PG8_BAR; PG8_SCHED;
            if constexpr (Epi::ROWSCALE) { if (last && wr == 0) {
                const float ssum = (float)rsq64 * (1.0f / 16777216.0f);
                rstab[(((tid >> 6) & 1) * 16 + (tid & 15)) * 8 + (tid >> 7) * 4 + ((tid >> 4) & 3)] = __builtin_amdgcn_rsqf(ssum * (1.f / 2048.f) + 1e-6f); } }
            PG8_LDA(At, 1, 1); PG8_STAGE(PG8_SB(1, 0), b3, voffB); PG8_STAGE(PG8_SB(1, 1), b3 + hstep, voffB); PG8_STAGE(PG8_SA(1, 0), a3, voffA);
            PG8_WAIT_V(8); PG8_WAIT_L(0); PG8_BAR; PG8_MMA(1, 0, At, B0); PG8_MMA(1, 1, At, B1); PG8_BAR; PG8_SCHED;
            } else {
            PG8_LDB(B0, 0, 0); PG8_SCHED; PG8_LDA(At, 0, 0); PG8_STAGE(PG8_SA(1, 1), a1 + hstep, voffA);
            PG8_WAIT_L(8); PG8_BAR; PG8_WAIT_L(0); PG8_MMA(0, 0, At, B0); PG8_BAR; PG8_SCHED;
            PG8_LDB(B1, 0, 1); PG8_STAGE(PG8_SB(0, 0), b2, voffB);
            PG8_BAR; PG8_WAIT_L(0); PG8_MMA(0, 1, At, B1); PG8_BAR;
            PG8_LDA(At, 0, 1); PG8_STAGE(PG8_SA(0, 0), a2, voffA);
            PG8_BAR; PG8_WAIT_L(0); PG8_MMA(1, 0, At, B0); PG8_BAR; PG8_SCHED;
            PG8_STAGE(PG8_SB(0, 1), b2 + hstep, voffB);
            PG8_WAIT_V(6); PG8_BAR; PG8_MMA(1, 1, At, B1); PG8_BAR;
            PG8_LDB(B0, 1, 0); PG8_SCHED; PG8_LDA(At, 1, 0); PG8_STAGE(PG8_SA(0, 1), a2 + hstep, voffA);
            PG8_WAIT_L(8); PG8_BAR; PG8_WAIT_L(0); PG8_MMA(0, 0, At, B0); PG8_BAR; PG8_SCHED;
            PG8_LDB(B1, 1, 1); PG8_STAGE(PG8_SB(1, 0), b3, voffB);
            PG8_BAR; PG8_WAIT_L(0); PG8_MMA(0, 1, At, B1); PG8_BAR;
            PG8_LDA(At, 1, 1); PG8_STAGE(PG8_SA(1, 0), a3, voffA);
            PG8_BAR; PG8_WAIT_L(0); PG8_MMA(1, 0, At, B0); PG8_BAR; PG8_SCHED;
            PG8_STAGE(PG8_SB(1, 1), b3 + hstep, voffB);
            PG8_WAIT_V(6); PG8_BAR; PG8_MMA(1, 1, At, B1); PG8_BAR;
            }
        }
        if constexpr (ALIGN_EPI) { if (wr == 0) PG8_BAR; }
        if constexpr (!Epi::AFTER_DRAIN) { if constexpr (Epi::ROWSCALE) {
            const f32x4 ra = *(const PG8_LAS f32x4*)(rstab + (wr * 16 + fr) * 8), rb = *(const PG8_LAS f32x4*)(rstab + (wr * 16 + fr) * 8 + 4);
            const float rs[8] = {ra[0], ra[1], ra[2], ra[3], rb[0], rb[1], rb[2], rb[3]};
            if constexpr (Epi::NEEDS_LDS) E(acc, cur, wr, wc, fr, fq, rs, (PG8_LAS float*)(lds + XCH_OFF)); else E(acc, cur, wr, wc, fr, fq, rs); } else E(acc, cur, wr, wc, fr, fq); S.done(cur); }
        if (!has_next) break;
#pragma unroll
        for (int a = 0; a < 2; ++a)
#pragma unroll
            for (int b = 0; b < 2; ++b)
#pragma unroll
                for (int m = 0; m < 4; ++m)
#pragma unroll
                    for (int n = 0; n < 2; ++n) acc[a][b][m][n] = (f32x4){0.f, 0.f, 0.f, 0.f};
        cur = nxt; cA = nA; cB = nB; ++ui;
        if constexpr (ALIGN_EPI) { if (wr == 1) PG8_BAR; }
    }
    PG8_WAIT_V(0);
    if constexpr (!ALIGN_EPI) { if (wr == 0) PG8_BAR; }
    PG8_BAR;
    if constexpr (Epi::AFTER_DRAIN) { E.fused(acc, cur, wr, wc, fr, fq, lds, wid, lane); S.done(cur); }
#undef PG8_SA
#undef PG8_SB
#undef PG8_STAGE
#undef PG8_LDA
#undef PG8_LDB
#undef PG8_MMA
#undef PG8_WAIT_V
#undef PG8_WAIT_L
#undef PG8_BAR
#undef PG8_SCHED
}
}
namespace pg8 {
struct EpiSwiGLU {
    static constexpr bool PERM = true, AFTER_DRAIN = false, ROWSCALE = true, NEEDS_LDS = false;
    bf16_t* O; int ldc; const unsigned long long* ss;
    __device__ __forceinline__ void operator()(const f32x4 (&acc)[2][2][4][2], const Unit& u, int wr, int wc, int fr, int fq, const float (&rs)[8]) const {
        const int row0 = u.pm * BM + wr * 64 + fr, col0 = u.pn * HALF + wc * 32 + 8 * fq;
#pragma unroll
        for (int ai = 0; ai < 2; ++ai)
#pragma unroll
            for (int m = 0; m < 4; ++m) { bf16_t* rowp = O + (size_t)(row0 + ai * HALF + m * 16) * ldc + col0;
                const float rstd = rs[ai * 4 + m];
                float h[8];
#pragma unroll
                for (int n = 0; n < 2; ++n)
#pragma unroll
                    for (int j = 0; j < 4; ++j) { const float g = acc[ai][0][m][n][j] * rstd, up = acc[ai][1][m][n][j] * rstd;
                        h[4 * n + j] = g * __builtin_amdgcn_rcpf(1.0f + __expf(-g)) * up; }
                u32x4 w; w.x = cvt_pk_bf16(h[0], h[1]); w.y = cvt_pk_bf16(h[2], h[3]); w.z = cvt_pk_bf16(h[4], h[5]); w.w = cvt_pk_bf16(h[6], h[7]);
                __builtin_nontemporal_store(w, (u32x4*)rowp); }
    }
};
struct EpiResid {
    static constexpr bool PERM = true, AFTER_DRAIN = false, ROWSCALE = false;
    const void* base; void* out; unsigned long long* ssq; int base_f32, out_f32; float scale;
    static constexpr int row_off = 0;
    static __device__ __forceinline__ void row_sum(float t, int j, int fq, float& ta, float& tb) {
        { const auto r = __builtin_amdgcn_permlane16_swap(__float_as_uint(t), __float_as_uint(t), false, false); t = __uint_as_float(r[0]) + __uint_as_float(r[1]); }
        { const auto r = __builtin_amdgcn_permlane32_swap(__float_as_uint(t), __float_as_uint(t), false, false); t = __uint_as_float(r[0]) + __uint_as_float(r[1]); }
        if (j & 1) tb = (fq == (j >> 1)) ? t : tb; else ta = (fq == (j >> 1)) ? t : ta;
    }
    __device__ __forceinline__ void operator()(const f32x4 (&acc)[2][2][4][2], const Unit& u, int wr, int wc, int fr, int fq) const {
        const int row0 = u.pm * BM + wr * 64 + fr, col0 = u.pn * BM + wc * 32 + 8 * fq;
        const unsigned e0 = (unsigned)((row_off + row0) * 2048 + col0);
        const bool bf = base_f32 != 0, of = out_f32 != 0;
        float ta = 0.f, tb = 0.f;
        if (!bf) {
            u32x4 raw[2][4][2];
#pragma unroll
            for (int ai = 0; ai < 2; ++ai)
#pragma unroll
                for (int m = 0; m < 4; ++m)
#pragma unroll
                    for (int bj = 0; bj < 2; ++bj) raw[ai][m][bj] = *(const u32x4*)((const bf16_t*)base + e0 + (unsigned)((ai * HALF + m * 16) * 2048 + bj * HALF));
#pragma unroll
            for (int ai = 0; ai < 2; ++ai)
#pragma unroll
                for (int m = 0; m < 4; ++m) { float rsum = 0.f;
#pragma unroll
                    for (int bj = 0; bj < 2; ++bj) { const unsigned eo = e0 + (unsigned)((ai * HALF + m * 16) * 2048 + bj * HALF); const u32x4 w = raw[ai][m][bj];
                        const f32x4 b0 = (f32x4){__uint_as_float(w.x << 16), __uint_as_float(w.x & 0xffff0000u), __uint_as_float(w.y << 16), __uint_as_float(w.y & 0xffff0000u)};
                        const f32x4 b1 = (f32x4){__uint_as_float(w.z << 16), __uint_as_float(w.z & 0xffff0000u), __uint_as_float(w.w << 16), __uint_as_float(w.w & 0xffff0000u)};
                        const f32x4 v0 = b0 + acc[ai][bj][m][0] * scale, v1 = b1 + acc[ai][bj][m][1] * scale;
                        rsum += (v0[0] * v0[0] + v0[1] * v0[1]) + (v0[2] * v0[2] + v0[3] * v0[3]) + (v1[0] * v1[0] + v1[1] * v1[1]) + (v1[2] * v1[2] + v1[3] * v1[3]);
                        if (of) { __builtin_nontemporal_store(v0, (f32x4*)((float*)out + eo)); __builtin_nontemporal_store(v1, (f32x4*)((float*)out + eo + 4)); }
                        else { u32x4 o; o.x = cvt_pk_bf16(v0[0], v0[1]); o.y = cvt_pk_bf16(v0[2], v0[3]); o.z = cvt_pk_bf16(v1[0], v1[1]); o.w = cvt_pk_bf16(v1[2], v1[3]);
                            *(u32x4*)((bf16_t*)out + eo) = o; } }
                    row_sum(rsum, ai * 4 + m, fq, ta, tb); }
        } else {
#pragma unroll
            for (int ai = 0; ai < 2; ++ai) {
                f32x4 b0[4][2], b1[4][2];
#pragma unroll
                for (int m = 0; m < 4; ++m)
#pragma unroll
                    for (int bj = 0; bj < 2; ++bj) { const unsigned eo = e0 + (unsigned)((ai * HALF + m * 16) * 2048 + bj * HALF);
                        b0[m][bj] = __builtin_nontemporal_load((const f32x4*)((const float*)base + eo)); b1[m][bj] = __builtin_nontemporal_load((const f32x4*)((const float*)base + eo + 4)); }
#pragma unroll
                for (int m = 0; m < 4; ++m) { float rsum = 0.f;
#pragma unroll
                    for (int bj = 0; bj < 2; ++bj) { const unsigned eo = e0 + (unsigned)((ai * HALF + m * 16) * 2048 + bj * HALF);
                        const f32x4 v0 = b0[m][bj] + acc[ai][bj][m][0] * scale, v1 = b1[m][bj] + acc[ai][bj][m][1] * scale;
                        rsum += (v0[0] * v0[0] + v0[1] * v0[1]) + (v0[2] * v0[2] + v0[3] * v0[3]) + (v1[0] * v1[0] + v1[1] * v1[1]) + (v1[2] * v1[2] + v1[3] * v1[3]);
                        if (of) { __builtin_nontemporal_store(v0, (f32x4*)((float*)out + eo)); __builtin_nontemporal_store(v1, (f32x4*)((float*)out + eo + 4)); }
                        else { u32x4 o; o.x = cvt_pk_bf16(v0[0], v0[1]); o.y = cvt_pk_bf16(v0[2], v0[3]); o.z = cvt_pk_bf16(v1[0], v1[1]); o.w = cvt_pk_bf16(v1[2], v1[3]);
                            *(u32x4*)((bf16_t*)out + eo) = o; } }
                    row_sum(rsum, ai * 4 + m, fq, ta, tb); }
                __builtin_amdgcn_sched_barrier(0);
            }
        }
        { unsigned long long* sp = ssq + row0 + (fq >> 1) * HALF + (fq & 1) * 32;
            __hip_atomic_fetch_add(sp, (unsigned long long)(ta * 16777216.0f), __ATOMIC_RELAXED, __HIP_MEMORY_SCOPE_AGENT);
            __hip_atomic_fetch_add(sp + 16, (unsigned long long)(tb * 16777216.0f), __ATOMIC_RELAXED, __HIP_MEMORY_SCOPE_AGENT); }
    }
};
struct EpiZ {
    static constexpr bool PERM = true, AFTER_DRAIN = false, ROWSCALE = true, NEEDS_LDS = true;
    bf16_t* Z; const unsigned long long* ss; const float* qg; const float* kg; int ldz;
    __device__ __forceinline__ void operator()(const f32x4 (&acc)[2][2][4][2], const Unit& u, int wr, int wc, int fr, int fq, const float (&rs)[8], PG8_LAS float* xch) const {
        const int row0 = u.pm * BM + wr * 64 + fr;
        const int col0 = u.pn * BM + wc * 32 + 8 * fq;
        if (u.pn < 4 || u.pn >= 10) {
#pragma unroll
            for (int ai = 0; ai < 2; ++ai)
#pragma unroll
                for (int m = 0; m < 4; ++m) { bf16_t* rowp = Z + (size_t)(row0 + ai * HALF + m * 16) * ldz + col0;
                    const float rstd = rs[ai * 4 + m];
#pragma unroll
                    for (int bj = 0; bj < 2; ++bj) { const f32x4 v0 = acc[ai][bj][m][0] * rstd, v1 = acc[ai][bj][m][1] * rstd;
                        u32x4 w; w.x = cvt_pk_bf16(v0[0], v0[1]); w.y = cvt_pk_bf16(v0[2], v0[3]); w.z = cvt_pk_bf16(v1[0], v1[1]); w.w = cvt_pk_bf16(v1[2], v1[3]);
                        __builtin_nontemporal_store(w, (u32x4*)(rowp + bj * HALF)); } }
            return;
        }
        asm volatile("" : "+v"(fr), "+v"(fq));
        const bool isq = u.pn < 7;
        const float* gp = (isq ? qg : kg) + wc * 32 + 8 * fq;
        const f32x4 g0 = *(const f32x4*)gp, g1 = *(const f32x4*)(gp + 4);
        float keep[2][2];
#pragma unroll
        for (int ai = 0; ai < 2; ++ai)
#pragma unroll
            for (int m = 0; m < 4; ++m) { const float rstd = rs[ai * 4 + m];
#pragma unroll
                for (int bj = 0; bj < 2; ++bj) { const f32x4 v0 = acc[ai][bj][m][0] * rstd, v1 = acc[ai][bj][m][1] * rstd;
                    float t = (v0[0] * v0[0] + v0[1] * v0[1]) + (v0[2] * v0[2] + v0[3] * v0[3]) + (v1[0] * v1[0] + v1[1] * v1[1]) + (v1[2] * v1[2] + v1[3] * v1[3]);
                    { const auto r = __builtin_amdgcn_permlane16_swap(__float_as_uint(t), __float_as_uint(t), false, false); t = __uint_as_float(r[0]) + __uint_as_float(r[1]); }
                    { const auto r = __builtin_amdgcn_permlane32_swap(__float_as_uint(t), __float_as_uint(t), false, false); t = __uint_as_float(r[0]) + __uint_as_float(r[1]); }
                    if (m == 0) keep[ai][bj] = t; else keep[ai][bj] = (fq == m) ? t : keep[ai][bj]; } }
#pragma unroll
        for (int ai = 0; ai < 2; ++ai)
#pragma unroll
            for (int bj = 0; bj < 2; ++bj) xch[(ai * HALF + wr * 64 + fq * 16 + fr) * 8 + bj * 4 + wc] = keep[ai][bj];
        asm volatile("s_waitcnt lgkmcnt(0)" ::: "memory");
        __builtin_amdgcn_s_barrier();
        const float qscale = isq ? 0.08838834764831845f : 1.0f;
#pragma unroll
        for (int ai = 0; ai < 2; ++ai)
#pragma unroll
            for (int m = 0; m < 4; ++m) { const int rt = ai * HALF + wr * 64 + m * 16 + fr; bf16_t* rowp = Z + (size_t)(u.pm * BM + rt) * ldz + col0;
                const float rstd = rs[ai * 4 + m];
#pragma unroll
                for (int bj = 0; bj < 2; ++bj) {
                    const f32x4 px = *(const PG8_LAS f32x4*)(xch + rt * 8 + bj * 4);
                    const float rq = __builtin_amdgcn_rsqf(((px[0] + px[1]) + (px[2] + px[3])) * (1.f / 128.f) + 1e-6f) * rstd * qscale;
                    f32x4 v0 = acc[ai][bj][m][0] * rq * g0, v1 = acc[ai][bj][m][1] * rq * g1;
                    u32x4 w; w.x = cvt_pk_bf16(v0[0], v0[1]); w.y = cvt_pk_bf16(v0[2], v0[3]); w.z = cvt_pk_bf16(v1[0], v1[1]); w.w = cvt_pk_bf16(v1[2], v1[3]);
                    __builtin_nontemporal_store(w, (u32x4*)(rowp + bj * HALF)); } }
    }
};
}
constexpr int NWAVES = 8;
constexpr int BATCH = 4, SEQ = 8192, DM = 2048, DFF = 5632, DEPTH = 4;
constexpr int M = BATCH * SEQ;
constexpr int NIN = 5648, NZ = 5632, NINP = 5888;
constexpr int ZLD = NZ;
constexpr int ZC_AU = 0, ZC_AV = 512, ZC_BQ = 1024, ZC_BK = 1792, ZC_BV = 2560, ZC_CQ = 3328, ZC_CK = 3712, ZC_CV = 4096, ZC_CG = 4864;
constexpr int YC_A = 0, YC_B = 512, YC_C = 1280;
constexpr int NCHUNK = M / 64;
constexpr float EPS = 1e-6f;

constexpr size_t MiB = 1u << 20;
constexpr size_t WS_CTL = 0, CTL_ZERO_BYTES = 1 * MiB;
constexpr size_t WS_ROPE = 1 * MiB;
constexpr size_t WS_DEC = 4 * MiB;
constexpr size_t WS_LSE = 5 * MiB;
constexpr size_t WS_W = 8 * MiB;
constexpr size_t W_GU = (size_t)2 * DFF * DM * 2, W_D = (size_t)DM * DFF * 2, W_IN = (size_t)NINP * DM * 2, W_OUT = (size_t)DM * DM * 2;
constexpr size_t WL_GU0 = 0, WL_D0 = WL_GU0 + W_GU, WL_GU1 = WL_D0 + W_D, WL_D1 = WL_GU1 + W_GU, WL_IN = WL_D1 + W_D, WL_OUT = WL_IN + W_IN, W_LAYER = WL_OUT + W_OUT;
constexpr size_t WS_H = WS_W + DEPTH * W_LAYER;
constexpr size_t WS_HZ = WS_H + (size_t)M * DM * 2;
constexpr size_t WS_Y = WS_HZ + (size_t)M * DFF * 2;
constexpr size_t WS_OG = WS_Y + (size_t)M * DM * 2;
constexpr size_t WS_QD = WS_OG + (size_t)3 * M * 768 * 2;
constexpr size_t WS_KD = WS_QD + (size_t)M * 384 * 2;
constexpr size_t WS_SB = WS_KD + (size_t)M * 384 * 2;
constexpr size_t WS_SS = WS_SB + (size_t)NCHUNK * 6 * 8192 * 2;
constexpr size_t WS_END = WS_SS + (size_t)13 * M * 8;
constexpr float SS_SCALE = 16777216.0f, SS_INV = 1.0f / 16777216.0f;
static_assert(W_LAYER == 163 * MiB && WS_H == 660 * MiB && (size_t)NCHUNK * 6 * 128 * 64 * 4 <= (size_t)M * DM * 2, "ws map");
constexpr int CW_BAR = 4096;

constexpr int SCR_BYTES = 139264;
constexpr int LDSCTL_OFF = SCR_BYTES;
constexpr int LDSX_OFF = 143360;
constexpr int LDS_BYTES = 151552;
static_assert(LDSX_OFF == pg8::XCH_OFF, "lds");
static_assert(pg8::STAGE_BYTES <= SCR_BYTES, "lds");

#define GAS __attribute__((address_space(1)))
#define LAS __attribute__((address_space(3)))
typedef unsigned short bf16;
typedef unsigned v4u __attribute__((ext_vector_type(4)));
typedef unsigned v2u __attribute__((ext_vector_type(2)));
typedef float f32x4 __attribute__((ext_vector_type(4)));
typedef short bf16x8 __attribute__((ext_vector_type(8)));
typedef short s16x4 __attribute__((ext_vector_type(4)));
#define LDS_WAIT() asm volatile("s_waitcnt lgkmcnt(0)" ::: "memory")
__device__ __forceinline__ float bflo(unsigned w) { return __uint_as_float(w << 16); }
__device__ __forceinline__ float bfhi(unsigned w) { return __uint_as_float(w & 0xffff0000u); }
__device__ __forceinline__ float bf1(bf16 b) { return __uint_as_float(((unsigned)b) << 16); }
__device__ __forceinline__ unsigned pk2(float lo, float hi) { return pg8::cvt_pk_bf16(lo, hi); }
__device__ __forceinline__ bf16 f2bf(float f) { return (bf16)(pg8::cvt_pk_bf16(f, 0.f) & 0xffffu); }
__device__ __forceinline__ void unpack8(const v4u w, float (&f)[8]) { f[0] = bflo(w.x); f[1] = bfhi(w.x); f[2] = bflo(w.y); f[3] = bfhi(w.y); f[4] = bflo(w.z); f[5] = bfhi(w.z); f[6] = bflo(w.w); f[7] = bfhi(w.w); }
__device__ __forceinline__ v4u pack8(const float (&f)[8]) { v4u w; w.x = pk2(f[0], f[1]); w.y = pk2(f[2], f[3]); w.z = pk2(f[4], f[5]); w.w = pk2(f[6], f[7]); return w; }
__device__ __forceinline__ float gelu_tanh(float x) {
    const float u = 0.7978845608028654f * (x + 0.044715f * x * x * x);
    const float e = __expf(2.0f * u);
    const float th = 1.0f - 2.0f * __builtin_amdgcn_rcpf(1.0f + e);
    return 0.5f * x * (1.0f + th);
}
__device__ __forceinline__ float silu_f(float x) { return x * __builtin_amdgcn_rcpf(1.0f + __expf(-x)); }
__device__ __forceinline__ bf16x8 lds_row8(const LAS unsigned char* p) { return *(const LAS bf16x8*)p; }
typedef short v4i16_t __attribute__((ext_vector_type(4)));
__device__ __forceinline__ s16x4 lds_tr4(const LAS unsigned char* p) { return __builtin_bit_cast(s16x4, __builtin_amdgcn_ds_read_tr16_b64_v4i16((LAS v4i16_t*)p)); }
__device__ __forceinline__ bf16x8 cat8(s16x4 lo, s16x4 hi) { return __builtin_shufflevector(lo, hi, 0, 1, 2, 3, 4, 5, 6, 7); }
#define MFMA16(a, b, c) __builtin_amdgcn_mfma_f32_16x16x32_bf16((a), (b), (c), 0, 0, 0)
__device__ __forceinline__ v4u widen_pair(v2u a, v2u b) {
    const auto rx = __builtin_amdgcn_permlane16_swap(a.x, b.x, false, false); const auto ry = __builtin_amdgcn_permlane16_swap(a.y, b.y, false, false);
    v4u w; w.x = rx[0]; w.y = ry[0]; w.z = rx[1]; w.w = ry[1]; return w;
}
__device__ __forceinline__ void unwiden_pair(v4u w, v2u& a, v2u& b) {
    const auto rx = __builtin_amdgcn_permlane16_swap(w.x, w.z, false, false); const auto ry = __builtin_amdgcn_permlane16_swap(w.y, w.w, false, false);
    a.x = rx[0]; a.y = ry[0]; b.x = rx[1]; b.y = ry[1];
}
__device__ __forceinline__ int wide_col(int g4) { return (g4 & 1) ? 16 + 4 * (g4 - 1) : 4 * g4; }

#define XB_TMO      128
#define XB_XCNT(j)  (256  + 64 * (j))
#define XB_XSUB(j)  (1280 + 64 * (j))
#define XB_XGEN(j)  (2304 + 64 * (j))
#define XB_TOP      3328
#define XB_TOPGEN   3392
#define XCD_BAR_WORDS 3456
#define XB_SPIN_CAP (1u << 21)

__device__ __forceinline__ unsigned xb_ld(unsigned* p)              { return __hip_atomic_load(p, __ATOMIC_RELAXED, __HIP_MEMORY_SCOPE_AGENT); }
__device__ __forceinline__ unsigned xb_add(unsigned* p, unsigned v) { return __hip_atomic_fetch_add(p, v, __ATOMIC_RELAXED, __HIP_MEMORY_SCOPE_AGENT); }
__device__ __forceinline__ unsigned xb_xcc_id() { return (unsigned)__builtin_amdgcn_s_getreg((3 << 11) | 20) & 0xFu; }
#define XB_SPIN(cond, bar) do { unsigned _sp = 0; while (cond) { __builtin_amdgcn_s_sleep(1); \
    if ((++_sp & 255u) == 0u) { if (xb_ld(&(bar)[XB_TMO])) break; if (_sp > XB_SPIN_CAP) { atomicAdd(&(bar)[XB_TMO], 1u); break; } } } } while (0)

struct XcdBarrier {
    unsigned* bar; unsigned x;
    volatile LAS unsigned* st;
};

__device__ __forceinline__ XcdBarrier xcd_barrier_post(unsigned* bar, volatile LAS unsigned* st) {
    XcdBarrier b; b.bar = bar; b.x = xb_xcc_id(); b.st = st;
    if (threadIdx.x == 0) (void)xb_add(&bar[XB_XCNT(b.x)], 1u);
    return b;
}
__device__ __forceinline__ void xcd_barrier_complete(unsigned* bar, unsigned x, unsigned& nloc, unsigned& nx) {
    const unsigned G = gridDim.x * gridDim.y * gridDim.z;
    unsigned sum, cnt, mine, sp = 0u;
    for (;;) {
        sum = 0u; cnt = 0u; mine = 0u;
#pragma unroll
        for (unsigned j = 0; j < 16; ++j) { const unsigned c = xb_ld(&bar[XB_XCNT(j)]); sum += c; cnt += (c > 0u) ? 1u : 0u; mine = (j == x) ? c : mine; }
        if (sum == G) break;
        __builtin_amdgcn_s_sleep(1);
        if ((++sp & 255u) == 0u) { if (xb_ld(&bar[XB_TMO])) break; if (sp > XB_SPIN_CAP) { atomicAdd(&bar[XB_TMO], 1u); break; } }
    }
    nloc = mine > 0u ? mine : 1u; nx = cnt > 0u ? cnt : 1u;
}

__device__ __forceinline__ void xcd_barrier(const XcdBarrier& b) {
    asm volatile("s_waitcnt vmcnt(0)" ::: "memory");
    __syncthreads();
    if (threadIdx.x == 0) {
        unsigned* bar = b.bar;
        __builtin_amdgcn_s_waitcnt(0);
        unsigned nloc = b.st[0], nx = b.st[1];
        if (nloc == 0u) { xcd_barrier_complete(bar, b.x, nloc, nx); b.st[0] = nloc; b.st[1] = nx; }
        const unsigned old = xb_add(&bar[XB_XSUB(b.x)], 1u);
        const unsigned gen = old / nloc;
        if (old + 1u == (gen + 1u) * nloc) {
            __builtin_amdgcn_fence(__ATOMIC_RELEASE, "agent");
            asm volatile("s_waitcnt vmcnt(0)" ::: "memory");
            const unsigned og = xb_add(&bar[XB_TOP], 1u);
            const unsigned tg = og / nx;
            if (og + 1u == (tg + 1u) * nx) xb_add(&bar[XB_TOPGEN], 1u);
            else XB_SPIN(xb_ld(&bar[XB_TOPGEN]) == tg, bar);
            __builtin_amdgcn_fence(__ATOMIC_ACQUIRE, "agent");
            xb_add(&bar[XB_XGEN(b.x)], 1u);
            asm volatile("s_waitcnt vmcnt(0)" ::: "memory");
        } else {
            XB_SPIN(xb_ld(&bar[XB_XGEN(b.x)]) == gen, bar);
            __builtin_amdgcn_fence(__ATOMIC_ACQUIRE, "agent");
            asm volatile("s_waitcnt vmcnt(0)" ::: "memory");
        }
    }
    __syncthreads();
}

struct Args {
    const float* in[16]; float* out; unsigned char* ws;
    float inv_freq[16];
};

__device__ __forceinline__ void transpose_item(const float* __restrict__ W, int ldw, int nvalid, int k0, int n0, bf16* __restrict__ WT, int ldt, int dst_row0, LAS float* scr, int lane, const float* __restrict__ gk = nullptr) {
    const int nq = lane & 15, kq = lane >> 4;
    const int nc = n0 + 4 * nq; const bool okc = nc < nvalid;
    const float* wp = W + (size_t)(k0 + kq) * ldw + nc;
    f32x4 v[16];
#pragma unroll
    for (int i = 0; i < 16; ++i) v[i] = okc ? __builtin_nontemporal_load((const f32x4*)(wp + (size_t)(4 * i) * ldw)) : (f32x4){0.f, 0.f, 0.f, 0.f};
    if (gk) {
        float gv[16];
#pragma unroll
        for (int i = 0; i < 16; ++i) gv[i] = gk[k0 + kq + 4 * i];
#pragma unroll
        for (int i = 0; i < 16; ++i) v[i] *= gv[i];
    }
    LAS float* sw = scr + (4 * nq) * 65 + kq;
#pragma unroll
    for (int i = 0; i < 16; ++i) { sw[4 * i] = v[i].x; sw[65 + 4 * i] = v[i].y; sw[130 + 4 * i] = v[i].z; sw[195 + 4 * i] = v[i].w; }
    LDS_WAIT(); asm volatile("" ::: "memory");
    const int c = lane & 7;
#pragma unroll
    for (int j = 0; j < 8; ++j) { const int n = (lane >> 3) + 8 * j; const LAS float* s = scr + n * 65 + 8 * c;
        v4u o; o.x = pk2(s[0], s[1]); o.y = pk2(s[2], s[3]); o.z = pk2(s[4], s[5]); o.w = pk2(s[6], s[7]);
        *(v4u*)(WT + (size_t)(dst_row0 + n) * ldt + k0 + 8 * c) = o; }
    LDS_WAIT(); asm volatile("" ::: "memory");
}
constexpr int IT_GU = (DM / 64) * (DFF / 64);
constexpr int IT_D = (DFF / 64) * (DM / 64);
constexpr int IT_IN = (DM / 64) * (NINP / 64);
constexpr int IT_OUT = (DM / 64) * (DM / 64);
constexpr int IT_LAYER = 2 * (2 * IT_GU + IT_D) + IT_IN + IT_OUT;

typedef const __attribute__((address_space(4))) Args* ArgPc;
__device__ __forceinline__ void prologue(ArgPc Ap, unsigned char* ws, LAS unsigned char* lds, int gw, int ngw, int wave, int lane, int gtid, int ngt) {
    LAS float* scr = (LAS float*)(lds + wave * 16640);
    for (int it = gw; it < DEPTH * IT_LAYER; it += ngw) {
        const int l = it / IT_LAYER; int r = it - l * IT_LAYER;
        unsigned char* wl = ws + WS_W + (size_t)l * W_LAYER;
        if (r < 2 * (2 * IT_GU + IT_D)) {
            const int f = r / (2 * IT_GU + IT_D); r -= f * (2 * IT_GU + IT_D);
            const size_t wsel = (size_t)(l * 2 + f);
            if (r < 2 * IT_GU) {
                const int up = r / IT_GU; r -= up * IT_GU;
                const float* W = (up ? Ap->in[3] : Ap->in[2]) + wsel * DM * DFF;
                const int kb = r / (DFF / 64), nb = r % (DFF / 64), n0 = nb * 64;
                bf16* WT = (bf16*)(wl + (f ? WL_GU1 : WL_GU0));
                transpose_item(W, DFF, DFF, kb * 64, n0, WT, DM, 256 * (n0 >> 7) + (n0 & 127) + 128 * up, scr, lane, Ap->in[1] + wsel * DM);
            } else {
                r -= 2 * IT_GU;
                const float* W = Ap->in[4] + wsel * DFF * DM;
                const int kb = r / (DM / 64), nb = r % (DM / 64);
                bf16* WT = (bf16*)(wl + (f ? WL_D1 : WL_D0));
                transpose_item(W, DM, DM, kb * 64, nb * 64, WT, DFF, nb * 64, scr, lane);
            }
        } else {
            r -= 2 * (2 * IT_GU + IT_D);
            if (r < IT_IN) {
                const float* W = Ap->in[6] + (size_t)l * DM * NIN;
                const int kb = r / (NINP / 64), nb = r % (NINP / 64);
                transpose_item(W, NIN, NIN, kb * 64, nb * 64, (bf16*)(wl + WL_IN), DM, nb * 64, scr, lane, Ap->in[5] + (size_t)l * DM);
            } else {
                r -= IT_IN;
                const float* W = Ap->in[15] + (size_t)l * DM * DM;
                const int kb = r / (DM / 64), nb = r % (DM / 64);
                transpose_item(W, DM, DM, kb * 64, nb * 64, (bf16*)(wl + WL_OUT), DM, nb * 64, scr, lane);
            }
        }
    }
    { unsigned long long* ss = (unsigned long long*)(ws + WS_SS); for (int i = gtid; i < 13 * M; i += ngt) ss[i] = 0ull; }
    float* rc = (float*)(ws + WS_ROPE); float* rs = rc + SEQ * 16;
    for (int i = gtid; i < SEQ * 16; i += ngt) {
        const int pos = i >> 4, k = i & 15;
        const float angf = (float)pos * Ap->inv_freq[k];
        const double a = (double)angf;
        const double q = __builtin_rint(a * 0.63661977236758134308);
        double x = __builtin_fma(-q, 1.57079632679489655800e+00, a); x = __builtin_fma(-q, 6.12323399573676603587e-17, x);
        const double x2 = x * x;
        double sp = 1.0 / 6227020800.0; sp = sp * x2 - 1.0 / 39916800.0; sp = sp * x2 + 1.0 / 362880.0; sp = sp * x2 - 1.0 / 5040.0; sp = sp * x2 + 1.0 / 120.0; sp = sp * x2 - 1.0 / 6.0; sp = sp * x2 + 1.0; sp *= x;
        double cp = 1.0 / 87178291200.0; cp = -cp; cp = cp * x2 + 1.0 / 479001600.0; cp = cp * x2 - 1.0 / 3628800.0; cp = cp * x2 + 1.0 / 40320.0; cp = cp * x2 - 1.0 / 720.0; cp = cp * x2 + 1.0 / 24.0; cp = cp * x2 - 0.5; cp = cp * x2 + 1.0;
        const int qi = ((int)q) & 3;
        const double sv = (qi == 0) ? sp : (qi == 1) ? cp : (qi == 2) ? -sp : -cp;
        const double cv = (qi == 0) ? cp : (qi == 1) ? -sp : (qi == 2) ? -cp : sp;
        rc[i] = (float)cv; rs[i] = (float)sv;
    }
}

__device__ __forceinline__ float wave_sum(float v) {
#pragma unroll
    for (int o = 1; o < 64; o <<= 1) v += __shfl_xor(v, o);
    return v;
}
__device__ __forceinline__ void conv_phase(const float* __restrict__ x, bf16* __restrict__ xb, unsigned long long* __restrict__ ss, int gw, int ngw, int lane) {
    for (int m = gw; m < M; m += ngw) {
        const f32x4* xr = (const f32x4*)(x + (size_t)m * DM) + lane;
        f32x4 v[8]; float s = 0.f;
#pragma unroll
        for (int j = 0; j < 8; ++j) { v[j] = xr[64 * j]; s += (v[j].x * v[j].x + v[j].y * v[j].y) + (v[j].z * v[j].z + v[j].w * v[j].w); }
        s = wave_sum(s);
        v2u* o = (v2u*)(xb + (size_t)m * DM) + lane;
#pragma unroll
        for (int j = 0; j < 8; ++j) { v2u w; w.x = pk2(v[j].x, v[j].y); w.y = pk2(v[j].z, v[j].w); o[64 * j] = w; }
        if (lane == 0) ss[m] = (unsigned long long)(s * SS_SCALE);
    }
}


constexpr int LD128 = 272;
constexpr int LD64 = 144;
__device__ __forceinline__ void gmlp_unit(LAS unsigned char* lds, const bf16* __restrict__ z, const float* __restrict__ sgw, const float* __restrict__ sgb, const float* __restrict__ sgn,
                                          bf16* __restrict__ y, int um, int tid, int w, int lane) {
    const int g = um & 3, cn = um >> 2; const size_t R0 = (size_t)cn * 128;
    const int c16 = lane & 15, g4 = lane >> 4, q4 = c16 >> 2, p4 = lane & 3;
    LAS unsigned char* WM = lds; LAS unsigned char* VN = lds + 128 * LD128;
#pragma unroll
    for (int it = 0; it < 4; ++it) {
        const int c = tid + 512 * it, t = c >> 4, ch = c & 15;
        const float* wp = sgw + ((size_t)(g * 128 + t)) * 128 + 8 * ch;
        const f32x4 w0 = *(const f32x4*)wp, w1 = *(const f32x4*)(wp + 4);
        float f[8] = {w0.x, w0.y, w0.z, w0.w, w1.x, w1.y, w1.z, w1.w};
#pragma unroll
        for (int e = 0; e < 8; ++e) f[e] = (8 * ch + e <= t) ? f[e] : 0.f;
        *(LAS v4u*)(WM + t * LD128 + ch * 16) = pack8(f);
        const v4u vw = *(const v4u*)(z + (R0 + t) * ZLD + ZC_AV + 128 * g + 8 * ch);
        float v[8]; unpack8(vw, v); float ss = 0.f;
#pragma unroll
        for (int e = 0; e < 8; ++e) { v[e] = gelu_tanh(v[e]); ss += v[e] * v[e]; }
        ss += __shfl_xor(ss, 1); ss += __shfl_xor(ss, 2); ss += __shfl_xor(ss, 4); ss += __shfl_xor(ss, 8);
        const float rstd = rsqrtf(ss * (1.f / 128.f) + EPS);
        const float* gp = sgn + 128 * g + 8 * ch;
        const f32x4 g0 = *(const f32x4*)gp, g1 = *(const f32x4*)(gp + 4);
        const float gg[8] = {g0.x, g0.y, g0.z, g0.w, g1.x, g1.y, g1.z, g1.w};
#pragma unroll
        for (int e = 0; e < 8; ++e) v[e] = v[e] * rstd * gg[e];
        *(LAS v4u*)(VN + t * LD128 + ch * 16) = pack8(v);
    }
    __syncthreads();
    f32x4 acc[8];
#pragma unroll
    for (int ct = 0; ct < 8; ++ct) acc[ct] = (f32x4){0.f, 0.f, 0.f, 0.f};
    const int nks = (w >> 1) + 1;
#pragma unroll
    for (int ks = 0; ks < 4; ++ks) {
        if (ks < nks) {
            const bf16x8 af = lds_row8(WM + (16 * w + c16) * LD128 + (32 * ks + 8 * g4) * 2);
            const LAS unsigned char* vb = VN + (32 * ks + 8 * g4 + q4) * LD128 + (4 * p4) * 2;
#pragma unroll
            for (int ct = 0; ct < 8; ++ct) {
                const bf16x8 bfr = cat8(lds_tr4(vb + ct * 32), lds_tr4(vb + 4 * LD128 + ct * 32));
                acc[ct] = MFMA16(bfr, af, acc[ct]);
            }
        }
    }
    const int t = 16 * w + c16; const float bias = sgb[g * 128 + t];
    const bf16* up = z + (R0 + t) * ZLD + ZC_AU + 128 * g + wide_col(g4);
    bf16* yp = y + (R0 + t) * DM + YC_A + 128 * g + wide_col(g4);
#pragma unroll
    for (int ct = 0; ct < 8; ct += 2) {
        v2u o[2], uu[2]; unwiden_pair(*(const v4u*)(up + 16 * ct), uu[0], uu[1]);
#pragma unroll
        for (int q = 0; q < 2; ++q) { const int c = ct + q;
            const v2u uw = uu[q];
            const float u0 = gelu_tanh(bflo(uw.x)), u1 = gelu_tanh(bfhi(uw.x)), u2 = gelu_tanh(bflo(uw.y)), u3 = gelu_tanh(bfhi(uw.y));
            o[q].x = pk2(u0 * (acc[c][0] + bias), u1 * (acc[c][1] + bias)); o[q].y = pk2(u2 * (acc[c][2] + bias), u3 * (acc[c][3] + bias)); }
        *(v4u*)(yp + 16 * ct) = widen_pair(o[0], o[1]);
    }
    __syncthreads();
}

__device__ __forceinline__ void qk_prepass(bf16* __restrict__ z, const float* __restrict__ qgain, const float* __restrict__ kgain, const float* __restrict__ ropec, const float* __restrict__ ropes,
                                           int gw, int ngw, int lane) {
    const int ch = lane & 15;
    const f32x4 q0 = *(const f32x4*)(qgain + 8 * ch), q1 = *(const f32x4*)(qgain + 8 * ch + 4), k0 = *(const f32x4*)(kgain + 8 * ch), k1 = *(const f32x4*)(kgain + 8 * ch + 4);
    const float qg[8] = {q0.x, q0.y, q0.z, q0.w, q1.x, q1.y, q1.z, q1.w}, kg[8] = {k0.x, k0.y, k0.z, k0.w, k1.x, k1.y, k1.z, k1.w};
    const float sg = (ch < 2) ? -1.f : 1.f;
    for (int m = gw; m < M; m += ngw) {
        bf16* zr = z + (size_t)m * ZLD + ZC_BQ + 8 * lane;
        const int t = m & (SEQ - 1);
        v4u w[3];
#pragma unroll
        for (int it = 0; it < 3; ++it) w[it] = *(const v4u*)(zr + 512 * it);
        float cc[8], sn[8];
        {
            const float* cp = ropec + t * 16 + 8 * (ch & 1); const float* sp = ropes + t * 16 + 8 * (ch & 1);
            const f32x4 c0 = *(const f32x4*)cp, c1 = *(const f32x4*)(cp + 4), s0 = *(const f32x4*)sp, s1 = *(const f32x4*)(sp + 4);
            cc[0] = c0.x; cc[1] = c0.y; cc[2] = c0.z; cc[3] = c0.w; cc[4] = c1.x; cc[5] = c1.y; cc[6] = c1.z; cc[7] = c1.w;
            sn[0] = s0.x; sn[1] = s0.y; sn[2] = s0.z; sn[3] = s0.w; sn[4] = s1.x; sn[5] = s1.y; sn[6] = s1.z; sn[7] = s1.w;
        }
#pragma unroll
        for (int it = 0; it < 3; ++it) {
            const bool isq = (4 * it + (lane >> 4)) < 6;
            float f[8]; unpack8(w[it], f); float ss = 0.f;
#pragma unroll
            for (int e = 0; e < 8; ++e) ss += f[e] * f[e];
            ss += __shfl_xor(ss, 1); ss += __shfl_xor(ss, 2); ss += __shfl_xor(ss, 4); ss += __shfl_xor(ss, 8);
            const float rstd = rsqrtf(ss * (1.f / 128.f) + EPS);
#pragma unroll
            for (int e = 0; e < 8; ++e) f[e] = f[e] * rstd * (isq ? qg[e] : kg[e]);
            float pr[8];
#pragma unroll
            for (int e = 0; e < 8; ++e) pr[e] = __shfl_xor(f[e], 2);
            if (ch < 4) {
#pragma unroll
                for (int e = 0; e < 8; ++e) f[e] = f[e] * cc[e] + sg * pr[e] * sn[e];
            }
            const float sc = isq ? 0.08838834764831845f : 1.0f;
#pragma unroll
            for (int e = 0; e < 8; ++e) f[e] *= sc;
            *(v4u*)(zr + 512 * it) = pack8(f);
        }
    }
}
__device__ __forceinline__ void rope_prepass(bf16* __restrict__ z, const float* __restrict__ ropec, const float* __restrict__ ropes, int gw, int ngw, int lane) {
    const int c4 = lane & 3; const bool act = lane < 48;
    const float sg = (c4 < 2) ? -1.f : 1.f;
    const int loff = ZC_BQ + (act ? (lane >> 2) : 0) * 128 + 8 * c4, toff = 8 * (c4 & 1);
    for (int m0 = gw * 4; m0 < M; m0 += ngw * 4) {
        v4u w[4]; f32x4 cc[4][2], sn[4][2];
#pragma unroll
        for (int r = 0; r < 4; ++r) { const int m = m0 + r, t = m & (SEQ - 1);
            w[r] = *(const v4u*)(z + (size_t)m * ZLD + loff);
            cc[r][0] = *(const f32x4*)(ropec + t * 16 + toff); cc[r][1] = *(const f32x4*)(ropec + t * 16 + toff + 4);
            sn[r][0] = *(const f32x4*)(ropes + t * 16 + toff); sn[r][1] = *(const f32x4*)(ropes + t * 16 + toff + 4); }
#pragma unroll
        for (int r = 0; r < 4; ++r) {
            float f[8]; unpack8(w[r], f);
            const float c[8] = {cc[r][0].x, cc[r][0].y, cc[r][0].z, cc[r][0].w, cc[r][1].x, cc[r][1].y, cc[r][1].z, cc[r][1].w};
            const float s[8] = {sn[r][0].x, sn[r][0].y, sn[r][0].z, sn[r][0].w, sn[r][1].x, sn[r][1].y, sn[r][1].z, sn[r][1].w};
#pragma unroll
            for (int e = 0; e < 8; ++e) { const float pr = __shfl_xor(f[e], 2); f[e] = f[e] * c[e] + sg * pr * s[e]; }
            if (act) *(v4u*)(z + (size_t)(m0 + r) * ZLD + loff) = pack8(f);
        }
    }
}
struct AttnDesc { int gi, dil, h, r, nb; size_t rowbase; };
__device__ __forceinline__ AttnDesc attn_decode(int gi, int ub) {
    AttnDesc d; d.gi = gi; int rem = ub;
    d.dil = (gi == 0) ? 1 : (gi == 1) ? 4 : 16; const int nblk = 64 / d.dil;
    const int b = rem / 384; rem -= b * 384; d.h = rem >> 6; rem &= 63;
    d.r = rem / nblk; d.nb = rem - d.r * nblk; d.rowbase = (size_t)b * SEQ; return d;
}
struct AttnRegs { v4u k[4], v[4], pk[4], pv[4], q[4]; };
__device__ __forceinline__ void attn_issue(const bf16* __restrict__ z, const AttnDesc& d, bool need_prev, AttnRegs& R, int tid, int w, int lane) {
    const int ch = tid & 15, row0 = tid >> 4;
#pragma unroll
    for (int it = 0; it < 4; ++it) {
        const int t = (128 * d.nb + row0 + 32 * it) * d.dil + d.r;
        const bf16* zr = z + (d.rowbase + t) * ZLD + 128 * d.h + 8 * ch;
        R.k[it] = *(const v4u*)(zr + ZC_BK); R.v[it] = *(const v4u*)(zr + ZC_BV);
    }
    if (need_prev) {
#pragma unroll
        for (int it = 0; it < 4; ++it) {
            const int t = (128 * (d.nb - 1) + row0 + 32 * it) * d.dil + d.r;
            const bf16* zr = z + (d.rowbase + t) * ZLD + 128 * d.h + 8 * ch;
            R.pk[it] = *(const v4u*)(zr + ZC_BK); R.pv[it] = *(const v4u*)(zr + ZC_BV);
        }
    }
    const int tq = (128 * d.nb + 16 * w + (lane & 15)) * d.dil + d.r;
    const bf16* zq = z + (d.rowbase + tq) * ZLD + ZC_BQ + 128 * d.h + 8 * (lane >> 4);
#pragma unroll
    for (int ks = 0; ks < 4; ++ks) R.q[ks] = *(const v4u*)(zq + 32 * ks);
}
__device__ __forceinline__ void attn_stage(LAS unsigned char* lds, const AttnRegs& R, int nb, bool had_prev, int tid) {
    LAS unsigned char* KS = lds; LAS unsigned char* VS = lds + 256 * LD128;
    const int ch = tid & 15, row0 = tid >> 4;
    const int vsw = 32 * ((ch >> 1) ^ (row0 & 7)) + 16 * (ch & 1);
    const int sc = (nb & 1) * 128, sp = ((nb + 1) & 1) * 128;
#pragma unroll
    for (int it = 0; it < 4; ++it) {
        const int row = sc + row0 + 32 * it;
        *(LAS v4u*)(KS + row * LD128 + ch * 16) = R.k[it];
        *(LAS v4u*)(VS + 256 * row + vsw) = R.v[it];
    }
    if (had_prev) {
#pragma unroll
        for (int it = 0; it < 4; ++it) {
            const int row = sp + row0 + 32 * it;
            *(LAS v4u*)(KS + row * LD128 + ch * 16) = R.pk[it];
            *(LAS v4u*)(VS + 256 * row + vsw) = R.pv[it];
        }
    } else if (nb == 0) {
#pragma unroll
        for (int it = 0; it < 4; ++it) *(LAS v4u*)(VS + 256 * (sp + row0 + 32 * it) + vsw) = (v4u){0u, 0u, 0u, 0u};
    }
}
struct AttnOut { v4u o[4]; float lv; bf16* op; float* lp; };
__device__ __forceinline__ void attn_store(const AttnOut& r, int lane) {
#pragma unroll
    for (int q = 0; q < 4; ++q) *(v4u*)(r.op + 32 * q) = r.o[q];
    if ((lane >> 4) == 0) *r.lp = r.lv;
}
__device__ __forceinline__ void attn_compute(LAS unsigned char* lds, const AttnDesc& d, const bf16x8 (&qf)[4], bf16* __restrict__ og, float* __restrict__ lse, int w, int lane, AttnOut& res) {
    const int c16 = lane & 15, g4 = lane >> 4, q4 = c16 >> 2, p4 = lane & 3;
    const LAS unsigned char* KS = lds; const LAS unsigned char* VS = lds + 256 * LD128;
    const int qi = 16 * w + c16; const int tq = (128 * d.nb + qi) * d.dil + d.r;
    f32x4 sc[9];
#pragma unroll
    for (int j = 0; j < 9; ++j) {
        sc[j] = (f32x4){0.f, 0.f, 0.f, 0.f};
        const int kt = w + j; const int lrow = ((d.nb + (kt >> 3) + 1) & 1) * 128 + (kt & 7) * 16;
        const LAS unsigned char* kp = KS + (lrow + c16) * LD128 + 16 * g4;
#pragma unroll
        for (int ks = 0; ks < 4; ++ks) sc[j] = MFMA16(lds_row8(kp + 64 * ks), qf[ks], sc[j]);
    }
    float mx = -1e30f;
#pragma unroll
    for (int j = 0; j < 9; ++j)
#pragma unroll
        for (int e = 0; e < 4; ++e) { const int kj = 16 * (w + j) + 4 * g4 + e; const int dist = qi + 128 - kj;
            const bool valid = (dist >= 0) && (dist <= 128) && (d.nb > 0 || kj >= 128);
            sc[j][e] = valid ? sc[j][e] : -1e30f; mx = fmaxf(mx, sc[j][e]); }
    mx = fmaxf(mx, __shfl_xor(mx, 16)); mx = fmaxf(mx, __shfl_xor(mx, 32));
    float l = 0.f;
#pragma unroll
    for (int j = 0; j < 9; ++j)
#pragma unroll
        for (int e = 0; e < 4; ++e) { const float p = __expf(sc[j][e] - mx); sc[j][e] = p; l += p; }
    l += __shfl_xor(l, 16); l += __shfl_xor(l, 32);
    const int xr = 4 * (g4 & 1) + q4;
    f32x4 oa[8];
#pragma unroll
    for (int ct = 0; ct < 8; ++ct) oa[ct] = (f32x4){0.f, 0.f, 0.f, 0.f};
#pragma unroll
    for (int s = 0; s < 5; ++s) {
        v4u pw; pw.x = pk2(sc[2 * s][0], sc[2 * s][1]); pw.y = pk2(sc[2 * s][2], sc[2 * s][3]);
        if (s < 4) { pw.z = pk2(sc[2 * s + 1][0], sc[2 * s + 1][1]); pw.w = pk2(sc[2 * s + 1][2], sc[2 * s + 1][3]); } else { pw.z = 0u; pw.w = 0u; }
        const bf16x8 pf = __builtin_bit_cast(bf16x8, pw);
        const int kt0 = w + 2 * s, kt1 = (w + 2 * s + 1 > 15) ? 15 : (w + 2 * s + 1);
        const int lr0 = ((d.nb + (kt0 >> 3) + 1) & 1) * 128 + (kt0 & 7) * 16, lr1 = ((d.nb + (kt1 >> 3) + 1) & 1) * 128 + (kt1 & 7) * 16;
        const LAS unsigned char* v0 = VS + (lr0 + 4 * g4 + q4) * 256 + 8 * p4;
        const LAS unsigned char* v1 = VS + (lr1 + 4 * g4 + q4) * 256 + 8 * p4;
#pragma unroll
        for (int ct = 0; ct < 8; ++ct) oa[ct] = MFMA16(cat8(lds_tr4(v0 + 32 * (ct ^ xr)), lds_tr4(v1 + 32 * (ct ^ xr))), pf, oa[ct]);
    }
    const float inv = 1.0f / l;
    const size_t orow = (size_t)d.gi * M + d.rowbase + tq;
    res.op = og + orow * 768 + 128 * d.h + wide_col(g4);
#pragma unroll
    for (int ct = 0; ct < 8; ct += 2) { v2u o0, o1; o0.x = pk2(oa[ct][0] * inv, oa[ct][1] * inv); o0.y = pk2(oa[ct][2] * inv, oa[ct][3] * inv);
        o1.x = pk2(oa[ct + 1][0] * inv, oa[ct + 1][1] * inv); o1.y = pk2(oa[ct + 1][2] * inv, oa[ct + 1][3] * inv);
        res.o[ct >> 1] = widen_pair(o0, o1); }
    res.lp = lse + orow * 6 + d.h; res.lv = mx + __logf(l);
}
__device__ __forceinline__ void attn_phase(LAS unsigned char* lds, const bf16* __restrict__ z, bf16* __restrict__ og, float* __restrict__ lse, int vc, int G, int tid, int w, int lane) {
    const int nrounds = (256 - vc + G - 1) / G;
    const int nit = nrounds * 18;
    AttnRegs R; AttnDesc d = attn_decode(0, 6 * vc); bool np = d.nb > 0;
    AttnOut res; res.op = og; res.lp = lse; res.lv = 0.f;
#pragma unroll
    for (int q = 0; q < 4; ++q) res.o[q] = (v4u){0u, 0u, 0u, 0u};
    if (nit > 0) attn_issue(z, d, np, R, tid, w, lane);
    for (int it = 0; it < nit; ++it) {
        asm volatile("" : "+s"(w), "+v"(tid));
        lane = tid & 63;
        attn_stage(lds, R, d.nb, np, tid);
        if (it > 0) attn_store(res, lane);
        bf16x8 qf[4];
#pragma unroll
        for (int ks = 0; ks < 4; ++ks) qf[ks] = __builtin_bit_cast(bf16x8, R.q[ks]);
        const AttnDesc dc = d;
        __syncthreads();
        if (it + 1 < nit) { const int n = it + 1, j = n % 6, gi = (n / 6) % 3, seg = vc + (n / 18) * G;
            d = attn_decode(gi, 6 * seg + j); np = (j == 0) && d.nb > 0; attn_issue(z, d, np, R, tid, w, lane); }
        attn_compute(lds, dc, qf, og, lse, w, lane, res);
        __syncthreads();
    }
    if (nit > 0) attn_store(res, lane);
}

__device__ __forceinline__ int t64_f(int row) { return ((row >> 1) & 1) | (((row >> 3) & 1) << 1); }
__device__ __forceinline__ int t64_off(int row, int ch) { return 128 * row + 32 * ((ch >> 1) ^ t64_f(row)) + 16 * (ch & 1); }
__device__ __forceinline__ float log_sigmoid_f(float x) { return fminf(x, 0.f) - __logf(1.0f + __expf(-fabsf(x))); }

__device__ __forceinline__ void gla_r_wave(LAS float* rtab, const bf16* __restrict__ h, const bf16* __restrict__ wrt, const unsigned long long* __restrict__ ss, int slab, int w, int lane) {
    const int c16 = lane & 15, g4 = lane >> 4;
    const bf16* hp = h + ((size_t)slab * 128 + 16 * w + c16) * DM + 8 * g4; const bf16* wp = wrt + (size_t)c16 * DM + 8 * g4;
    f32x4 acc = (f32x4){0.f, 0.f, 0.f, 0.f};
    for (int ks0 = 0; ks0 < 64; ks0 += 8) {
        v4u a[8], b[8];
#pragma unroll
        for (int i = 0; i < 8; ++i) { a[i] = *(const v4u*)(hp + 32 * (ks0 + i)); b[i] = *(const v4u*)(wp + 32 * (ks0 + i)); }
#pragma unroll
        for (int i = 0; i < 8; ++i) acc = MFMA16(__builtin_bit_cast(bf16x8, b[i]), __builtin_bit_cast(bf16x8, a[i]), acc);
    }
    acc *= __builtin_amdgcn_rsqf((float)ss[slab * 128 + 16 * w + c16] * SS_INV * (1.f / DM) + EPS);
    *(LAS f32x4*)(rtab + (16 * w + c16) * 16 + 4 * g4) = acc;
}
__device__ __forceinline__ void gla_g1_wave(LAS unsigned char* wl, const bf16* __restrict__ z, const LAS float* rch, const float* __restrict__ wg, const float* __restrict__ bg,
                                            float* __restrict__ UT, float* __restrict__ dec, bf16* __restrict__ QD, bf16* __restrict__ KD, int chunk, int h, int lane) {
    const size_t R0 = (size_t)chunk * 64;
    const int c16 = lane & 15, g4 = lane >> 4, q4 = c16 >> 2, p4 = lane & 3;
    const bf16* zk = z + R0 * ZLD + ZC_CK + 64 * h + lane; const bf16* zq = z + R0 * ZLD + ZC_CQ + 64 * h + lane;
    bf16 kr[16], qr[16];
#pragma unroll
    for (int i = 0; i < 16; ++i) { kr[i] = zk[(size_t)i * ZLD]; qr[i] = zq[(size_t)i * ZLD]; }
    const bf16* zv = z + (R0 + (lane >> 3)) * ZLD + ZC_CV + 128 * h + 8 * (lane & 7);
    v4u vr[8];
#pragma unroll
    for (int it = 0; it < 8; ++it) vr[it] = *(const v4u*)(zv + (size_t)(8 * it) * ZLD);
    float bl[64]; float blast;
    {
        float wcol[16], rr[16];
#pragma unroll
        for (int i = 0; i < 16; ++i) { wcol[i] = wg[i * 384 + 64 * h + lane]; rr[i] = rch[64 * i + lane]; }
        const float bias = bg[64 * h + lane];
        float run = 0.f;
#pragma unroll
        for (int j = 0; j < 64; ++j) {
            float x = bias;
#pragma unroll
            for (int i = 0; i < 16; ++i) x += __int_as_float(__builtin_amdgcn_readlane(__float_as_int(rr[j >> 2]), (j & 3) * 16 + i)) * wcol[i];
            run += log_sigmoid_f(x) * (1.f / 16.f); bl[j] = run;
        }
        blast = run;
    }
    const float elast = __expf(blast);
    dec[((size_t)chunk * 6 + h) * 64 + lane] = elast;
    LAS unsigned char* KT = wl; LAS unsigned char* VH = wl + 8192;
    bf16* qdp = QD + R0 * 384 + 64 * h + lane; bf16* kdp = KD + R0 * 384 + 64 * h + lane;
#pragma unroll
    for (int bt = 0; bt < 4; ++bt) {
        bf16 kn[16], qn[16];
        if (bt < 3) {
#pragma unroll
            for (int i = 0; i < 16; ++i) { kn[i] = zk[(size_t)(16 * (bt + 1) + i) * ZLD]; qn[i] = zq[(size_t)(16 * (bt + 1) + i) * ZLD]; }
        }
#pragma unroll
        for (int i = 0; i < 16; ++i) { const int j = 16 * bt + i;
            const float e = __expf(bl[j]), ei = __expf(-bl[j]);
            const float kv = bf1(kr[i]), qv = bf1(qr[i]);
            const float kd = kv * ei;
            qdp[(size_t)j * 384] = f2bf(qv * 0.125f * e);
            kdp[(size_t)j * 384] = f2bf(kd);
            *(LAS bf16*)(KT + 128 * j + 32 * ((lane >> 4) ^ t64_f(j)) + 2 * (lane & 15)) = f2bf(kd * elast);
        }
        if (bt < 3) {
#pragma unroll
            for (int i = 0; i < 16; ++i) { kr[i] = kn[i]; qr[i] = qn[i]; }
        }
    }
    float* up = UT + ((size_t)chunk * 6 + h) * 8192 + (size_t)c16 * 64 + 4 * g4;
#pragma unroll
    for (int vh = 0; vh < 2; ++vh) {
#pragma unroll
        for (int it = 0; it < 8; ++it) { const int row = (lane >> 3) + 8 * it; *(LAS v4u*)(VH + t64_off(row, lane & 7)) = vr[it]; }
        if (vh == 0) {
#pragma unroll
            for (int it = 0; it < 8; ++it) vr[it] = *(const v4u*)(zv + (size_t)(8 * it) * ZLD + 64);
        }
        asm volatile("s_waitcnt lgkmcnt(0)" ::: "memory");
        f32x4 acc[4][4];
#pragma unroll
        for (int vt = 0; vt < 4; ++vt)
#pragma unroll
            for (int kt = 0; kt < 4; ++kt) acc[vt][kt] = (f32x4){0.f, 0.f, 0.f, 0.f};
#pragma unroll
        for (int ks = 0; ks < 2; ++ks) {
            const int row = 32 * ks + 8 * g4 + q4; const int fr = t64_f(row);
            bf16x8 af[4], bfr[4];
#pragma unroll
            for (int t = 0; t < 4; ++t) {
                const int o = 128 * row + 32 * (t ^ fr) + 8 * p4;
                af[t] = cat8(lds_tr4(VH + o), lds_tr4(VH + o + 512));
                bfr[t] = cat8(lds_tr4(KT + o), lds_tr4(KT + o + 512));
            }
#pragma unroll
            for (int vt = 0; vt < 4; ++vt)
#pragma unroll
                for (int kt = 0; kt < 4; ++kt) acc[vt][kt] = MFMA16(bfr[kt], af[vt], acc[vt][kt]);
        }
#pragma unroll
        for (int vt = 0; vt < 4; ++vt)
#pragma unroll
            for (int kt = 0; kt < 4; ++kt) *(f32x4*)(up + (size_t)(64 * vh + 16 * vt) * 64 + 16 * kt) = acc[vt][kt];
        asm volatile("s_waitcnt lgkmcnt(0)" ::: "memory");
    }
}
__device__ __forceinline__ void gla_scan(const float* __restrict__ UT, const float* __restrict__ dec, bf16* __restrict__ SB, int gtid, int ngt) {
    for (int e = gtid; e < BATCH * 6 * 8192; e += ngt) {
        const int kk = e & 63, hv = e >> 6; const int b = hv / (6 * 128), hvr = hv - b * (6 * 128); const int h = hvr >> 7;
        const size_t o0 = (size_t)b * 128 * 6 * 8192 + (size_t)hvr * 64 + kk;
        const float* up = UT + o0; bf16* sp = SB + o0;
        const float* dp = dec + (size_t)b * 128 * 384 + h * 64 + kk;
        float st = 0.f;
        for (int n0 = 0; n0 < 128; n0 += 16) {
            float uv[16], dv[16];
#pragma unroll
            for (int i = 0; i < 16; ++i) { uv[i] = up[(size_t)(n0 + i) * 6 * 8192]; dv[i] = dp[(size_t)(n0 + i) * 384]; }
#pragma unroll
            for (int i = 0; i < 16; ++i) { sp[(size_t)(n0 + i) * 6 * 8192] = f2bf(st); st = dv[i] * st + uv[i]; }
        }
    }
}
__device__ __forceinline__ void gla_g3_wave(LAS unsigned char* wl, const bf16* __restrict__ z, const bf16* __restrict__ QD, const bf16* __restrict__ KD, const bf16* __restrict__ SB,
                                            const float* __restrict__ outg, bf16* __restrict__ y, int chunk, int h, int lane) {
    const size_t R0 = (size_t)chunk * 64;
    const int c16 = lane & 15, g4 = lane >> 4, q4 = c16 >> 2, p4 = lane & 3;
    {
        const bf16* zv = z + (R0 + (lane >> 4)) * ZLD + ZC_CV + 128 * h + 8 * (lane & 15);
        const int ch = lane & 15;
#pragma unroll
        for (int half = 0; half < 2; ++half) {
            v4u vr[8];
#pragma unroll
            for (int it = 0; it < 8; ++it) vr[it] = *(const v4u*)(zv + (size_t)(4 * (8 * half + it)) * ZLD);
#pragma unroll
            for (int it = 0; it < 8; ++it) { const int row = (lane >> 4) + 4 * (8 * half + it);
                *(LAS v4u*)(wl + 256 * row + 32 * ((ch >> 1) ^ (row & 7)) + 16 * (ch & 1)) = vr[it]; }
        }
    }
    bf16x8 qf[4][2], kf[4][2];
    {
        const bf16* qp = QD + (R0 + c16) * 384 + 64 * h + 8 * g4; const bf16* kp = KD + (R0 + c16) * 384 + 64 * h + 8 * g4;
#pragma unroll
        for (int t = 0; t < 4; ++t)
#pragma unroll
            for (int ks = 0; ks < 2; ++ks) { qf[t][ks] = __builtin_bit_cast(bf16x8, *(const v4u*)(qp + (size_t)(16 * t) * 384 + 32 * ks));
                                             kf[t][ks] = __builtin_bit_cast(bf16x8, *(const v4u*)(kp + (size_t)(16 * t) * 384 + 32 * ks)); }
    }
    bf16x8 pf[4][2];
#pragma unroll
    for (int it = 0; it < 4; ++it) {
        unsigned pw[4][2];
#pragma unroll
        for (int jt = 0; jt < 4; ++jt) {
            if (jt <= it) {
                f32x4 a = (f32x4){0.f, 0.f, 0.f, 0.f};
#pragma unroll
                for (int ks = 0; ks < 2; ++ks) a = MFMA16(kf[jt][ks], qf[it][ks], a);
                if (jt == it) { const int d0 = c16 - 4 * g4;
                    a[0] = (0 <= d0) ? a[0] : 0.f; a[1] = (1 <= d0) ? a[1] : 0.f; a[2] = (2 <= d0) ? a[2] : 0.f; a[3] = (3 <= d0) ? a[3] : 0.f; }
                pw[jt][0] = pk2(a[0], a[1]); pw[jt][1] = pk2(a[2], a[3]);
            } else { pw[jt][0] = 0u; pw[jt][1] = 0u; }
        }
#pragma unroll
        for (int s = 0; s < 2; ++s) { v4u w4; w4.x = pw[2 * s][0]; w4.y = pw[2 * s][1]; w4.z = pw[2 * s + 1][0]; w4.w = pw[2 * s + 1][1]; pf[it][s] = __builtin_bit_cast(bf16x8, w4); }
    }
    asm volatile("s_waitcnt lgkmcnt(0)" ::: "memory");
    f32x4 acc[4][8];
#pragma unroll
    for (int it = 0; it < 4; ++it)
#pragma unroll
        for (int ct = 0; ct < 8; ++ct) acc[it][ct] = (f32x4){0.f, 0.f, 0.f, 0.f};
    const int xr = 4 * (g4 & 1) + q4;
    const LAS unsigned char* vb = wl + 256 * (4 * g4 + q4) + 8 * p4;
#pragma unroll
    for (int ct = 0; ct < 8; ++ct) {
        const int co = 32 * (ct ^ xr);
#pragma unroll
        for (int s = 0; s < 2; ++s) {
            const bf16x8 vf = cat8(lds_tr4(vb + 256 * (32 * s) + co), lds_tr4(vb + 256 * (32 * s + 16) + co));
#pragma unroll
            for (int it = 0; it < 4; ++it) if (2 * s <= it) acc[it][ct] = MFMA16(vf, pf[it][s], acc[it][ct]);
        }
        const bf16* sp = SB + ((size_t)chunk * 6 + h) * 8192 + (size_t)(16 * ct + c16) * 64 + 8 * g4;
#pragma unroll
        for (int ks = 0; ks < 2; ++ks) {
            const bf16x8 sf = __builtin_bit_cast(bf16x8, *(const v4u*)(sp + 32 * ks));
#pragma unroll
            for (int it = 0; it < 4; ++it) acc[it][ct] = MFMA16(sf, qf[it][ks], acc[it][ct]);
        }
    }
#pragma unroll
    for (int it = 0; it < 4; ++it) {
        float ss = 0.f;
#pragma unroll
        for (int ct = 0; ct < 8; ++ct) ss += (acc[it][ct][0] * acc[it][ct][0] + acc[it][ct][1] * acc[it][ct][1]) + (acc[it][ct][2] * acc[it][ct][2] + acc[it][ct][3] * acc[it][ct][3]);
        ss += __shfl_xor(ss, 16); ss += __shfl_xor(ss, 32);
        const float rstd = rsqrtf(ss * (1.f / 128.f) + EPS);
        const size_t row = R0 + 16 * it + c16;
        const bf16* gp = z + row * ZLD + ZC_CG + 128 * h + wide_col(g4);
        bf16* yp = y + row * DM + YC_C + 128 * h + wide_col(g4);
#pragma unroll
        for (int ct = 0; ct < 8; ct += 2) {
            v2u o[2], gg[2]; unwiden_pair(*(const v4u*)(gp + 16 * ct), gg[0], gg[1]);
#pragma unroll
            for (int q = 0; q < 2; ++q) { const int c = ct + q;
                const v2u gw = gg[q]; const f32x4 og4 = *(const f32x4*)(outg + 16 * c + 4 * g4);
                o[q].x = pk2(acc[it][c][0] * rstd * og4.x * silu_f(bflo(gw.x)), acc[it][c][1] * rstd * og4.y * silu_f(bfhi(gw.x)));
                o[q].y = pk2(acc[it][c][2] * rstd * og4.z * silu_f(bflo(gw.y)), acc[it][c][3] * rstd * og4.w * silu_f(bfhi(gw.y))); }
            *(v4u*)(yp + 16 * ct) = widen_pair(o[0], o[1]);
        }
    }
    asm volatile("s_waitcnt lgkmcnt(0)" ::: "memory");
}
__device__ __forceinline__ void attn_merge(const bf16* __restrict__ og, const float* __restrict__ lse, bf16* __restrict__ y, int gtid, int ngt) {
    for (int idx = gtid; idx < M * 96; idx += ngt) {
        const int row = idx / 96, cc = idx - row * 96, h = cc >> 4;
        const float l0 = lse[(size_t)row * 6 + h], l1 = lse[((size_t)M + row) * 6 + h], l2 = lse[((size_t)2 * M + row) * 6 + h];
        const float mx = fmaxf(l0, fmaxf(l1, l2));
        float w0 = __expf(l0 - mx), w1 = __expf(l1 - mx), w2 = __expf(l2 - mx);
        const float inv = 1.0f / (w0 + w1 + w2); w0 *= inv; w1 *= inv; w2 *= inv;
        float a[8], b[8], c[8];
        unpack8(*(const v4u*)(og + (size_t)row * 768 + 8 * cc), a);
        unpack8(*(const v4u*)(og + ((size_t)M + row) * 768 + 8 * cc), b);
        unpack8(*(const v4u*)(og + ((size_t)2 * M + row) * 768 + 8 * cc), c);
#pragma unroll
        for (int e = 0; e < 8; ++e) a[e] = w0 * a[e] + w1 * b[e] + w2 * c[e];
        *(v4u*)(y + (size_t)row * DM + YC_B + 8 * cc) = pack8(a);
    }
}

#ifndef DBG_MASK
#define DBG_MASK 0xFFFF
#endif
#define PH(b) if constexpr ((DBG_MASK >> (b)) & 1)
#ifndef PROBE_MASK
#define PROBE_MASK 0
#endif
#if PROBE_MASK
#define REP(b) int nrep_##b = 1 + ((PROBE_MASK >> (b)) & 1); asm volatile("" : "+s"(nrep_##b)); _Pragma("unroll 1") for (int rep_ = 0; rep_ < nrep_##b; ++rep_)
#else
#define REP(b) for (int rep_ = 0; rep_ < 1; ++rep_)
#endif
typedef const __attribute__((address_space(4))) Args* ArgP;
#define PHASE_BEGIN() ArgP ap = (ArgP)__builtin_amdgcn_kernarg_segment_ptr(); asm volatile("" : "+s"(ap)); \
    unsigned char* const ws = ap->ws; int tid = threadIdx.x; asm volatile("" : "+v"(tid)); \
    int lane = tid & 63; const int wave = __builtin_amdgcn_readfirstlane(tid >> 6), G = gridDim.x, bx = blockIdx.x; \
    const int gw = bx * NWAVES + wave, ngw = G * NWAVES, gtid = bx * (NWAVES * 64) + tid, ngt = G * NWAVES * 64; \
    (void)ws; (void)lane; (void)wave; (void)gw; (void)ngw; (void)gtid; (void)ngt; \
    LAS unsigned char* lds = (LAS unsigned char*)lds_raw

#ifdef PROF_SEL
#ifndef PROF_AMP
#define PROF_AMP 4
#endif
#define TS_BEGIN(id) do { if ((id) == PROF_SEL) prof_t0 = __builtin_amdgcn_s_memrealtime(); } while (0)
#define TS_END(id) do { if ((id) == PROF_SEL) { const unsigned long long now_ = __builtin_amdgcn_s_memrealtime(); const unsigned long long dt_ = (now_ - prof_t0) * PROF_AMP; \
    if (dt_ < 100000000ull) while (__builtin_amdgcn_s_memrealtime() - now_ < dt_) __builtin_amdgcn_s_sleep(8); __syncthreads(); } } while (0)
#else
#define TS_BEGIN(id) do { } while (0)
#define TS_END(id) do { } while (0)
#endif
__global__ void __launch_bounds__(NWAVES * 64, 2) hymba_fwd(Args args) {
    extern __shared__ __attribute__((aligned(16))) unsigned char lds_raw[];
    {
        LAS unsigned char* lds0 = (LAS unsigned char*)lds_raw;
        for (int u = threadIdx.x; u < (LDSX_OFF - LDSCTL_OFF) / 4; u += NWAVES * 64) ((LAS unsigned*)(lds0 + LDSCTL_OFF))[u] = 0u;
    }
    __syncthreads();
    XcdBarrier bar = xcd_barrier_post((unsigned*)(args.ws + WS_CTL) + CW_BAR, (volatile LAS unsigned*)((LAS unsigned char*)lds_raw + LDSCTL_OFF) + 8);
#define GRID_BAR() do { XcdBarrier b_ = bar; asm volatile("" : "+s"(b_.bar), "+s"(b_.x)); xcd_barrier(b_); } while (0)
#ifdef PROF_SEL
    unsigned long long prof_t0 = 0ull;
#endif

    TS_BEGIN(0);
    REP(0) PH(0) { PHASE_BEGIN(); prologue(ap, ws, lds, gw, ngw, wave, lane, gtid, ngt); }
    GRID_BAR();
    TS_END(0);

    for (int s = 0; s < 3 * DEPTH; ++s) {
        const int l = s / 3, k = s - 3 * l, f = k >> 1;
        if (s == 0) {
            TS_BEGIN(1);
            PH(1) { PHASE_BEGIN(); conv_phase(ap->in[0], (bf16*)(ws + WS_H), (unsigned long long*)(ws + WS_SS), gw, ngw, lane); }
            GRID_BAR();
            TS_END(1);
        }
        if (k != 1) {
            TS_BEGIN(2);
            REP(2) PH(2) { PHASE_BEGIN();
                const bf16* Bt = (const bf16*)(ws + WS_W + (size_t)l * W_LAYER + (f ? WL_GU1 : WL_GU0));
                const bf16* xa = (s == 0) ? (const bf16*)(ws + WS_H) : (s == 3 * DEPTH - 1) ? (const bf16*)(ws + WS_OG) : (const bf16*)ap->out;
                pg8::Gemm g{xa, Bt, M, 2 * DFF, DM}; pg8::StaticOrder S; S.init(M, 2 * DFF, G, bx);
                pg8::EpiSwiGLU E{(bf16*)(ws + WS_HZ), DFF, (const unsigned long long*)(ws + WS_SS) + (size_t)s * M};
                pg8::gemm_phase<pg8::EpiSwiGLU, pg8::StaticOrder, true, true>(lds, g, S, E); }
        } else {
            TS_BEGIN(4);
            REP(4) PH(4) { PHASE_BEGIN();
                const bf16* Bt = (const bf16*)(ws + WS_W + (size_t)l * W_LAYER + WL_IN);
                pg8::Gemm g{(const bf16*)ap->out, Bt, M, NZ, DM}; pg8::StaticOrder S; S.init(M, NZ, G, bx);
                pg8::EpiZ E{(bf16*)(ws + WS_HZ), (const unsigned long long*)(ws + WS_SS) + (size_t)s * M, ap->in[10] + (size_t)l * 128, ap->in[11] + (size_t)l * 128, ZLD};
                pg8::gemm_phase<pg8::EpiZ, pg8::StaticOrder, true, true>(lds, g, S, E); }
            GRID_BAR();
            TS_END(4);
            TS_BEGIN(5);
            PH(5) { PHASE_BEGIN(); const float* ropec = (const float*)(ws + WS_ROPE); rope_prepass((bf16*)(ws + WS_HZ), ropec, ropec + SEQ * 16, gw, ngw, lane); }
            PH(6) { for (int slab = blockIdx.x; slab < M / 128; slab += gridDim.x) { PHASE_BEGIN();
                LAS float* rtab = (LAS float*)(lds + 131072);
                gla_r_wave(rtab, (const bf16*)ap->out, (const bf16*)(ws + WS_W + (size_t)l * W_LAYER + WL_IN) + (size_t)NZ * DM, (const unsigned long long*)(ws + WS_SS) + (size_t)s * M, slab, wave, lane);
                __syncthreads();
                for (int u = wave; u < 12; u += NWAVES) {
                    asm volatile("" : "+v"(tid)); lane = tid & 63;
                    gla_g1_wave(lds + wave * 16384, (const bf16*)(ws + WS_HZ), rtab + (u / 6) * 1024, ap->in[12] + (size_t)l * 16 * 384, ap->in[13] + (size_t)l * 384,
                                (float*)((char*)ap->out + (size_t)M * DM * 2), (float*)(ws + WS_DEC), (bf16*)(ws + WS_QD), (bf16*)(ws + WS_KD), 2 * slab + u / 6, u % 6, lane); }
                __syncthreads(); } }
            __syncthreads();
            PH(7) { for (int slab = blockIdx.x; slab < M / 128; slab += gridDim.x) for (int g = 0; g < 4; ++g) { PHASE_BEGIN();
                gmlp_unit(lds, (const bf16*)(ws + WS_HZ), ap->in[8] + (size_t)l * 4 * 128 * 128, ap->in[9] + (size_t)l * 512, ap->in[7] + (size_t)l * 512, (bf16*)(ws + WS_Y), 4 * slab + g, tid, wave, lane); } }
            GRID_BAR();
            TS_END(5);
            TS_BEGIN(6);
            PH(8) { PHASE_BEGIN(); gla_scan((const float*)((const char*)ap->out + (size_t)M * DM * 2), (const float*)(ws + WS_DEC), (bf16*)(ws + WS_SB), gtid, ngt); }
            REP(12) { PH(12) { PHASE_BEGIN();
                const int vc = (G % 8 == 0) ? (bx % 8) * (G / 8) + bx / 8 : bx;
                attn_phase(lds, (const bf16*)(ws + WS_HZ), (bf16*)(ws + WS_OG), (float*)(ws + WS_LSE), vc, G, tid, wave, lane); } }
            GRID_BAR();
            TS_END(6);
            TS_BEGIN(7);
            REP(9) { PH(9) { for (int slab = blockIdx.x; slab < M / 128; slab += gridDim.x) { PHASE_BEGIN();
                for (int u = wave; u < 12; u += NWAVES) {
                    asm volatile("" : "+v"(tid)); lane = tid & 63;
                    gla_g3_wave(lds + wave * 16384, (const bf16*)(ws + WS_HZ), (const bf16*)(ws + WS_QD), (const bf16*)(ws + WS_KD), (const bf16*)(ws + WS_SB), ap->in[14] + (size_t)l * 128,
                                (bf16*)(ws + WS_Y), 2 * slab + u / 6, u % 6, lane); } } } }
            __syncthreads();
            REP(10) PH(10) { PHASE_BEGIN(); attn_merge((const bf16*)(ws + WS_OG), (const float*)(ws + WS_LSE), (bf16*)(ws + WS_Y), gtid, ngt); }
        }
        GRID_BAR();
        if (k != 1) TS_END(2); else TS_END(7);
        if (k != 1) TS_BEGIN(3); else TS_BEGIN(8);
        PH(3) { PHASE_BEGIN();
            const bool last = (s == 3 * DEPTH - 1), first = (s == 0);
            const void* xin = first ? (const void*)ap->in[0] : last ? (const void*)(ws + WS_OG) : (const void*)ap->out;
            void* xout = (s == 3 * DEPTH - 2) ? (void*)(ws + WS_OG) : (void*)ap->out;
            const unsigned char* wl = ws + WS_W + (size_t)l * W_LAYER;
            const bf16* A = (k == 1) ? (const bf16*)(ws + WS_Y) : (const bf16*)(ws + WS_HZ);
            const bf16* Bt = (const bf16*)(wl + ((k == 1) ? WL_OUT : (f ? WL_D1 : WL_D0)));
            pg8::Gemm g{A, Bt, M, DM, (k == 1) ? DM : DFF}; pg8::StaticOrder S; S.init(M, DM, G, bx, 4);
            pg8::EpiResid E{xin, xout, (unsigned long long*)(ws + WS_SS) + (size_t)(s + 1) * M, first ? 1 : 0, last ? 1 : 0, (k == 1) ? 1.0f : 0.5f};
            pg8::gemm_phase<pg8::EpiResid, pg8::StaticOrder, true, true>(lds, g, S, E); }
        GRID_BAR();
        if (k != 1) TS_END(3); else TS_END(8);
#if defined(PROF_SEL) && PROF_SEL == 99
        if (s == PROF_IDLE_AT) { const unsigned long long now_ = __builtin_amdgcn_s_memrealtime(); while (__builtin_amdgcn_s_memrealtime() - now_ < (unsigned long long)PROF_IDLE_US * 100ull) __builtin_amdgcn_s_sleep(8); __syncthreads(); }
#endif
    }
}

extern "C" void kernel_launch(void* const* d_in, const int* in_sizes, int n_in, void* d_out, int out_size, void* d_ws, size_t ws_size, hipStream_t stream) {
    static int grid = 0;
    if (grid == 0) {
        if (n_in != 16 || in_sizes[0] != M * DM || out_size != M * DM || ws_size < WS_END) { fprintf(stderr, "kernel_launch: shape/workspace mismatch (n_in %d, ws %zu, need %zu)\n", n_in, ws_size, (size_t)WS_END); grid = -1; return; }
        int dev = 0, cus = 0, per_cu = 0;
        if (hipGetDevice(&dev) != hipSuccess || hipDeviceGetAttribute(&cus, hipDeviceAttributeMultiprocessorCount, dev) != hipSuccess) { grid = -1; return; }
        if (hipFuncSetAttribute((const void*)hymba_fwd, hipFuncAttributeMaxDynamicSharedMemorySize, LDS_BYTES) != hipSuccess) { fprintf(stderr, "kernel_launch: hipFuncSetAttribute failed\n"); grid = -1; return; }
        if (hipOccupancyMaxActiveBlocksPerMultiprocessor(&per_cu, (const void*)hymba_fwd, NWAVES * 64, LDS_BYTES) != hipSuccess || per_cu < 1) fprintf(stderr, "kernel_launch: occupancy query says %d\n", per_cu);
        (void)hipGetLastError();
        grid = cus;
    }
    if (grid < 0) return;
    if (hipMemsetAsync((char*)d_ws + WS_CTL, 0, CTL_ZERO_BYTES, stream) != hipSuccess) return;
    Args a{};
    for (int i = 0; i < 16; ++i) a.in[i] = (const float*)d_in[i];
    a.out = (float*)d_out; a.ws = (unsigned char*)d_ws;
    for (int i = 0; i < 16; ++i) a.inv_freq[i] = (float)std::pow(500000.0, -(double)i / 16.0);
    hipLaunchKernelGGL(hymba_fwd, dim3(grid), dim3(NWAVES * 64), LDS_BYTES, stream, a);
}
```

```cpp
#include <hip/hip_runtime.h>
#include <cstdio>
#include <cstdint>
#include <cmath>
namespace pg8 {
#define PG8_LAS __attribute__((address_space(3)))
typedef unsigned short bf16_t;
typedef short bf16x8 __attribute__((ext_vector_type(8)));
typedef float f32x4 __attribute__((ext_vector_type(4)));
typedef unsigned u32x4 __attribute__((ext_vector_type(4)));
constexpr int BM = 256, BK = 64, HALF = 128, HTB = HALF * BK * 2  , STAGE_BYTES = 8 * HTB, NXCD = 8, WGM = 8;
constexpr int XCH_OFF = 143360;

__host__ __device__ __forceinline__ int lds_byte(int r, int c) { const int st = (r >> 4) * 2 + (c >> 5), rr = r & 15, cc = c & 31, ob = rr * 64 + cc * 2; return st * 1024 + (ob ^ (((ob >> 9) & 1) << 5)); }
__host__ __device__ __forceinline__ void stage_rc(int b, int& R, int& C) { const int st = b / 1024, sb = b % 1024, swz = sb ^ (((sb >> 9) & 1) << 5); R = (st >> 1) * 16 + swz / 64; C = (st & 1) * 32 + (swz % 64) / 2; }
__host__ __device__ __forceinline__ int perm32(int rho) { const int n = rho >> 4, i = rho & 15; return 8 * (i >> 2) + 4 * n + (i & 3); }

struct Unit { int pm, pn; };
struct Gemm { const bf16_t* A; const bf16_t* Bt; int M, N, K; };

struct StaticOrder {
    int nM, nN, nwg, G, c, wgm;
    __host__ __device__ void init(int M, int N, int G_, int c_, int wgm_ = WGM) { nM = M / BM; nN = N / BM; nwg = nM * nN; G = G_; c = c_; wgm = wgm_; }
    __host__ __device__ bool next(int i, Unit& u) const {
        const long L = (long)i * G + c; if (L >= nwg) return false;
        int wgid = (int)L; { const int q = nwg / NXCD, r = nwg % NXCD, xcd = wgid % NXCD, off = wgid / NXCD; wgid = (xcd < r ? xcd * (q + 1) : r * (q + 1) + (xcd - r) * q) + off; }
        const int nig = wgm * nN, gid = wgid / nig, fm = gid * wgm, gsz = (nM - fm) < wgm ? (nM - fm) : wgm;
        u.pm = fm + ((wgid % nig) % gsz); u.pn = (wgid % nig) / gsz; return true;
    }
    __device__ __forceinline__ void a_ready(const Unit&) const {}
    __device__ __forceinline__ void done(const Unit&) const {}
};
typedef __bf16 bf16x2_t __attribute__((ext_vector_type(2)));
typedef float f32x2_t __attribute__((ext_vector_type(2)));
__device__ __forceinline__ unsigned cvt_pk_bf16(float lo, float hi) { f32x2_t v = {lo, hi}; bf16x2_t b = __builtin_convertvector(v, bf16x2_t); return __builtin_bit_cast(unsigned, b); }
typedef float f32x2 __attribute__((ext_vector_type(2)));
#ifndef RS_ASM
#define RS_ASM 0
#endif
template <class Epi, class Sched, bool ALIGN_EPI = false, bool SP2 = false>
__device__ __forceinline__ void gemm_phase(PG8_LAS unsigned char* lds, const Gemm g, const Sched& S, const Epi& E) {
    int tid_l = threadIdx.x; asm volatile("" : "+v"(tid_l));
    const int tid = tid_l, wid = __builtin_amdgcn_readfirstlane(tid >> 6), lane = tid & 63, wr = wid >> 2, wc = wid & 3, fr = lane & 15, fq = lane >> 4;
    const int K = g.K, nt = K / BK;
    unsigned voffA[2], voffB[2];
#pragma unroll
    for (int i = 0; i < 2; ++i) { int R, C; stage_rc(tid * 16 + i * 8192, R, C); const int Rb = Epi::PERM ? ((R & ~31) + perm32(R & 31)) : R;
        voffA[i] = (unsigned)(R * K + C) * 2u; voffB[i] = (unsigned)(Rb * K + C) * 2u; }
    const size_t kstep = (size_t)(BK * 2);
    const size_t hstep = (size_t)HALF * K * 2;
    const size_t tstep = 2 * hstep;
    const unsigned ldsw = (unsigned)wid * 1024u;
    const int aoff = lds_byte(wr * 64 + fr, fq * 8), boff = lds_byte(wc * 32 + fr, fq * 8);
#define PG8_SA(b, h) (((b) * 2 + (h)) * HTB)
#define PG8_SB(b, h) ((4 + (b) * 2 + (h)) * HTB)
#define PG8_STAGE(bufoff, gbase, voff) do { _Pragma("unroll") for (int _i = 0; _i < 2; ++_i) \
        __builtin_amdgcn_global_load_lds((const unsigned*)((const char*)(gbase) + (voff)[_i]), (PG8_LAS unsigned*)(lds + (bufoff) + ldsw + _i * 8192), 16, 0, 0); } while (0)
#define PG8_LDA(dst, b, h) do { _Pragma("unroll") for (int m = 0; m < 4; ++m) _Pragma("unroll") for (int k = 0; k < 2; ++k) dst[m][k] = *(const PG8_LAS bf16x8*)(lds + PG8_SA(b, h) + aoff + m * 2048 + k * 1024); } while (0)
#define PG8_LDB(dst, b, h) do { _Pragma("unroll") for (int n = 0; n < 2; ++n) _Pragma("unroll") for (int k = 0; k < 2; ++k) dst[n][k] = *(const PG8_LAS bf16x8*)(lds + PG8_SB(b, h) + boff + n * 2048 + k * 1024); } while (0)
#define PG8_MMA(ai, bj, At, Bt) do { __builtin_amdgcn_s_setprio(1); _Pragma("unroll") for (int k = 0; k < 2; ++k) _Pragma("unroll") for (int m = 0; m < 4; ++m) _Pragma("unroll") for (int n = 0; n < 2; ++n) \
        acc[ai][bj][m][n] = __builtin_amdgcn_mfma_f32_16x16x32_bf16(Bt[n][k], At[m][k], acc[ai][bj][m][n], 0, 0, 0); __builtin_amdgcn_s_setprio(0); } while (0)
#define PG8_WAIT_V(n) asm volatile("s_waitcnt vmcnt(" #n ")" ::: "memory")
#define PG8_WAIT_L(n) asm volatile("s_waitcnt lgkmcnt(" #n ")" ::: "memory")
#define PG8_BAR __builtin_amdgcn_s_barrier()
#define PG8_SCHED __builtin_amdgcn_sched_barrier(0)
    Unit cur, nxt; int ui = 0;
    if (!S.next(0, cur)) return;
    f32x4 acc[2][2][4][2];
#pragma unroll
    for (int a = 0; a < 2; ++a)
#pragma unroll
        for (int b = 0; b < 2; ++b)
#pragma unroll
            for (int m = 0; m < 4; ++m)
#pragma unroll
                for (int n = 0; n < 2; ++n) acc[a][b][m][n] = (f32x4){0.f, 0.f, 0.f, 0.f};
    bf16x8 At[4][2], B0[2][2], B1[2][2];
    unsigned long long rsq64 = 0ull;
    PG8_LAS float* const rstab = (PG8_LAS float*)(lds + STAGE_BYTES);
    const char* cA = (const char*)g.A + (size_t)cur.pm * tstep; const char* cB = (const char*)g.Bt + (size_t)cur.pn * tstep;
    S.a_ready(cur);
    if constexpr (SP2) {
        PG8_STAGE(PG8_SB(0, 0), cB, voffB); PG8_STAGE(PG8_SB(0, 1), cB + hstep, voffB); PG8_STAGE(PG8_SA(0, 0), cA, voffA); PG8_STAGE(PG8_SA(0, 1), cA + hstep, voffA);
        if (wr == 1) PG8_BAR;
        PG8_WAIT_V(2); PG8_BAR;
        PG8_STAGE(PG8_SB(1, 0), cB + kstep, voffB); PG8_STAGE(PG8_SA(1, 0), cA + kstep, voffA); PG8_STAGE(PG8_SB(1, 1), cB + hstep + kstep, voffB);
        PG8_WAIT_V(6); PG8_BAR;
    } else {
        PG8_STAGE(PG8_SB(0, 0), cB, voffB); PG8_STAGE(PG8_SA(0, 0), cA, voffA); PG8_STAGE(PG8_SB(0, 1), cB + hstep, voffB); PG8_STAGE(PG8_SA(0, 1), cA + hstep, voffA);
        if (wr == 1) PG8_BAR;
        PG8_WAIT_V(4); PG8_BAR;
        PG8_STAGE(PG8_SB(1, 0), cB + kstep, voffB); PG8_STAGE(PG8_SA(1, 0), cA + kstep, voffA); PG8_STAGE(PG8_SB(1, 1), cB + hstep + kstep, voffB);
        PG8_WAIT_V(6); PG8_BAR;
    }
    for (;;) {
        const bool has_next = S.next(ui + 1, nxt);
        const char* nA = has_next ? (const char*)g.A + (size_t)nxt.pm * tstep : cA; const char* nB = has_next ? (const char*)g.Bt + (size_t)nxt.pn * tstep : cB;
        for (int t = 0; t < nt; t += 2) {
            const bool last = (t == nt - 2);
            const char* a1 = cA + (size_t)(t + 1) * kstep;
            const char* a2 = last ? nA : cA + (size_t)(t + 2) * kstep; const char* b2 = last ? nB : cB + (size_t)(t + 2) * kstep;
            const char* a3 = a2 + kstep; const char* b3 = b2 + kstep;
            if (last && has_next) S.a_ready(nxt);
            if constexpr (Epi::ROWSCALE) { if (last && wr == 0) { const unsigned long long* rp = E.ss + cur.pm * BM + tid;
                asm volatile("global_load_dwordx2 %0, %1, off" : "+v"(rsq64) : "v"(rp) : "memory"); } }
            if constexpr (SP2) {
            PG8_LDB(B0, 0, 0); PG8_LDB(B1, 0, 1); PG8_SCHED; PG8_LDA(At, 0, 0); PG8_STAGE(PG8_SA(1, 1), a1 + hstep, voffA);
            PG8_WAIT_V(8); PG8_WAIT_L(0); PG8_BAR; PG8_MMA(0, 0, At, B0); PG8_MMA(0, 1, At, B1); PG8_BAR; PG8_SCHED;
            PG8_LDA(At, 0, 1); PG8_STAGE(PG8_SB(0, 0), b2, voffB); PG8_STAGE(PG8_SB(0, 1), b2 + hstep, voffB); PG8_STAGE(PG8_SA(0, 0), a2, voffA);
            PG8_WAIT_V(8); PG8_WAIT_L(0); PG8_BAR; PG8_MMA(1, 0, At, B0); PG8_MMA(1, 1, At, B1); PG8_BAR; PG8_SCHED;
            PG8_LDB(B0, 1, 0); PG8_LDB(B1, 1, 1); PG8_SCHED; PG8_LDA(At, 1, 0); PG8_STAGE(PG8_SA(0, 1), a2 + hstep, voffA);
            PG8_WAIT_V(8); PG8_WAIT_L(0); PG8_BAR; PG8_MMA(0, 0, At, B0); PG8_MMA(0, 1, At, B1); PG8_BAR; PG8_SCHED;
            if constexpr (Epi::ROWSCALE) { if (last && wr == 0) {
                const float ssum = (float)rsq64 * (1.0f / 16777216.0f);
                rstab[(((tid >> 6) & 1) * 16 + (tid & 15)) * 8 + (tid >> 7) * 4 + ((tid >> 4) & 3)] = __builtin_amdgcn_rsqf(ssum * (1.f / 2048.f) + 1e-6f); } }
            PG8_LDA(At, 1, 1); PG8_STAGE(PG8_SB(1, 0), b3, voffB); PG8_STAGE(PG8_SB(1, 1), b3 + hstep, voffB); PG8_STAGE(PG8_SA(1, 0), a3, voffA);
            PG8_WAIT_V(8); PG8_WAIT_L(0); PG8_BAR; PG8_MMA(1, 0, At, B0); PG8_MMA(1, 1, At, B1); PG8_BAR; PG8_SCHED;
            } else {
            PG8_LDB(B0, 0, 0); PG8_SCHED; PG8_LDA(At, 0, 0); PG8_STAGE(PG8_SA(1, 1), a1 + hstep, voffA);
            PG8_WAIT_L(8); PG8_BAR; PG8_WAIT_L(0); PG8_MMA(0, 0, At, B0); PG8_BAR; PG8_SCHED;
            PG8_LDB(B1, 0, 1); PG8_STAGE(PG8_SB(0, 0), b2, voffB);
            PG8_BAR; PG8_WAIT_L(0); PG8_MMA(0, 1, At, B1); PG8_BAR;
            PG8_LDA(At, 0, 1); PG8_STAGE(PG8_SA(0, 0), a2, voffA);
            PG8_BAR; PG8_WAIT_L(0); PG8_MMA(1, 0, At, B0); PG8_BAR; PG8_SCHED;
            PG8_STAGE(PG8_SB(0, 1), b2 + hstep, voffB);
            PG8_WAIT_V(6); PG8_BAR; PG8_MMA(1, 1, At, B1); PG8_BAR;
            PG8_LDB(B0, 1, 0); PG8_SCHED; PG8_LDA(At, 1, 0); PG8_STAGE(PG8_SA(0, 1), a2 + hstep, voffA);
            PG8_WAIT_L(8); PG8_BAR; PG8_WAIT_L(0); PG8_MMA(0, 0, At, B0); PG8_BAR; PG8_SCHED;
            PG8_LDB(B1, 1, 1); PG8_STAGE(PG8_SB(1, 0), b3, voffB);
            PG8_BAR; PG8_WAIT_L(0); PG8_MMA(0, 1, At, B1); PG8_BAR;
            PG8_LDA(At, 1, 1); PG8_STAGE(PG8_SA(1, 0), a3, voffA);
            PG8_BAR; PG8_WAIT_L(0); PG8_MMA(1, 0, At, B0); PG8_BAR; PG8_SCHED;
            PG8_STAGE(PG8_SB(1, 1), b3 + hstep, voffB);
            PG8_WAIT_V(6); PG8_BAR; PG8_MMA(1, 1, At, B1); PG8_BAR;
            }
        }
        if constexpr (ALIGN_EPI) { if (wr == 0) PG8_BAR; }
        if constexpr (!Epi::AFTER_DRAIN) { if constexpr (Epi::ROWSCALE) {
            const f32x4 ra = *(const PG8_LAS f32x4*)(rstab + (wr * 16 + fr) * 8), rb = *(const PG8_LAS f32x4*)(rstab + (wr * 16 + fr) * 8 + 4);
            const float rs[8] = {ra[0], ra[1], ra[2], ra[3], rb[0], rb[1], rb[2], rb[3]};
            if constexpr (Epi::NEEDS_LDS) E(acc, cur, wr, wc, fr, fq, rs, (PG8_LAS float*)(lds + XCH_OFF)); else E(acc, cur, wr, wc, fr, fq, rs); } else E(acc, cur, wr, wc, fr, fq); S.done(cur); }
        if (!has_next) break;
#pragma unroll
        for (int a = 0; a < 2; ++a)
#pragma unroll
            for (int b = 0; b < 2; ++b)
#pragma unroll
                for (int m = 0; m < 4; ++m)
#pragma unroll
                    for (int n = 0; n < 2; ++n) acc[a][b][m][n] = (f32x4){0.f, 0.f, 0.f, 0.f};
        cur = nxt; cA = nA; cB = nB; ++ui;
        if constexpr (ALIGN_EPI) { if (wr == 1) PG8_BAR; }
    }
    PG8_WAIT_V(0);
    if constexpr (!ALIGN_EPI) { if (wr == 0) PG8_BAR; }
    PG8_BAR;
    if constexpr (Epi::AFTER_DRAIN) { E.fused(acc, cur, wr, wc, fr, fq, lds, wid, lane); S.done(cur); }
#undef PG8_SA
#undef PG8_SB
#undef PG8_STAGE
#undef PG8_LDA
#undef PG8_LDB
#undef PG8_MMA
#undef PG8_WAIT_V
#undef PG8_WAIT_L
#undef PG8_BAR
#undef PG8_SCHED
}
}
namespace pg8 {
struct EpiSwiGLU {
    static constexpr bool PERM = true, AFTER_DRAIN = false, ROWSCALE = true, NEEDS_LDS = false;
    bf16_t* O; int ldc; const unsigned long long* ss;
    __device__ __forceinline__ void operator()(const f32x4 (&acc)[2][2][4][2], const Unit& u, int wr, int wc, int fr, int fq, const float (&rs)[8]) const {
        const int row0 = u.pm * BM + wr * 64 + fr, col0 = u.pn * HALF + wc * 32 + 8 * fq;
#pragma unroll
        for (int ai = 0; ai < 2; ++ai)
#pragma unroll
            for (int m = 0; m < 4; ++m) { bf16_t* rowp = O + (size_t)(row0 + ai * HALF + m * 16) * ldc + col0;
                const float rstd = rs[ai * 4 + m];
                const float c1 = rstd * -1.4426950408889634f, r2 = rstd * rstd;
                float h[8];
#pragma unroll
                for (int n = 0; n < 2; ++n) { const f32x4 ag = acc[ai][0][m][n], au = acc[ai][1][m][n];
                    const f32x4 arg = ag * c1; f32x4 den;
#pragma unroll
                    for (int j = 0; j < 4; ++j) den[j] = __builtin_amdgcn_exp2f(arg[j]);
                    den = den + 1.0f;
#pragma unroll
                    for (int j = 0; j < 4; ++j) den[j] = __builtin_amdgcn_rcpf(den[j]);
                    const f32x4 hv = (ag * au) * (den * r2);
#pragma unroll
                    for (int j = 0; j < 4; ++j) h[4 * n + j] = hv[j]; }
                u32x4 w; w.x = cvt_pk_bf16(h[0], h[1]); w.y = cvt_pk_bf16(h[2], h[3]); w.z = cvt_pk_bf16(h[4], h[5]); w.w = cvt_pk_bf16(h[6], h[7]);
                __builtin_nontemporal_store(w, (u32x4*)rowp); }
    }
};
struct EpiResid {
    static constexpr bool PERM = true, AFTER_DRAIN = false, ROWSCALE = false;
    const void* base; void* out; unsigned long long* ssq; int base_f32, out_f32; float scale;
    static constexpr int row_off = 0;
    static __device__ __forceinline__ void row_sum(float t, int j, int fq, float& ta, float& tb) {
        { const auto r = __builtin_amdgcn_permlane16_swap(__float_as_uint(t), __float_as_uint(t), false, false); t = __uint_as_float(r[0]) + __uint_as_float(r[1]); }
        { const auto r = __builtin_amdgcn_permlane32_swap(__float_as_uint(t), __float_as_uint(t), false, false); t = __uint_as_float(r[0]) + __uint_as_float(r[1]); }
        if (j & 1) tb = (fq == (j >> 1)) ? t : tb; else ta = (fq == (j >> 1)) ? t : ta;
    }
    __device__ __forceinline__ void operator()(const f32x4 (&acc)[2][2][4][2], const Unit& u, int wr, int wc, int fr, int fq) const {
        const int row0 = u.pm * BM + wr * 64 + fr, col0 = u.pn * BM + wc * 32 + 8 * fq;
        const unsigned e0 = (unsigned)((row_off + row0) * 2048 + col0);
        const bool bf = base_f32 != 0, of = out_f32 != 0;
        float ta = 0.f, tb = 0.f;
        if (!bf) {
            u32x4 raw[2][4][2];
#pragma unroll
            for (int ai = 0; ai < 2; ++ai)
#pragma unroll
                for (int m = 0; m < 4; ++m)
#pragma unroll
                    for (int bj = 0; bj < 2; ++bj) raw[ai][m][bj] = *(const u32x4*)((const bf16_t*)base + e0 + (unsigned)((ai * HALF + m * 16) * 2048 + bj * HALF));
#pragma unroll
            for (int ai = 0; ai < 2; ++ai)
#pragma unroll
                for (int m = 0; m < 4; ++m) { float rsum = 0.f;
#pragma unroll
                    for (int bj = 0; bj < 2; ++bj) { const unsigned eo = e0 + (unsigned)((ai * HALF + m * 16) * 2048 + bj * HALF); const u32x4 w = raw[ai][m][bj];
                        const f32x4 b0 = (f32x4){__uint_as_float(w.x << 16), __uint_as_float(w.x & 0xffff0000u), __uint_as_float(w.y << 16), __uint_as_float(w.y & 0xffff0000u)};
                        const f32x4 b1 = (f32x4){__uint_as_float(w.z << 16), __uint_as_float(w.z & 0xffff0000u), __uint_as_float(w.w << 16), __uint_as_float(w.w & 0xffff0000u)};
                        const f32x4 v0 = b0 + acc[ai][bj][m][0] * scale, v1 = b1 + acc[ai][bj][m][1] * scale;
                        rsum += (v0[0] * v0[0] + v0[1] * v0[1]) + (v0[2] * v0[2] + v0[3] * v0[3]) + (v1[0] * v1[0] + v1[1] * v1[1]) + (v1[2] * v1[2] + v1[3] * v1[3]);
                        if (of) { __builtin_nontemporal_store(v0, (f32x4*)((float*)out + eo)); __builtin_nontemporal_store(v1, (f32x4*)((float*)out + eo + 4)); }
                        else { u32x4 o; o.x = cvt_pk_bf16(v0[0], v0[1]); o.y = cvt_pk_bf16(v0[2], v0[3]); o.z = cvt_pk_bf16(v1[0], v1[1]); o.w = cvt_pk_bf16(v1[2], v1[3]);
                            *(u32x4*)((bf16_t*)out + eo) = o; } }
                    row_sum(rsum, ai * 4 + m, fq, ta, tb); }
        } else {
#pragma unroll
            for (int ai = 0; ai < 2; ++ai) {
                f32x4 b0[4][2], b1[4][2];
#pragma unroll
                for (int m = 0; m < 4; ++m)
#pragma unroll
                    for (int bj = 0; bj < 2; ++bj) { const unsigned eo = e0 + (unsigned)((ai * HALF + m * 16) * 2048 + bj * HALF);
                        b0[m][bj] = __builtin_nontemporal_load((const f32x4*)((const float*)base + eo)); b1[m][bj] = __builtin_nontemporal_load((const f32x4*)((const float*)base + eo + 4)); }
#pragma unroll
                for (int m = 0; m < 4; ++m) { float rsum = 0.f;
#pragma unroll
                    for (int bj = 0; bj < 2; ++bj) { const unsigned eo = e0 + (unsigned)((ai * HALF + m * 16) * 2048 + bj * HALF);
                        const f32x4 v0 = b0[m][bj] + acc[ai][bj][m][0] * scale, v1 = b1[m][bj] + acc[ai][bj][m][1] * scale;
                        rsum += (v0[0] * v0[0] + v0[1] * v0[1]) + (v0[2] * v0[2] + v0[3] * v0[3]) + (v1[0] * v1[0] + v1[1] * v1[1]) + (v1[2] * v1[2] + v1[3] * v1[3]);
                        if (of) { __builtin_nontemporal_store(v0, (f32x4*)((float*)out + eo)); __builtin_nontemporal_store(v1, (f32x4*)((float*)out + eo + 4)); }
                        else { u32x4 o; o.x = cvt_pk_bf16(v0[0], v0[1]); o.y = cvt_pk_bf16(v0[2], v0[3]); o.z = cvt_pk_bf16(v1[0], v1[1]); o.w = cvt_pk_bf16(v1[2], v1[3]);
                            *(u32x4*)((bf16_t*)out + eo) = o; } }
                    row_sum(rsum, ai * 4 + m, fq, ta, tb); }
                __builtin_amdgcn_sched_barrier(0);
            }
        }
        { unsigned long long* sp = ssq + row0 + (fq >> 1) * HALF + (fq & 1) * 32;
            __hip_atomic_fetch_add(sp, (unsigned long long)(ta * 16777216.0f), __ATOMIC_RELAXED, __HIP_MEMORY_SCOPE_AGENT);
            __hip_atomic_fetch_add(sp + 16, (unsigned long long)(tb * 16777216.0f), __ATOMIC_RELAXED, __HIP_MEMORY_SCOPE_AGENT); }
    }
};
struct EpiZ {
    static constexpr bool PERM = true, AFTER_DRAIN = false, ROWSCALE = true, NEEDS_LDS = true;
    bf16_t* Z; const unsigned long long* ss; const float* qg; const float* kg; int ldz;
    __device__ __forceinline__ void operator()(const f32x4 (&acc)[2][2][4][2], const Unit& u, int wr, int wc, int fr, int fq, const float (&rs)[8], PG8_LAS float* xch) const {
        const int row0 = u.pm * BM + wr * 64 + fr;
        const int col0 = u.pn * BM + wc * 32 + 8 * fq;
        if (u.pn < 4 || u.pn >= 10) {
#pragma unroll
            for (int ai = 0; ai < 2; ++ai)
#pragma unroll
                for (int m = 0; m < 4; ++m) { bf16_t* rowp = Z + (size_t)(row0 + ai * HALF + m * 16) * ldz + col0;
                    const float rstd = rs[ai * 4 + m];
#pragma unroll
                    for (int bj = 0; bj < 2; ++bj) { const f32x4 v0 = acc[ai][bj][m][0] * rstd, v1 = acc[ai][bj][m][1] * rstd;
                        u32x4 w; w.x = cvt_pk_bf16(v0[0], v0[1]); w.y = cvt_pk_bf16(v0[2], v0[3]); w.z = cvt_pk_bf16(v1[0], v1[1]); w.w = cvt_pk_bf16(v1[2], v1[3]);
                        __builtin_nontemporal_store(w, (u32x4*)(rowp + bj * HALF)); } }
            return;
        }
        asm volatile("" : "+v"(fr), "+v"(fq));
        const bool isq = u.pn < 7;
        const float* gp = (isq ? qg : kg) + wc * 32 + 8 * fq;
        const f32x4 g0 = *(const f32x4*)gp, g1 = *(const f32x4*)(gp + 4);
        float keep[2][2];
#pragma unroll
        for (int ai = 0; ai < 2; ++ai)
#pragma unroll
            for (int m = 0; m < 4; ++m) { const float rstd = rs[ai * 4 + m];
#pragma unroll
                for (int bj = 0; bj < 2; ++bj) { const f32x4 v0 = acc[ai][bj][m][0] * rstd, v1 = acc[ai][bj][m][1] * rstd;
                    float t = (v0[0] * v0[0] + v0[1] * v0[1]) + (v0[2] * v0[2] + v0[3] * v0[3]) + (v1[0] * v1[0] + v1[1] * v1[1]) + (v1[2] * v1[2] + v1[3] * v1[3]);
                    { const auto r = __builtin_amdgcn_permlane16_swap(__float_as_uint(t), __float_as_uint(t), false, false); t = __uint_as_float(r[0]) + __uint_as_float(r[1]); }
                    { const auto r = __builtin_amdgcn_permlane32_swap(__float_as_uint(t), __float_as_uint(t), false, false); t = __uint_as_float(r[0]) + __uint_as_float(r[1]); }
                    if (m == 0) keep[ai][bj] = t; else keep[ai][bj] = (fq == m) ? t : keep[ai][bj]; } }
#pragma unroll
        for (int ai = 0; ai < 2; ++ai)
#pragma unroll
            for (int bj = 0; bj < 2; ++bj) xch[(ai * HALF + wr * 64 + fq * 16 + fr) * 8 + bj * 4 + wc] = keep[ai][bj];
        asm volatile("s_waitcnt lgkmcnt(0)" ::: "memory");
        __builtin_amdgcn_s_barrier();
        const float qscale = isq ? 0.08838834764831845f : 1.0f;
#pragma unroll
        for (int ai = 0; ai < 2; ++ai)
#pragma unroll
            for (int m = 0; m < 4; ++m) { const int rt = ai * HALF + wr * 64 + m * 16 + fr; bf16_t* rowp = Z + (size_t)(u.pm * BM + rt) * ldz + col0;
                const float rstd = rs[ai * 4 + m];
#pragma unroll
                for (int bj = 0; bj < 2; ++bj) {
                    const f32x4 px = *(const PG8_LAS f32x4*)(xch + rt * 8 + bj * 4);
                    const float rq = __builtin_amdgcn_rsqf(((px[0] + px[1]) + (px[2] + px[3])) * (1.f / 128.f) + 1e-6f) * rstd * qscale;
                    f32x4 v0 = acc[ai][bj][m][0] * rq * g0, v1 = acc[ai][bj][m][1] * rq * g1;
                    u32x4 w; w.x = cvt_pk_bf16(v0[0], v0[1]); w.y = cvt_pk_bf16(v0[2], v0[3]); w.z = cvt_pk_bf16(v1[0], v1[1]); w.w = cvt_pk_bf16(v1[2], v1[3]);
                    __builtin_nontemporal_store(w, (u32x4*)(rowp + bj * HALF)); } }
    }
};
}
constexpr int NWAVES = 8;
constexpr int BATCH = 4, SEQ = 8192, DM = 2048, DFF = 5632, DEPTH = 4;
constexpr int M = BATCH * SEQ;
constexpr int NIN = 5648, NZ = 5632, NINP = 5888;
constexpr int ZLD = NZ;
constexpr int ZC_AU = 0, ZC_AV = 512, ZC_BQ = 1024, ZC_BK = 1792, ZC_BV = 2560, ZC_CQ = 3328, ZC_CK = 3712, ZC_CV = 4096, ZC_CG = 4864;
constexpr int YC_A = 0, YC_B = 512, YC_C = 1280;
constexpr int NCHUNK = M / 64;
constexpr float EPS = 1e-6f;

constexpr size_t MiB = 1u << 20;
constexpr size_t WS_CTL = 0, CTL_ZERO_BYTES = 1 * MiB;
constexpr size_t WS_ROPE = 1 * MiB;
constexpr size_t WS_DEC = 4 * MiB;
constexpr size_t WS_LSE = 5 * MiB;
constexpr size_t WS_W = 8 * MiB;
constexpr size_t W_GU = (size_t)2 * DFF * DM * 2, W_D = (size_t)DM * DFF * 2, W_IN = (size_t)NINP * DM * 2, W_OUT = (size_t)DM * DM * 2;
constexpr size_t WL_GU0 = 0, WL_D0 = WL_GU0 + W_GU, WL_GU1 = WL_D0 + W_D, WL_D1 = WL_GU1 + W_GU, WL_IN = WL_D1 + W_D, WL_OUT = WL_IN + W_IN, W_LAYER = WL_OUT + W_OUT;
constexpr size_t WS_H = WS_W + DEPTH * W_LAYER;
constexpr size_t WS_HZ = WS_H + (size_t)M * DM * 2;
constexpr size_t WS_Y = WS_HZ + (size_t)M * DFF * 2;
constexpr size_t WS_OG = WS_Y + (size_t)M * DM * 2;
constexpr size_t WS_QD = WS_OG + (size_t)3 * M * 768 * 2;
constexpr size_t WS_KD = WS_QD + (size_t)M * 384 * 2;
constexpr size_t WS_SB = WS_KD + (size_t)M * 384 * 2;
constexpr size_t WS_SS = WS_SB + (size_t)NCHUNK * 6 * 8192 * 2;
constexpr size_t WS_END = WS_SS + (size_t)13 * M * 8;
constexpr float SS_SCALE = 16777216.0f, SS_INV = 1.0f / 16777216.0f;
static_assert(W_LAYER == 163 * MiB && WS_H == 660 * MiB && (size_t)NCHUNK * 6 * 128 * 64 * 4 <= (size_t)M * DM * 2, "ws map");
constexpr int CW_BAR = 4096;

constexpr int SCR_BYTES = 139264;
constexpr int LDSCTL_OFF = SCR_BYTES;
constexpr int LDSX_OFF = 143360;
constexpr int LDS_BYTES = 151552;
static_assert(LDSX_OFF == pg8::XCH_OFF, "lds");
static_assert(pg8::STAGE_BYTES <= SCR_BYTES, "lds");

#define GAS __attribute__((address_space(1)))
#define LAS __attribute__((address_space(3)))
typedef unsigned short bf16;
typedef unsigned v4u __attribute__((ext_vector_type(4)));
typedef unsigned v2u __attribute__((ext_vector_type(2)));
typedef float f32x4 __attribute__((ext_vector_type(4)));
typedef short bf16x8 __attribute__((ext_vector_type(8)));
typedef short s16x4 __attribute__((ext_vector_type(4)));
#define LDS_WAIT() asm volatile("s_waitcnt lgkmcnt(0)" ::: "memory")
__device__ __forceinline__ float bflo(unsigned w) { return __uint_as_float(w << 16); }
__device__ __forceinline__ float bfhi(unsigned w) { return __uint_as_float(w & 0xffff0000u); }
__device__ __forceinline__ float bf1(bf16 b) { return __uint_as_float(((unsigned)b) << 16); }
__device__ __forceinline__ unsigned pk2(float lo, float hi) { return pg8::cvt_pk_bf16(lo, hi); }
__device__ __forceinline__ bf16 f2bf(float f) { return (bf16)(pg8::cvt_pk_bf16(f, 0.f) & 0xffffu); }
__device__ __forceinline__ void unpack8(const v4u w, float (&f)[8]) { f[0] = bflo(w.x); f[1] = bfhi(w.x); f[2] = bflo(w.y); f[3] = bfhi(w.y); f[4] = bflo(w.z); f[5] = bfhi(w.z); f[6] = bflo(w.w); f[7] = bfhi(w.w); }
__device__ __forceinline__ v4u pack8(const float (&f)[8]) { v4u w; w.x = pk2(f[0], f[1]); w.y = pk2(f[2], f[3]); w.z = pk2(f[4], f[5]); w.w = pk2(f[6], f[7]); return w; }
__device__ __forceinline__ float gelu_tanh(float x) {
    const float u = 0.7978845608028654f * (x + 0.044715f * x * x * x);
    const float e = __expf(2.0f * u);
    const float th = 1.0f - 2.0f * __builtin_amdgcn_rcpf(1.0f + e);
    return 0.5f * x * (1.0f + th);
}
__device__ __forceinline__ float silu_f(float x) { return x * __builtin_amdgcn_rcpf(1.0f + __expf(-x)); }
__device__ __forceinline__ bf16x8 lds_row8(const LAS unsigned char* p) { return *(const LAS bf16x8*)p; }
typedef short v4i16_t __attribute__((ext_vector_type(4)));
__device__ __forceinline__ s16x4 lds_tr4(const LAS unsigned char* p) { return __builtin_bit_cast(s16x4, __builtin_amdgcn_ds_read_tr16_b64_v4i16((LAS v4i16_t*)p)); }
__device__ __forceinline__ bf16x8 cat8(s16x4 lo, s16x4 hi) { return __builtin_shufflevector(lo, hi, 0, 1, 2, 3, 4, 5, 6, 7); }
#define MFMA16(a, b, c) __builtin_amdgcn_mfma_f32_16x16x32_bf16((a), (b), (c), 0, 0, 0)
__device__ __forceinline__ v4u widen_pair(v2u a, v2u b) {
    const auto rx = __builtin_amdgcn_permlane16_swap(a.x, b.x, false, false); const auto ry = __builtin_amdgcn_permlane16_swap(a.y, b.y, false, false);
    v4u w; w.x = rx[0]; w.y = ry[0]; w.z = rx[1]; w.w = ry[1]; return w;
}
__device__ __forceinline__ void unwiden_pair(v4u w, v2u& a, v2u& b) {
    const auto rx = __builtin_amdgcn_permlane16_swap(w.x, w.z, false, false); const auto ry = __builtin_amdgcn_permlane16_swap(w.y, w.w, false, false);
    a.x = rx[0]; a.y = ry[0]; b.x = rx[1]; b.y = ry[1];
}
__device__ __forceinline__ int wide_col(int g4) { return (g4 & 1) ? 16 + 4 * (g4 - 1) : 4 * g4; }

#define XB_TMO      128
#define XB_XCNT(j)  (256  + 64 * (j))
#define XB_XSUB(j)  (1280 + 64 * (j))
#define XB_XGEN(j)  (2304 + 64 * (j))
#define XB_TOP      3328
#define XB_TOPGEN   3392
#define XCD_BAR_WORDS 3456
#define XB_SPIN_CAP (1u << 21)

__device__ __forceinline__ unsigned xb_ld(unsigned* p)              { return __hip_atomic_load(p, __ATOMIC_RELAXED, __HIP_MEMORY_SCOPE_AGENT); }
__device__ __forceinline__ unsigned xb_add(unsigned* p, unsigned v) { return __hip_atomic_fetch_add(p, v, __ATOMIC_RELAXED, __HIP_MEMORY_SCOPE_AGENT); }
__device__ __forceinline__ unsigned xb_xcc_id() { return (unsigned)__builtin_amdgcn_s_getreg((3 << 11) | 20) & 0xFu; }
#define XB_SPIN(cond, bar) do { unsigned _sp = 0; while (cond) { __builtin_amdgcn_s_sleep(1); \
    if ((++_sp & 255u) == 0u) { if (xb_ld(&(bar)[XB_TMO])) break; if (_sp > XB_SPIN_CAP) { atomicAdd(&(bar)[XB_TMO], 1u); break; } } } } while (0)

struct XcdBarrier {
    unsigned* bar; unsigned x;
    volatile LAS unsigned* st;
};

__device__ __forceinline__ XcdBarrier xcd_barrier_post(unsigned* bar, volatile LAS unsigned* st) {
    XcdBarrier b; b.bar = bar; b.x = xb_xcc_id(); b.st = st;
    if (threadIdx.x == 0) (void)xb_add(&bar[XB_XCNT(b.x)], 1u);
    return b;
}
__device__ __forceinline__ void xcd_barrier_complete(unsigned* bar, unsigned x, unsigned& nloc, unsigned& nx) {
    const unsigned G = gridDim.x * gridDim.y * gridDim.z;
    unsigned sum, cnt, mine, sp = 0u;
    for (;;) {
        sum = 0u; cnt = 0u; mine = 0u;
#pragma unroll
        for (unsigned j = 0; j < 16; ++j) { const unsigned c = xb_ld(&bar[XB_XCNT(j)]); sum += c; cnt += (c > 0u) ? 1u : 0u; mine = (j == x) ? c : mine; }
        if (sum == G) break;
        __builtin_amdgcn_s_sleep(1);
        if ((++sp & 255u) == 0u) { if (xb_ld(&bar[XB_TMO])) break; if (sp > XB_SPIN_CAP) { atomicAdd(&bar[XB_TMO], 1u); break; } }
    }
    nloc = mine > 0u ? mine : 1u; nx = cnt > 0u ? cnt : 1u;
}

__device__ __forceinline__ void xcd_barrier(const XcdBarrier& b) {
    asm volatile("s_waitcnt vmcnt(0)" ::: "memory");
    __syncthreads();
    if (threadIdx.x == 0) {
        unsigned* bar = b.bar;
        __builtin_amdgcn_s_waitcnt(0);
        unsigned nloc = b.st[0], nx = b.st[1];
        if (nloc == 0u) { xcd_barrier_complete(bar, b.x, nloc, nx); b.st[0] = nloc; b.st[1] = nx; }
        const unsigned old = xb_add(&bar[XB_XSUB(b.x)], 1u);
        const unsigned gen = old / nloc;
        if (old + 1u == (gen + 1u) * nloc) {
            __builtin_amdgcn_fence(__ATOMIC_RELEASE, "agent");
            asm volatile("s_waitcnt vmcnt(0)" ::: "memory");
            const unsigned og = xb_add(&bar[XB_TOP], 1u);
            const unsigned tg = og / nx;
            if (og + 1u == (tg + 1u) * nx) xb_add(&bar[XB_TOPGEN], 1u);
            else XB_SPIN(xb_ld(&bar[XB_TOPGEN]) == tg, bar);
            __builtin_amdgcn_fence(__ATOMIC_ACQUIRE, "agent");
            xb_add(&bar[XB_XGEN(b.x)], 1u);
            asm volatile("s_waitcnt vmcnt(0)" ::: "memory");
        } else {
            XB_SPIN(xb_ld(&bar[XB_XGEN(b.x)]) == gen, bar);
            __builtin_amdgcn_fence(__ATOMIC_ACQUIRE, "agent");
            asm volatile("s_waitcnt vmcnt(0)" ::: "memory");
        }
    }
    __syncthreads();
}

struct Args {
    const float* in[16]; float* out; unsigned char* ws;
    float inv_freq[16];
};

__device__ __forceinline__ void transpose_item(const float* __restrict__ W, int ldw, int nvalid, int k0, int n0, bf16* __restrict__ WT, int ldt, int dst_row0, LAS float* scr, int lane, const float* __restrict__ gk = nullptr) {
    const int nq = lane & 15, kq = lane >> 4;
    const int nc = n0 + 4 * nq; const bool okc = nc < nvalid;
    const float* wp = W + (size_t)(k0 + kq) * ldw + nc;
    f32x4 v[16];
#pragma unroll
    for (int i = 0; i < 16; ++i) v[i] = okc ? __builtin_nontemporal_load((const f32x4*)(wp + (size_t)(4 * i) * ldw)) : (f32x4){0.f, 0.f, 0.f, 0.f};
    if (gk) {
        float gv[16];
#pragma unroll
        for (int i = 0; i < 16; ++i) gv[i] = gk[k0 + kq + 4 * i];
#pragma unroll
        for (int i = 0; i < 16; ++i) v[i] *= gv[i];
    }
    LAS float* sw = scr + (4 * nq) * 65 + kq;
#pragma unroll
    for (int i = 0; i < 16; ++i) { sw[4 * i] = v[i].x; sw[65 + 4 * i] = v[i].y; sw[130 + 4 * i] = v[i].z; sw[195 + 4 * i] = v[i].w; }
    LDS_WAIT(); asm volatile("" ::: "memory");
    const int c = lane & 7;
#pragma unroll
    for (int j = 0; j < 8; ++j) { const int n = (lane >> 3) + 8 * j; const LAS float* s = scr + n * 65 + 8 * c;
        v4u o; o.x = pk2(s[0], s[1]); o.y = pk2(s[2], s[3]); o.z = pk2(s[4], s[5]); o.w = pk2(s[6], s[7]);
        *(v4u*)(WT + (size_t)(dst_row0 + n) * ldt + k0 + 8 * c) = o; }
    LDS_WAIT(); asm volatile("" ::: "memory");
}
constexpr int IT_GU = (DM / 64) * (DFF / 64);
constexpr int IT_D = (DFF / 64) * (DM / 64);
constexpr int IT_IN = (DM / 64) * (NINP / 64);
constexpr int IT_OUT = (DM / 64) * (DM / 64);
constexpr int IT_LAYER = 2 * (2 * IT_GU + IT_D) + IT_IN + IT_OUT;

typedef const __attribute__((address_space(4))) Args* ArgPc;
__device__ __forceinline__ void prologue(ArgPc Ap, unsigned char* ws, LAS unsigned char* lds, int gw, int ngw, int wave, int lane, int gtid, int ngt) {
    LAS float* scr = (LAS float*)(lds + wave * 16640);
    for (int it = gw; it < DEPTH * IT_LAYER; it += ngw) {
        const int l = it / IT_LAYER; int r = it - l * IT_LAYER;
        unsigned char* wl = ws + WS_W + (size_t)l * W_LAYER;
        if (r < 2 * (2 * IT_GU + IT_D)) {
            const int f = r / (2 * IT_GU + IT_D); r -= f * (2 * IT_GU + IT_D);
            const size_t wsel = (size_t)(l * 2 + f);
            if (r < 2 * IT_GU) {
                const int up = r / IT_GU; r -= up * IT_GU;
                const float* W = (up ? Ap->in[3] : Ap->in[2]) + wsel * DM * DFF;
                const int kb = r / (DFF / 64), nb = r % (DFF / 64), n0 = nb * 64;
                bf16* WT = (bf16*)(wl + (f ? WL_GU1 : WL_GU0));
                transpose_item(W, DFF, DFF, kb * 64, n0, WT, DM, 256 * (n0 >> 7) + (n0 & 127) + 128 * up, scr, lane, Ap->in[1] + wsel * DM);
            } else {
                r -= 2 * IT_GU;
                const float* W = Ap->in[4] + wsel * DFF * DM;
                const int kb = r / (DM / 64), nb = r % (DM / 64);
                bf16* WT = (bf16*)(wl + (f ? WL_D1 : WL_D0));
                transpose_item(W, DM, DM, kb * 64, nb * 64, WT, DFF, nb * 64, scr, lane);
            }
        } else {
            r -= 2 * (2 * IT_GU + IT_D);
            if (r < IT_IN) {
                const float* W = Ap->in[6] + (size_t)l * DM * NIN;
                const int kb = r / (NINP / 64), nb = r % (NINP / 64);
                transpose_item(W, NIN, NIN, kb * 64, nb * 64, (bf16*)(wl + WL_IN), DM, nb * 64, scr, lane, Ap->in[5] + (size_t)l * DM);
            } else {
                r -= IT_IN;
                const float* W = Ap->in[15] + (size_t)l * DM * DM;
                const int kb = r / (DM / 64), nb = r % (DM / 64);
                transpose_item(W, DM, DM, kb * 64, nb * 64, (bf16*)(wl + WL_OUT), DM, nb * 64, scr, lane);
            }
        }
    }
    { unsigned long long* ss = (unsigned long long*)(ws + WS_SS); for (int i = M + gtid; i < 13 * M; i += ngt) ss[i] = 0ull; }
    float* rc = (float*)(ws + WS_ROPE); float* rs = rc + SEQ * 16;
    for (int i = gtid; i < SEQ * 16; i += ngt) {
        const int pos = i >> 4, k = i & 15;
        const float angf = (float)pos * Ap->inv_freq[k];
        const double a = (double)angf;
        const double q = __builtin_rint(a * 0.63661977236758134308);
        double x = __builtin_fma(-q, 1.57079632679489655800e+00, a); x = __builtin_fma(-q, 6.12323399573676603587e-17, x);
        const double x2 = x * x;
        double sp = 1.0 / 6227020800.0; sp = sp * x2 - 1.0 / 39916800.0; sp = sp * x2 + 1.0 / 362880.0; sp = sp * x2 - 1.0 / 5040.0; sp = sp * x2 + 1.0 / 120.0; sp = sp * x2 - 1.0 / 6.0; sp = sp * x2 + 1.0; sp *= x;
        double cp = 1.0 / 87178291200.0; cp = -cp; cp = cp * x2 + 1.0 / 479001600.0; cp = cp * x2 - 1.0 / 3628800.0; cp = cp * x2 + 1.0 / 40320.0; cp = cp * x2 - 1.0 / 720.0; cp = cp * x2 + 1.0 / 24.0; cp = cp * x2 - 0.5; cp = cp * x2 + 1.0;
        const int qi = ((int)q) & 3;
        const double sv = (qi == 0) ? sp : (qi == 1) ? cp : (qi == 2) ? -sp : -cp;
        const double cv = (qi == 0) ? cp : (qi == 1) ? -sp : (qi == 2) ? -cp : sp;
        rc[i] = (float)cv; rs[i] = (float)sv;
    }
}

__device__ __forceinline__ float wave_sum(float v) {
#pragma unroll
    for (int o = 1; o < 64; o <<= 1) v += __shfl_xor(v, o);
    return v;
}
__device__ __forceinline__ void conv_phase(const float* __restrict__ x, bf16* __restrict__ xb, unsigned long long* __restrict__ ss, int gw, int ngw, int lane) {
    for (int m = gw; m < M; m += ngw) {
        const f32x4* xr = (const f32x4*)(x + (size_t)m * DM) + lane;
        f32x4 v[8]; float s = 0.f;
#pragma unroll
        for (int j = 0; j < 8; ++j) { v[j] = xr[64 * j]; s += (v[j].x * v[j].x + v[j].y * v[j].y) + (v[j].z * v[j].z + v[j].w * v[j].w); }
        s = wave_sum(s);
        v2u* o = (v2u*)(xb + (size_t)m * DM) + lane;
#pragma unroll
        for (int j = 0; j < 8; ++j) { v2u w; w.x = pk2(v[j].x, v[j].y); w.y = pk2(v[j].z, v[j].w); o[64 * j] = w; }
        if (lane == 0) ss[m] = (unsigned long long)(s * SS_SCALE);
    }
}


constexpr int LD128 = 272;
constexpr int LD64 = 144;
__device__ __forceinline__ void gmlp_unit(LAS unsigned char* lds, const bf16* __restrict__ z, const float* __restrict__ sgw, const float* __restrict__ sgb, const float* __restrict__ sgn,
                                          bf16* __restrict__ y, int um, int tid, int w, int lane) {
    const int g = um & 3, cn = um >> 2; const size_t R0 = (size_t)cn * 128;
    const int c16 = lane & 15, g4 = lane >> 4, q4 = c16 >> 2, p4 = lane & 3;
    LAS unsigned char* WM = lds; LAS unsigned char* VN = lds + 128 * LD128;
#pragma unroll
    for (int it = 0; it < 4; ++it) {
        const int c = tid + 512 * it, t = c >> 4, ch = c & 15;
        const float* wp = sgw + ((size_t)(g * 128 + t)) * 128 + 8 * ch;
        const f32x4 w0 = *(const f32x4*)wp, w1 = *(const f32x4*)(wp + 4);
        float f[8] = {w0.x, w0.y, w0.z, w0.w, w1.x, w1.y, w1.z, w1.w};
#pragma unroll
        for (int e = 0; e < 8; ++e) f[e] = (8 * ch + e <= t) ? f[e] : 0.f;
        *(LAS v4u*)(WM + t * LD128 + ch * 16) = pack8(f);
        const v4u vw = *(const v4u*)(z + (R0 + t) * ZLD + ZC_AV + 128 * g + 8 * ch);
        float v[8]; unpack8(vw, v); float ss = 0.f;
#pragma unroll
        for (int e = 0; e < 8; ++e) { v[e] = gelu_tanh(v[e]); ss += v[e] * v[e]; }
        ss += __shfl_xor(ss, 1); ss += __shfl_xor(ss, 2); ss += __shfl_xor(ss, 4); ss += __shfl_xor(ss, 8);
        const float rstd = rsqrtf(ss * (1.f / 128.f) + EPS);
        const float* gp = sgn + 128 * g + 8 * ch;
        const f32x4 g0 = *(const f32x4*)gp, g1 = *(const f32x4*)(gp + 4);
        const float gg[8] = {g0.x, g0.y, g0.z, g0.w, g1.x, g1.y, g1.z, g1.w};
#pragma unroll
        for (int e = 0; e < 8; ++e) v[e] = v[e] * rstd * gg[e];
        *(LAS v4u*)(VN + t * LD128 + ch * 16) = pack8(v);
    }
    __syncthreads();
    f32x4 acc[8];
#pragma unroll
    for (int ct = 0; ct < 8; ++ct) acc[ct] = (f32x4){0.f, 0.f, 0.f, 0.f};
    const int nks = (w >> 1) + 1;
#pragma unroll
    for (int ks = 0; ks < 4; ++ks) {
        if (ks < nks) {
            const bf16x8 af = lds_row8(WM + (16 * w + c16) * LD128 + (32 * ks + 8 * g4) * 2);
            const LAS unsigned char* vb = VN + (32 * ks + 8 * g4 + q4) * LD128 + (4 * p4) * 2;
#pragma unroll
            for (int ct = 0; ct < 8; ++ct) {
                const bf16x8 bfr = cat8(lds_tr4(vb + ct * 32), lds_tr4(vb + 4 * LD128 + ct * 32));
                acc[ct] = MFMA16(bfr, af, acc[ct]);
            }
        }
    }
    const int t = 16 * w + c16; const float bias = sgb[g * 128 + t];
    const bf16* up = z + (R0 + t) * ZLD + ZC_AU + 128 * g + wide_col(g4);
    bf16* yp = y + (R0 + t) * DM + YC_A + 128 * g + wide_col(g4);
#pragma unroll
    for (int ct = 0; ct < 8; ct += 2) {
        v2u o[2], uu[2]; unwiden_pair(*(const v4u*)(up + 16 * ct), uu[0], uu[1]);
#pragma unroll
        for (int q = 0; q < 2; ++q) { const int c = ct + q;
            const v2u uw = uu[q];
            const float u0 = gelu_tanh(bflo(uw.x)), u1 = gelu_tanh(bfhi(uw.x)), u2 = gelu_tanh(bflo(uw.y)), u3 = gelu_tanh(bfhi(uw.y));
            o[q].x = pk2(u0 * (acc[c][0] + bias), u1 * (acc[c][1] + bias)); o[q].y = pk2(u2 * (acc[c][2] + bias), u3 * (acc[c][3] + bias)); }
        *(v4u*)(yp + 16 * ct) = widen_pair(o[0], o[1]);
    }
    __syncthreads();
}

__device__ __forceinline__ void qk_prepass(bf16* __restrict__ z, const float* __restrict__ qgain, const float* __restrict__ kgain, const float* __restrict__ ropec, const float* __restrict__ ropes,
                                           int gw, int ngw, int lane) {
    const int ch = lane & 15;
    const f32x4 q0 = *(const f32x4*)(qgain + 8 * ch), q1 = *(const f32x4*)(qgain + 8 * ch + 4), k0 = *(const f32x4*)(kgain + 8 * ch), k1 = *(const f32x4*)(kgain + 8 * ch + 4);
    const float qg[8] = {q0.x, q0.y, q0.z, q0.w, q1.x, q1.y, q1.z, q1.w}, kg[8] = {k0.x, k0.y, k0.z, k0.w, k1.x, k1.y, k1.z, k1.w};
    const float sg = (ch < 2) ? -1.f : 1.f;
    for (int m = gw; m < M; m += ngw) {
        bf16* zr = z + (size_t)m * ZLD + ZC_BQ + 8 * lane;
        const int t = m & (SEQ - 1);
        v4u w[3];
#pragma unroll
        for (int it = 0; it < 3; ++it) w[it] = *(const v4u*)(zr + 512 * it);
        float cc[8], sn[8];
        {
            const float* cp = ropec + t * 16 + 8 * (ch & 1); const float* sp = ropes + t * 16 + 8 * (ch & 1);
            const f32x4 c0 = *(const f32x4*)cp, c1 = *(const f32x4*)(cp + 4), s0 = *(const f32x4*)sp, s1 = *(const f32x4*)(sp + 4);
            cc[0] = c0.x; cc[1] = c0.y; cc[2] = c0.z; cc[3] = c0.w; cc[4] = c1.x; cc[5] = c1.y; cc[6] = c1.z; cc[7] = c1.w;
            sn[0] = s0.x; sn[1] = s0.y; sn[2] = s0.z; sn[3] = s0.w; sn[4] = s1.x; sn[5] = s1.y; sn[6] = s1.z; sn[7] = s1.w;
        }
#pragma unroll
        for (int it = 0; it < 3; ++it) {
            const bool isq = (4 * it + (lane >> 4)) < 6;
            float f[8]; unpack8(w[it], f); float ss = 0.f;
#pragma unroll
            for (int e = 0; e < 8; ++e) ss += f[e] * f[e];
            ss += __shfl_xor(ss, 1); ss += __shfl_xor(ss, 2); ss += __shfl_xor(ss, 4); ss += __shfl_xor(ss, 8);
            const float rstd = rsqrtf(ss * (1.f / 128.f) + EPS);
#pragma unroll
            for (int e = 0; e < 8; ++e) f[e] = f[e] * rstd * (isq ? qg[e] : kg[e]);
            float pr[8];
#pragma unroll
            for (int e = 0; e < 8; ++e) pr[e] = __shfl_xor(f[e], 2);
            if (ch < 4) {
#pragma unroll
                for (int e = 0; e < 8; ++e) f[e] = f[e] * cc[e] + sg * pr[e] * sn[e];
            }
            const float sc = isq ? 0.08838834764831845f : 1.0f;
#pragma unroll
            for (int e = 0; e < 8; ++e) f[e] *= sc;
            *(v4u*)(zr + 512 * it) = pack8(f);
        }
    }
}
__device__ __forceinline__ void rope_prepass(bf16* __restrict__ z, const float* __restrict__ ropec, const float* __restrict__ ropes, int gw, int ngw, int lane) {
    const int c4 = lane & 3; const bool act = lane < 48;
    const float sg = (c4 < 2) ? -1.f : 1.f;
    const int loff = ZC_BQ + (act ? (lane >> 2) : 0) * 128 + 8 * c4, toff = 8 * (c4 & 1);
    for (int m0 = gw * 4; m0 < M; m0 += ngw * 4) {
        v4u w[4]; f32x4 cc[4][2], sn[4][2];
#pragma unroll
        for (int r = 0; r < 4; ++r) { const int m = m0 + r, t = m & (SEQ - 1);
            w[r] = *(const v4u*)(z + (size_t)m * ZLD + loff);
            cc[r][0] = *(const f32x4*)(ropec + t * 16 + toff); cc[r][1] = *(const f32x4*)(ropec + t * 16 + toff + 4);
            sn[r][0] = *(const f32x4*)(ropes + t * 16 + toff); sn[r][1] = *(const f32x4*)(ropes + t * 16 + toff + 4); }
#pragma unroll
        for (int r = 0; r < 4; ++r) {
            float f[8]; unpack8(w[r], f);
            const float c[8] = {cc[r][0].x, cc[r][0].y, cc[r][0].z, cc[r][0].w, cc[r][1].x, cc[r][1].y, cc[r][1].z, cc[r][1].w};
            const float s[8] = {sn[r][0].x, sn[r][0].y, sn[r][0].z, sn[r][0].w, sn[r][1].x, sn[r][1].y, sn[r][1].z, sn[r][1].w};
#pragma unroll
            for (int e = 0; e < 8; ++e) { const float pr = __shfl_xor(f[e], 2); f[e] = f[e] * c[e] + sg * pr * s[e]; }
            if (act) *(v4u*)(z + (size_t)(m0 + r) * ZLD + loff) = pack8(f);
        }
    }
}
struct AttnDesc { int gi, dil, h, r, nb; size_t rowbase; };
__device__ __forceinline__ AttnDesc attn_decode(int gi, int ub) {
    AttnDesc d; d.gi = gi; int rem = ub;
    d.dil = (gi == 0) ? 1 : (gi == 1) ? 4 : 16; const int nblk = 64 / d.dil;
    const int b = rem / 384; rem -= b * 384; d.h = rem >> 6; rem &= 63;
    d.r = rem / nblk; d.nb = rem - d.r * nblk; d.rowbase = (size_t)b * SEQ; return d;
}
struct AttnRegs { v4u k[4], v[4], pk[4], pv[4], q[4]; };
__device__ __forceinline__ void attn_issue(const bf16* __restrict__ z, const AttnDesc& d, bool need_prev, AttnRegs& R, int tid, int w, int lane) {
    const int ch = tid & 15, row0 = tid >> 4;
#pragma unroll
    for (int it = 0; it < 4; ++it) {
        const int t = (128 * d.nb + row0 + 32 * it) * d.dil + d.r;
        const bf16* zr = z + (d.rowbase + t) * ZLD + 128 * d.h + 8 * ch;
        R.k[it] = *(const v4u*)(zr + ZC_BK); R.v[it] = *(const v4u*)(zr + ZC_BV);
    }
    if (need_prev) {
#pragma unroll
        for (int it = 0; it < 4; ++it) {
            const int t = (128 * (d.nb - 1) + row0 + 32 * it) * d.dil + d.r;
            const bf16* zr = z + (d.rowbase + t) * ZLD + 128 * d.h + 8 * ch;
            R.pk[it] = *(const v4u*)(zr + ZC_BK); R.pv[it] = *(const v4u*)(zr + ZC_BV);
        }
    }
    const int tq = (128 * d.nb + 16 * w + (lane & 15)) * d.dil + d.r;
    const bf16* zq = z + (d.rowbase + tq) * ZLD + ZC_BQ + 128 * d.h + 8 * (lane >> 4);
#pragma unroll
    for (int ks = 0; ks < 4; ++ks) R.q[ks] = *(const v4u*)(zq + 32 * ks);
}
__device__ __forceinline__ void attn_stage(LAS unsigned char* lds, const AttnRegs& R, int nb, bool had_prev, int tid) {
    LAS unsigned char* KS = lds; LAS unsigned char* VS = lds + 256 * LD128;
    const int ch = tid & 15, row0 = tid >> 4;
    const int vsw = 32 * ((ch >> 1) ^ (row0 & 7)) + 16 * (ch & 1);
    const int sc = (nb & 1) * 128, sp = ((nb + 1) & 1) * 128;
#pragma unroll
    for (int it = 0; it < 4; ++it) {
        const int row = sc + row0 + 32 * it;
        *(LAS v4u*)(KS + row * LD128 + ch * 16) = R.k[it];
        *(LAS v4u*)(VS + 256 * row + vsw) = R.v[it];
    }
    if (had_prev) {
#pragma unroll
        for (int it = 0; it < 4; ++it) {
            const int row = sp + row0 + 32 * it;
            *(LAS v4u*)(KS + row * LD128 + ch * 16) = R.pk[it];
            *(LAS v4u*)(VS + 256 * row + vsw) = R.pv[it];
        }
    } else if (nb == 0) {
#pragma unroll
        for (int it = 0; it < 4; ++it) *(LAS v4u*)(VS + 256 * (sp + row0 + 32 * it) + vsw) = (v4u){0u, 0u, 0u, 0u};
    }
}
struct AttnOut { v4u o[4]; float lv; bf16* op; float* lp; };
__device__ __forceinline__ void attn_store(const AttnOut& r, int lane) {
#pragma unroll
    for (int q = 0; q < 4; ++q) *(v4u*)(r.op + 32 * q) = r.o[q];
    if ((lane >> 4) == 0) *r.lp = r.lv;
}
__device__ __forceinline__ void attn_compute(LAS unsigned char* lds, const AttnDesc& d, const bf16x8 (&qf)[4], bf16* __restrict__ og, float* __restrict__ lse, int w, int lane, AttnOut& res) {
    const int c16 = lane & 15, g4 = lane >> 4, q4 = c16 >> 2, p4 = lane & 3;
    const LAS unsigned char* KS = lds; const LAS unsigned char* VS = lds + 256 * LD128;
    const int qi = 16 * w + c16; const int tq = (128 * d.nb + qi) * d.dil + d.r;
    f32x4 sc[9];
#pragma unroll
    for (int j = 0; j < 9; ++j) {
        sc[j] = (f32x4){0.f, 0.f, 0.f, 0.f};
        const int kt = w + j; const int lrow = ((d.nb + (kt >> 3) + 1) & 1) * 128 + (kt & 7) * 16;
        const LAS unsigned char* kp = KS + (lrow + c16) * LD128 + 16 * g4;
#pragma unroll
        for (int ks = 0; ks < 4; ++ks) sc[j] = MFMA16(lds_row8(kp + 64 * ks), qf[ks], sc[j]);
    }
    float mx = -1e30f;
#pragma unroll
    for (int j = 0; j < 9; ++j)
#pragma unroll
        for (int e = 0; e < 4; ++e) { const int kj = 16 * (w + j) + 4 * g4 + e; const int dist = qi + 128 - kj;
            const bool valid = (dist >= 0) && (dist <= 128) && (d.nb > 0 || kj >= 128);
            sc[j][e] = valid ? sc[j][e] : -1e30f; mx = fmaxf(mx, sc[j][e]); }
    mx = fmaxf(mx, __shfl_xor(mx, 16)); mx = fmaxf(mx, __shfl_xor(mx, 32));
    float l = 0.f;
#pragma unroll
    for (int j = 0; j < 9; ++j)
#pragma unroll
        for (int e = 0; e < 4; ++e) { const float p = __expf(sc[j][e] - mx); sc[j][e] = p; l += p; }
    l += __shfl_xor(l, 16); l += __shfl_xor(l, 32);
    const int xr = 4 * (g4 & 1) + q4;
    f32x4 oa[8];
#pragma unroll
    for (int ct = 0; ct < 8; ++ct) oa[ct] = (f32x4){0.f, 0.f, 0.f, 0.f};
#pragma unroll
    for (int s = 0; s < 5; ++s) {
        v4u pw; pw.x = pk2(sc[2 * s][0], sc[2 * s][1]); pw.y = pk2(sc[2 * s][2], sc[2 * s][3]);
        if (s < 4) { pw.z = pk2(sc[2 * s + 1][0], sc[2 * s + 1][1]); pw.w = pk2(sc[2 * s + 1][2], sc[2 * s + 1][3]); } else { pw.z = 0u; pw.w = 0u; }
        const bf16x8 pf = __builtin_bit_cast(bf16x8, pw);
        const int kt0 = w + 2 * s, kt1 = (w + 2 * s + 1 > 15) ? 15 : (w + 2 * s + 1);
        const int lr0 = ((d.nb + (kt0 >> 3) + 1) & 1) * 128 + (kt0 & 7) * 16, lr1 = ((d.nb + (kt1 >> 3) + 1) & 1) * 128 + (kt1 & 7) * 16;
        const LAS unsigned char* v0 = VS + (lr0 + 4 * g4 + q4) * 256 + 8 * p4;
        const LAS unsigned char* v1 = VS + (lr1 + 4 * g4 + q4) * 256 + 8 * p4;
#pragma unroll
        for (int ct = 0; ct < 8; ++ct) oa[ct] = MFMA16(cat8(lds_tr4(v0 + 32 * (ct ^ xr)), lds_tr4(v1 + 32 * (ct ^ xr))), pf, oa[ct]);
    }
    const float inv = 1.0f / l;
    const size_t orow = (size_t)d.gi * M + d.rowbase + tq;
    res.op = og + orow * 768 + 128 * d.h + wide_col(g4);
#pragma unroll
    for (int ct = 0; ct < 8; ct += 2) { v2u o0, o1; o0.x = pk2(oa[ct][0] * inv, oa[ct][1] * inv); o0.y = pk2(oa[ct][2] * inv, oa[ct][3] * inv);
        o1.x = pk2(oa[ct + 1][0] * inv, oa[ct + 1][1] * inv); o1.y = pk2(oa[ct + 1][2] * inv, oa[ct + 1][3] * inv);
        res.o[ct >> 1] = widen_pair(o0, o1); }
    res.lp = lse + orow * 6 + d.h; res.lv = mx + __logf(l);
}
__device__ __forceinline__ void attn_phase(LAS unsigned char* lds, const bf16* __restrict__ z, bf16* __restrict__ og, float* __restrict__ lse, int vc, int G, int tid, int w, int lane) {
    const int nrounds = (256 - vc + G - 1) / G;
    const int nit = nrounds * 18;
    AttnRegs R; AttnDesc d = attn_decode(0, 6 * vc); bool np = d.nb > 0;
    AttnOut res; res.op = og; res.lp = lse; res.lv = 0.f;
#pragma unroll
    for (int q = 0; q < 4; ++q) res.o[q] = (v4u){0u, 0u, 0u, 0u};
    if (nit > 0) attn_issue(z, d, np, R, tid, w, lane);
    for (int it = 0; it < nit; ++it) {
        asm volatile("" : "+s"(w), "+v"(tid));
        lane = tid & 63;
        attn_stage(lds, R, d.nb, np, tid);
        if (it > 0) attn_store(res, lane);
        bf16x8 qf[4];
#pragma unroll
        for (int ks = 0; ks < 4; ++ks) qf[ks] = __builtin_bit_cast(bf16x8, R.q[ks]);
        const AttnDesc dc = d;
        __syncthreads();
        if (it + 1 < nit) { const int n = it + 1, j = n % 6, gi = (n / 6) % 3, seg = vc + (n / 18) * G;
            d = attn_decode(gi, 6 * seg + j); np = (j == 0) && d.nb > 0; attn_issue(z, d, np, R, tid, w, lane); }
        attn_compute(lds, dc, qf, og, lse, w, lane, res);
        __syncthreads();
    }
    if (nit > 0) attn_store(res, lane);
}

__device__ __forceinline__ int t64_f(int row) { return ((row >> 1) & 1) | (((row >> 3) & 1) << 1); }
__device__ __forceinline__ int t64_off(int row, int ch) { return 128 * row + 32 * ((ch >> 1) ^ t64_f(row)) + 16 * (ch & 1); }
__device__ __forceinline__ float log_sigmoid_f(float x) { return fminf(x, 0.f) - __logf(1.0f + __expf(-fabsf(x))); }

__device__ __forceinline__ void gla_r_wave(LAS float* rtab, const bf16* __restrict__ h, const bf16* __restrict__ wrt, const unsigned long long* __restrict__ ss, int slab, int w, int lane) {
    const int c16 = lane & 15, g4 = lane >> 4;
    const bf16* hp = h + ((size_t)slab * 128 + 16 * w + c16) * DM + 8 * g4; const bf16* wp = wrt + (size_t)c16 * DM + 8 * g4;
    f32x4 acc = (f32x4){0.f, 0.f, 0.f, 0.f};
    for (int ks0 = 0; ks0 < 64; ks0 += 8) {
        v4u a[8], b[8];
#pragma unroll
        for (int i = 0; i < 8; ++i) { a[i] = *(const v4u*)(hp + 32 * (ks0 + i)); b[i] = *(const v4u*)(wp + 32 * (ks0 + i)); }
#pragma unroll
        for (int i = 0; i < 8; ++i) acc = MFMA16(__builtin_bit_cast(bf16x8, b[i]), __builtin_bit_cast(bf16x8, a[i]), acc);
    }
    acc *= __builtin_amdgcn_rsqf((float)ss[slab * 128 + 16 * w + c16] * SS_INV * (1.f / DM) + EPS);
    *(LAS f32x4*)(rtab + (16 * w + c16) * 16 + 4 * g4) = acc;
}
__device__ __forceinline__ void gla_g1_wave(LAS unsigned char* wl, const bf16* __restrict__ z, const LAS float* rch, const float* __restrict__ wg, const float* __restrict__ bg,
                                            float* __restrict__ UT, float* __restrict__ dec, bf16* __restrict__ QD, bf16* __restrict__ KD, int chunk, int h, int lane) {
    const size_t R0 = (size_t)chunk * 64;
    const int c16 = lane & 15, g4 = lane >> 4, q4 = c16 >> 2, p4 = lane & 3;
    const bf16* zk = z + R0 * ZLD + ZC_CK + 64 * h + lane; const bf16* zq = z + R0 * ZLD + ZC_CQ + 64 * h + lane;
    bf16 kr[16], qr[16];
#pragma unroll
    for (int i = 0; i < 16; ++i) { kr[i] = zk[(size_t)i * ZLD]; qr[i] = zq[(size_t)i * ZLD]; }
    const bf16* zv = z + (R0 + (lane >> 3)) * ZLD + ZC_CV + 128 * h + 8 * (lane & 7);
    v4u vr[8];
#pragma unroll
    for (int it = 0; it < 8; ++it) vr[it] = *(const v4u*)(zv + (size_t)(8 * it) * ZLD);
    float bl[64]; float blast;
    {
        float wcol[16], rr[16];
#pragma unroll
        for (int i = 0; i < 16; ++i) { wcol[i] = wg[i * 384 + 64 * h + lane]; rr[i] = rch[64 * i + lane]; }
        const float bias = bg[64 * h + lane];
        float run = 0.f;
#pragma unroll
        for (int j = 0; j < 64; ++j) {
            float x = bias;
#pragma unroll
            for (int i = 0; i < 16; ++i) x += __int_as_float(__builtin_amdgcn_readlane(__float_as_int(rr[j >> 2]), (j & 3) * 16 + i)) * wcol[i];
            run += log_sigmoid_f(x) * (1.f / 16.f); bl[j] = run;
        }
        blast = run;
    }
    const float elast = __expf(blast);
    dec[((size_t)chunk * 6 + h) * 64 + lane] = elast;
    LAS unsigned char* KT = wl; LAS unsigned char* VH = wl + 8192;
    bf16* qdp = QD + R0 * 384 + 64 * h + lane; bf16* kdp = KD + R0 * 384 + 64 * h + lane;
#pragma unroll
    for (int bt = 0; bt < 4; ++bt) {
        bf16 kn[16], qn[16];
        if (bt < 3) {
#pragma unroll
            for (int i = 0; i < 16; ++i) { kn[i] = zk[(size_t)(16 * (bt + 1) + i) * ZLD]; qn[i] = zq[(size_t)(16 * (bt + 1) + i) * ZLD]; }
        }
#pragma unroll
        for (int i = 0; i < 16; ++i) { const int j = 16 * bt + i;
            const float e = __expf(bl[j]), ei = __expf(-bl[j]);
            const float kv = bf1(kr[i]), qv = bf1(qr[i]);
            const float kd = kv * ei;
            qdp[(size_t)j * 384] = f2bf(qv * 0.125f * e);
            kdp[(size_t)j * 384] = f2bf(kd);
            *(LAS bf16*)(KT + 128 * j + 32 * ((lane >> 4) ^ t64_f(j)) + 2 * (lane & 15)) = f2bf(kd * elast);
        }
        if (bt < 3) {
#pragma unroll
            for (int i = 0; i < 16; ++i) { kr[i] = kn[i]; qr[i] = qn[i]; }
        }
    }
    float* up = UT + ((size_t)chunk * 6 + h) * 8192 + (size_t)c16 * 64 + 4 * g4;
#pragma unroll
    for (int vh = 0; vh < 2; ++vh) {
#pragma unroll
        for (int it = 0; it < 8; ++it) { const int row = (lane >> 3) + 8 * it; *(LAS v4u*)(VH + t64_off(row, lane & 7)) = vr[it]; }
        if (vh == 0) {
#pragma unroll
            for (int it = 0; it < 8; ++it) vr[it] = *(const v4u*)(zv + (size_t)(8 * it) * ZLD + 64);
        }
        asm volatile("s_waitcnt lgkmcnt(0)" ::: "memory");
        f32x4 acc[4][4];
#pragma unroll
        for (int vt = 0; vt < 4; ++vt)
#pragma unroll
            for (int kt = 0; kt < 4; ++kt) acc[vt][kt] = (f32x4){0.f, 0.f, 0.f, 0.f};
#pragma unroll
        for (int ks = 0; ks < 2; ++ks) {
            const int row = 32 * ks + 8 * g4 + q4; const int fr = t64_f(row);
            bf16x8 af[4], bfr[4];
#pragma unroll
            for (int t = 0; t < 4; ++t) {
                const int o = 128 * row + 32 * (t ^ fr) + 8 * p4;
                af[t] = cat8(lds_tr4(VH + o), lds_tr4(VH + o + 512));
                bfr[t] = cat8(lds_tr4(KT + o), lds_tr4(KT + o + 512));
            }
#pragma unroll
            for (int vt = 0; vt < 4; ++vt)
#pragma unroll
                for (int kt = 0; kt < 4; ++kt) acc[vt][kt] = MFMA16(bfr[kt], af[vt], acc[vt][kt]);
        }
#pragma unroll
        for (int vt = 0; vt < 4; ++vt)
#pragma unroll
            for (int kt = 0; kt < 4; ++kt) *(f32x4*)(up + (size_t)(64 * vh + 16 * vt) * 64 + 16 * kt) = acc[vt][kt];
        asm volatile("s_waitcnt lgkmcnt(0)" ::: "memory");
    }
}
__device__ __forceinline__ void gla_scan(const float* __restrict__ UT, const float* __restrict__ dec, bf16* __restrict__ SB, int gtid, int ngt) {
    for (int e = gtid; e < BATCH * 6 * 8192; e += ngt) {
        const int kk = e & 63, hv = e >> 6; const int b = hv / (6 * 128), hvr = hv - b * (6 * 128); const int h = hvr >> 7;
        const size_t o0 = (size_t)b * 128 * 6 * 8192 + (size_t)hvr * 64 + kk;
        const float* up = UT + o0; bf16* sp = SB + o0;
        const float* dp = dec + (size_t)b * 128 * 384 + h * 64 + kk;
        float st = 0.f;
        for (int n0 = 0; n0 < 128; n0 += 16) {
            float uv[16], dv[16];
#pragma unroll
            for (int i = 0; i < 16; ++i) { uv[i] = up[(size_t)(n0 + i) * 6 * 8192]; dv[i] = dp[(size_t)(n0 + i) * 384]; }
#pragma unroll
            for (int i = 0; i < 16; ++i) { sp[(size_t)(n0 + i) * 6 * 8192] = f2bf(st); st = dv[i] * st + uv[i]; }
        }
    }
}
__device__ __forceinline__ void gla_g3_wave(LAS unsigned char* wl, const bf16* __restrict__ z, const bf16* __restrict__ QD, const bf16* __restrict__ KD, const bf16* __restrict__ SB,
                                            const float* __restrict__ outg, bf16* __restrict__ y, int chunk, int h, int lane) {
    const size_t R0 = (size_t)chunk * 64;
    const int c16 = lane & 15, g4 = lane >> 4, q4 = c16 >> 2, p4 = lane & 3;
    {
        const bf16* zv = z + (R0 + (lane >> 4)) * ZLD + ZC_CV + 128 * h + 8 * (lane & 15);
        const int ch = lane & 15;
#pragma unroll
        for (int half = 0; half < 2; ++half) {
            v4u vr[8];
#pragma unroll
            for (int it = 0; it < 8; ++it) vr[it] = *(const v4u*)(zv + (size_t)(4 * (8 * half + it)) * ZLD);
#pragma unroll
            for (int it = 0; it < 8; ++it) { const int row = (lane >> 4) + 4 * (8 * half + it);
                *(LAS v4u*)(wl + 256 * row + 32 * ((ch >> 1) ^ (row & 7)) + 16 * (ch & 1)) = vr[it]; }
        }
    }
    bf16x8 qf[4][2], kf[4][2];
    {
        const bf16* qp = QD + (R0 + c16) * 384 + 64 * h + 8 * g4; const bf16* kp = KD + (R0 + c16) * 384 + 64 * h + 8 * g4;
#pragma unroll
        for (int t = 0; t < 4; ++t)
#pragma unroll
            for (int ks = 0; ks < 2; ++ks) { qf[t][ks] = __builtin_bit_cast(bf16x8, *(const v4u*)(qp + (size_t)(16 * t) * 384 + 32 * ks));
                                             kf[t][ks] = __builtin_bit_cast(bf16x8, *(const v4u*)(kp + (size_t)(16 * t) * 384 + 32 * ks)); }
    }
    bf16x8 pf[4][2];
#pragma unroll
    for (int it = 0; it < 4; ++it) {
        unsigned pw[4][2];
#pragma unroll
        for (int jt = 0; jt < 4; ++jt) {
            if (jt <= it) {
                f32x4 a = (f32x4){0.f, 0.f, 0.f, 0.f};
#pragma unroll
                for (int ks = 0; ks < 2; ++ks) a = MFMA16(kf[jt][ks], qf[it][ks], a);
                if (jt == it) { const int d0 = c16 - 4 * g4;
                    a[0] = (0 <= d0) ? a[0] : 0.f; a[1] = (1 <= d0) ? a[1] : 0.f; a[2] = (2 <= d0) ? a[2] : 0.f; a[3] = (3 <= d0) ? a[3] : 0.f; }
                pw[jt][0] = pk2(a[0], a[1]); pw[jt][1] = pk2(a[2], a[3]);
            } else { pw[jt][0] = 0u; pw[jt][1] = 0u; }
        }
#pragma unroll
        for (int s = 0; s < 2; ++s) { v4u w4; w4.x = pw[2 * s][0]; w4.y = pw[2 * s][1]; w4.z = pw[2 * s + 1][0]; w4.w = pw[2 * s + 1][1]; pf[it][s] = __builtin_bit_cast(bf16x8, w4); }
    }
    asm volatile("s_waitcnt lgkmcnt(0)" ::: "memory");
    f32x4 acc[4][8];
#pragma unroll
    for (int it = 0; it < 4; ++it)
#pragma unroll
        for (int ct = 0; ct < 8; ++ct) acc[it][ct] = (f32x4){0.f, 0.f, 0.f, 0.f};
    const int xr = 4 * (g4 & 1) + q4;
    const LAS unsigned char* vb = wl + 256 * (4 * g4 + q4) + 8 * p4;
#pragma unroll
    for (int ct = 0; ct < 8; ++ct) {
        const int co = 32 * (ct ^ xr);
#pragma unroll
        for (int s = 0; s < 2; ++s) {
            const bf16x8 vf = cat8(lds_tr4(vb + 256 * (32 * s) + co), lds_tr4(vb + 256 * (32 * s + 16) + co));
#pragma unroll
            for (int it = 0; it < 4; ++it) if (2 * s <= it) acc[it][ct] = MFMA16(vf, pf[it][s], acc[it][ct]);
        }
        const bf16* sp = SB + ((size_t)chunk * 6 + h) * 8192 + (size_t)(16 * ct + c16) * 64 + 8 * g4;
#pragma unroll
        for (int ks = 0; ks < 2; ++ks) {
            const bf16x8 sf = __builtin_bit_cast(bf16x8, *(const v4u*)(sp + 32 * ks));
#pragma unroll
            for (int it = 0; it < 4; ++it) acc[it][ct] = MFMA16(sf, qf[it][ks], acc[it][ct]);
        }
    }
#pragma unroll
    for (int it = 0; it < 4; ++it) {
        float ss = 0.f;
#pragma unroll
        for (int ct = 0; ct < 8; ++ct) ss += (acc[it][ct][0] * acc[it][ct][0] + acc[it][ct][1] * acc[it][ct][1]) + (acc[it][ct][2] * acc[it][ct][2] + acc[it][ct][3] * acc[it][ct][3]);
        ss += __shfl_xor(ss, 16); ss += __shfl_xor(ss, 32);
        const float rstd = rsqrtf(ss * (1.f / 128.f) + EPS);
        const size_t row = R0 + 16 * it + c16;
        const bf16* gp = z + row * ZLD + ZC_CG + 128 * h + wide_col(g4);
        bf16* yp = y + row * DM + YC_C + 128 * h + wide_col(g4);
#pragma unroll
        for (int ct = 0; ct < 8; ct += 2) {
            v2u o[2], gg[2]; unwiden_pair(*(const v4u*)(gp + 16 * ct), gg[0], gg[1]);
#pragma unroll
            for (int q = 0; q < 2; ++q) { const int c = ct + q;
                const v2u gw = gg[q]; const f32x4 og4 = *(const f32x4*)(outg + 16 * c + 4 * g4);
                o[q].x = pk2(acc[it][c][0] * rstd * og4.x * silu_f(bflo(gw.x)), acc[it][c][1] * rstd * og4.y * silu_f(bfhi(gw.x)));
                o[q].y = pk2(acc[it][c][2] * rstd * og4.z * silu_f(bflo(gw.y)), acc[it][c][3] * rstd * og4.w * silu_f(bfhi(gw.y))); }
            *(v4u*)(yp + 16 * ct) = widen_pair(o[0], o[1]);
        }
    }
    asm volatile("s_waitcnt lgkmcnt(0)" ::: "memory");
}
__device__ __forceinline__ void attn_merge(const bf16* __restrict__ og, const float* __restrict__ lse, bf16* __restrict__ y, int gtid, int ngt) {
    for (int idx = gtid; idx < M * 96; idx += ngt) {
        const int row = idx / 96, cc = idx - row * 96, h = cc >> 4;
        const float l0 = lse[(size_t)row * 6 + h], l1 = lse[((size_t)M + row) * 6 + h], l2 = lse[((size_t)2 * M + row) * 6 + h];
        const float mx = fmaxf(l0, fmaxf(l1, l2));
        float w0 = __expf(l0 - mx), w1 = __expf(l1 - mx), w2 = __expf(l2 - mx);
        const float inv = 1.0f / (w0 + w1 + w2); w0 *= inv; w1 *= inv; w2 *= inv;
        float a[8], b[8], c[8];
        unpack8(*(const v4u*)(og + (size_t)row * 768 + 8 * cc), a);
        unpack8(*(const v4u*)(og + ((size_t)M + row) * 768 + 8 * cc), b);
        unpack8(*(const v4u*)(og + ((size_t)2 * M + row) * 768 + 8 * cc), c);
#pragma unroll
        for (int e = 0; e < 8; ++e) a[e] = w0 * a[e] + w1 * b[e] + w2 * c[e];
        *(v4u*)(y + (size_t)row * DM + YC_B + 8 * cc) = pack8(a);
    }
}

#ifndef DBG_MASK
#define DBG_MASK 0xFFFF
#endif
#define PH(b) if constexpr ((DBG_MASK >> (b)) & 1)
#ifndef PROBE_MASK
#define PROBE_MASK 0
#endif
#if PROBE_MASK
#define REP(b) int nrep_##b = 1 + ((PROBE_MASK >> (b)) & 1); asm volatile("" : "+s"(nrep_##b)); _Pragma("unroll 1") for (int rep_ = 0; rep_ < nrep_##b; ++rep_)
#else
#define REP(b) for (int rep_ = 0; rep_ < 1; ++rep_)
#endif
typedef const __attribute__((address_space(4))) Args* ArgP;
#define PHASE_BEGIN() ArgP ap = (ArgP)__builtin_amdgcn_kernarg_segment_ptr(); asm volatile("" : "+s"(ap)); \
    unsigned char* const ws = ap->ws; int tid = threadIdx.x; asm volatile("" : "+v"(tid)); \
    int lane = tid & 63; const int wave = __builtin_amdgcn_readfirstlane(tid >> 6), G = gridDim.x, bx = blockIdx.x; \
    const int gw = bx * NWAVES + wave, ngw = G * NWAVES, gtid = bx * (NWAVES * 64) + tid, ngt = G * NWAVES * 64; \
    (void)ws; (void)lane; (void)wave; (void)gw; (void)ngw; (void)gtid; (void)ngt; \
    LAS unsigned char* lds = (LAS unsigned char*)lds_raw

#ifdef PROF_SEL
#ifndef PROF_AMP
#define PROF_AMP 4
#endif
#define TS_BEGIN(id) do { if ((id) == PROF_SEL) prof_t0 = __builtin_amdgcn_s_memrealtime(); } while (0)
#define TS_END(id) do { if ((id) == PROF_SEL) { const unsigned long long now_ = __builtin_amdgcn_s_memrealtime(); const unsigned long long dt_ = (now_ - prof_t0) * PROF_AMP; \
    if (dt_ < 100000000ull) while (__builtin_amdgcn_s_memrealtime() - now_ < dt_) __builtin_amdgcn_s_sleep(8); __syncthreads(); } } while (0)
#else
#define TS_BEGIN(id) do { } while (0)
#define TS_END(id) do { } while (0)
#endif
__global__ void __launch_bounds__(NWAVES * 64, 2) hymba_fwd(Args args) {
    extern __shared__ __attribute__((aligned(16))) unsigned char lds_raw[];
    {
        LAS unsigned char* lds0 = (LAS unsigned char*)lds_raw;
        for (int u = threadIdx.x; u < (LDSX_OFF - LDSCTL_OFF) / 4; u += NWAVES * 64) ((LAS unsigned*)(lds0 + LDSCTL_OFF))[u] = 0u;
    }
    __syncthreads();
    XcdBarrier bar = xcd_barrier_post((unsigned*)(args.ws + WS_CTL) + CW_BAR, (volatile LAS unsigned*)((LAS unsigned char*)lds_raw + LDSCTL_OFF) + 8);
#define GRID_BAR() do { XcdBarrier b_ = bar; asm volatile("" : "+s"(b_.bar), "+s"(b_.x)); xcd_barrier(b_); } while (0)
#ifdef PROF_SEL
    unsigned long long prof_t0 = 0ull;
#endif

    TS_BEGIN(0);
    REP(0) PH(0) { PHASE_BEGIN(); prologue(ap, ws, lds, gw, ngw, wave, lane, gtid, ngt);
        conv_phase(ap->in[0], (bf16*)(ws + WS_H), (unsigned long long*)(ws + WS_SS), gw, ngw, lane); }
    GRID_BAR();
    TS_END(0);

    for (int s = 0; s < 3 * DEPTH; ++s) {
        const int l = s / 3, k = s - 3 * l, f = k >> 1;
        if (k != 1) {
            TS_BEGIN(2);
            REP(2) PH(2) { PHASE_BEGIN();
                const bf16* Bt = (const bf16*)(ws + WS_W + (size_t)l * W_LAYER + (f ? WL_GU1 : WL_GU0));
                const bf16* xa = (s == 0) ? (const bf16*)(ws + WS_H) : (s == 3 * DEPTH - 1) ? (const bf16*)(ws + WS_OG) : (const bf16*)ap->out;
                pg8::Gemm g{xa, Bt, M, 2 * DFF, DM}; pg8::StaticOrder S; S.init(M, 2 * DFF, G, bx);
                pg8::EpiSwiGLU E{(bf16*)(ws + WS_HZ), DFF, (const unsigned long long*)(ws + WS_SS) + (size_t)s * M};
                pg8::gemm_phase<pg8::EpiSwiGLU, pg8::StaticOrder, true, true>(lds, g, S, E); }
        } else {
            TS_BEGIN(4);
            REP(4) PH(4) { PHASE_BEGIN();
                const bf16* Bt = (const bf16*)(ws + WS_W + (size_t)l * W_LAYER + WL_IN);
                pg8::Gemm g{(const bf16*)ap->out, Bt, M, NZ, DM}; pg8::StaticOrder S; S.init(M, NZ, G, bx);
                pg8::EpiZ E{(bf16*)(ws + WS_HZ), (const unsigned long long*)(ws + WS_SS) + (size_t)s * M, ap->in[10] + (size_t)l * 128, ap->in[11] + (size_t)l * 128, ZLD};
                pg8::gemm_phase<pg8::EpiZ, pg8::StaticOrder, true, true>(lds, g, S, E); }
            GRID_BAR();
            TS_END(4);
            TS_BEGIN(5);
            PH(5) { PHASE_BEGIN(); const float* ropec = (const float*)(ws + WS_ROPE); rope_prepass((bf16*)(ws + WS_HZ), ropec, ropec + SEQ * 16, gw, ngw, lane); }
            PH(6) { for (int slab = blockIdx.x; slab < M / 128; slab += gridDim.x) { PHASE_BEGIN();
                LAS float* rtab = (LAS float*)(lds + 131072);
                gla_r_wave(rtab, (const bf16*)ap->out, (const bf16*)(ws + WS_W + (size_t)l * W_LAYER + WL_IN) + (size_t)NZ * DM, (const unsigned long long*)(ws + WS_SS) + (size_t)s * M, slab, wave, lane);
                __syncthreads();
                for (int u = wave; u < 12; u += NWAVES) {
                    asm volatile("" : "+v"(tid)); lane = tid & 63;
                    gla_g1_wave(lds + wave * 16384, (const bf16*)(ws + WS_HZ), rtab + (u / 6) * 1024, ap->in[12] + (size_t)l * 16 * 384, ap->in[13] + (size_t)l * 384,
                                (float*)((char*)ap->out + (size_t)M * DM * 2), (float*)(ws + WS_DEC), (bf16*)(ws + WS_QD), (bf16*)(ws + WS_KD), 2 * slab + u / 6, u % 6, lane); }
                __syncthreads(); } }
            __syncthreads();
            PH(7) { for (int slab = blockIdx.x; slab < M / 128; slab += gridDim.x) for (int g = 0; g < 4; ++g) { PHASE_BEGIN();
                gmlp_unit(lds, (const bf16*)(ws + WS_HZ), ap->in[8] + (size_t)l * 4 * 128 * 128, ap->in[9] + (size_t)l * 512, ap->in[7] + (size_t)l * 512, (bf16*)(ws + WS_Y), 4 * slab + g, tid, wave, lane); } }
            GRID_BAR();
            TS_END(5);
            TS_BEGIN(6);
            PH(8) { PHASE_BEGIN(); gla_scan((const float*)((const char*)ap->out + (size_t)M * DM * 2), (const float*)(ws + WS_DEC), (bf16*)(ws + WS_SB), gtid, ngt); }
            REP(12) { PH(12) { PHASE_BEGIN();
                const int vc = (G % 8 == 0) ? (bx % 8) * (G / 8) + bx / 8 : bx;
                attn_phase(lds, (const bf16*)(ws + WS_HZ), (bf16*)(ws + WS_OG), (float*)(ws + WS_LSE), vc, G, tid, wave, lane); } }
            GRID_BAR();
            TS_END(6);
            TS_BEGIN(7);
            REP(9) { PH(9) { for (int slab = blockIdx.x; slab < M / 128; slab += gridDim.x) { PHASE_BEGIN();
                for (int u = wave; u < 12; u += NWAVES) {
                    asm volatile("" : "+v"(tid)); lane = tid & 63;
                    gla_g3_wave(lds + wave * 16384, (const bf16*)(ws + WS_HZ), (const bf16*)(ws + WS_QD), (const bf16*)(ws + WS_KD), (const bf16*)(ws + WS_SB), ap->in[14] + (size_t)l * 128,
                                (bf16*)(ws + WS_Y), 2 * slab + u / 6, u % 6, lane); } } } }
            __syncthreads();
            REP(10) PH(10) { PHASE_BEGIN(); attn_merge((const bf16*)(ws + WS_OG), (const float*)(ws + WS_LSE), (bf16*)(ws + WS_Y), gtid, ngt); }
        }
        GRID_BAR();
        if (k != 1) TS_END(2); else TS_END(7);
        if (k != 1) TS_BEGIN(3); else TS_BEGIN(8);
        PH(3) { PHASE_BEGIN();
            const bool last = (s == 3 * DEPTH - 1), first = (s == 0);
            const void* xin = first ? (const void*)ap->in[0] : last ? (const void*)(ws + WS_OG) : (const void*)ap->out;
            void* xout = (s == 3 * DEPTH - 2) ? (void*)(ws + WS_OG) : (void*)ap->out;
            const unsigned char* wl = ws + WS_W + (size_t)l * W_LAYER;
            const bf16* A = (k == 1) ? (const bf16*)(ws + WS_Y) : (const bf16*)(ws + WS_HZ);
            const bf16* Bt = (const bf16*)(wl + ((k == 1) ? WL_OUT : (f ? WL_D1 : WL_D0)));
            pg8::Gemm g{A, Bt, M, DM, (k == 1) ? DM : DFF}; pg8::StaticOrder S; S.init(M, DM, G, bx, 4);
            pg8::EpiResid E{xin, xout, (unsigned long long*)(ws + WS_SS) + (size_t)(s + 1) * M, first ? 1 : 0, last ? 1 : 0, (k == 1) ? 1.0f : 0.5f};
            pg8::gemm_phase<pg8::EpiResid, pg8::StaticOrder, true, true>(lds, g, S, E); }
        GRID_BAR();
        if (k != 1) TS_END(3); else TS_END(8);
#if defined(PROF_SEL) && PROF_SEL == 99
        if (s == PROF_IDLE_AT) { const unsigned long long now_ = __builtin_amdgcn_s_memrealtime(); while (__builtin_amdgcn_s_memrealtime() - now_ < (unsigned long long)PROF_IDLE_US * 100ull) __builtin_amdgcn_s_sleep(8); __syncthreads(); }
#endif
    }
}

extern "C" void kernel_launch(void* const* d_in, const int* in_sizes, int n_in, void* d_out, int out_size, void* d_ws, size_t ws_size, hipStream_t stream) {
    static int grid = 0;
    if (grid == 0) {
        if (n_in != 16 || in_sizes[0] != M * DM || out_size != M * DM || ws_size < WS_END) { fprintf(stderr, "kernel_launch: shape/workspace mismatch (n_in %d, ws %zu, need %zu)\n", n_in, ws_size, (size_t)WS_END); grid = -1; return; }
        int dev = 0, cus = 0, per_cu = 0;
        if (hipGetDevice(&dev) != hipSuccess || hipDeviceGetAttribute(&cus, hipDeviceAttributeMultiprocessorCount, dev) != hipSuccess) { grid = -1; return; }
        if (hipFuncSetAttribute((const void*)hymba_fwd, hipFuncAttributeMaxDynamicSharedMemorySize, LDS_BYTES) != hipSuccess) { fprintf(stderr, "kernel_launch: hipFuncSetAttribute failed\n"); grid = -1; return; }
        if (hipOccupancyMaxActiveBlocksPerMultiprocessor(&per_cu, (const void*)hymba_fwd, NWAVES * 64, LDS_BYTES) != hipSuccess || per_cu < 1) fprintf(stderr, "kernel_launch: occupancy query says %d\n", per_cu);
        (void)hipGetLastError();
        grid = cus;
    }
    if (grid < 0) return;
    if (hipMemsetAsync((char*)d_ws + WS_CTL, 0, CTL_ZERO_BYTES, stream) != hipSuccess) return;
    Args a{};
    for (int i = 0; i < 16; ++i) a.in[i] = (const float*)d_in[i];
    a.out = (float*)d_out; a.ws = (unsigned char*)d_ws;
    for (int i = 0; i < 16; ++i) a.inv_freq[i] = (float)std::pow(500000.0, -(double)i / 16.0);
    hipLaunchKernelGGL(hymba_fwd, dim3(grid), dim3(NWAVES * 64), LDS_BYTES, stream, a);
}
```

```cpp
#include <hip/hip_runtime.h>
#include <cstdio>
#include <cstdint>
#include <cmath>
namespace pg8 {
#define PG8_LAS __attribute__((address_space(3)))
typedef unsigned short bf16_t;
typedef short bf16x8 __attribute__((ext_vector_type(8)));
typedef float f32x4 __attribute__((ext_vector_type(4)));
typedef unsigned u32x4 __attribute__((ext_vector_type(4)));
constexpr int BM = 256, BK = 64, HALF = 128, HTB = HALF * BK * 2  , STAGE_BYTES = 8 * HTB, NXCD = 8, WGM = 8;
constexpr int XCH_OFF = 143360;

__host__ __device__ __forceinline__ int lds_byte(int r, int c) { const int st = (r >> 4) * 2 + (c >> 5), rr = r & 15, cc = c & 31, ob = rr * 64 + cc * 2; return st * 1024 + (ob ^ (((ob >> 9) & 1) << 5)); }
__host__ __device__ __forceinline__ void stage_rc(int b, int& R, int& C) { const int st = b / 1024, sb = b % 1024, swz = sb ^ (((sb >> 9) & 1) << 5); R = (st >> 1) * 16 + swz / 64; C = (st & 1) * 32 + (swz % 64) / 2; }
__host__ __device__ __forceinline__ int perm32(int rho) { const int n = rho >> 4, i = rho & 15; return 8 * (i >> 2) + 4 * n + (i & 3); }

struct Unit { int pm, pn; };
struct Gemm { const bf16_t* A; const bf16_t* Bt; int M, N, K; };

struct StaticOrder {
    int nM, nN, nwg, G, c, wgm;
    __host__ __device__ void init(int M, int N, int G_, int c_, int wgm_ = WGM) { nM = M / BM; nN = N / BM; nwg = nM * nN; G = G_; c = c_; wgm = wgm_; }
    __host__ __device__ bool next(int i, Unit& u) const {
        const long L = (long)i * G + c; if (L >= nwg) return false;
        int wgid = (int)L; { const int q = nwg / NXCD, r = nwg % NXCD, xcd = wgid % NXCD, off = wgid / NXCD; wgid = (xcd < r ? xcd * (q + 1) : r * (q + 1) + (xcd - r) * q) + off; }
        const int nig = wgm * nN, gid = wgid / nig, fm = gid * wgm, gsz = (nM - fm) < wgm ? (nM - fm) : wgm;
        u.pm = fm + ((wgid % nig) % gsz); u.pn = (wgid % nig) / gsz; return true;
    }
    __device__ __forceinline__ void a_ready(const Unit&) const {}
    __device__ __forceinline__ void done(const Unit&) const {}
};
typedef __bf16 bf16x2_t __attribute__((ext_vector_type(2)));
typedef float f32x2_t __attribute__((ext_vector_type(2)));
__device__ __forceinline__ unsigned cvt_pk_bf16(float lo, float hi) { f32x2_t v = {lo, hi}; bf16x2_t b = __builtin_convertvector(v, bf16x2_t); return __builtin_bit_cast(unsigned, b); }
typedef float f32x2 __attribute__((ext_vector_type(2)));
#ifndef RS_ASM
#define RS_ASM 0
#endif
template <class Epi, class Sched, bool ALIGN_EPI = false, bool SP2 = false>
__device__ __forceinline__ void gemm_phase(PG8_LAS unsigned char* lds, const Gemm g, const Sched& S, const Epi& E) {
    int tid_l = threadIdx.x; asm volatile("" : "+v"(tid_l));
    const int tid = tid_l, wid = __builtin_amdgcn_readfirstlane(tid >> 6), lane = tid & 63, wr = wid >> 2, wc = wid & 3, fr = lane & 15, fq = lane >> 4;
    const int K = g.K, nt = K / BK;
    unsigned voffA[2], voffB[2];
#pragma unroll
    for (int i = 0; i < 2; ++i) { int R, C; stage_rc(tid * 16 + i * 8192, R, C); const int Rb = Epi::PERM ? ((R & ~31) + perm32(R & 31)) : R;
        voffA[i] = (unsigned)(R * K + C) * 2u; voffB[i] = (unsigned)(Rb * K + C) * 2u; }
    const size_t kstep = (size_t)(BK * 2);
    const size_t hstep = (size_t)HALF * K * 2;
    const size_t tstep = 2 * hstep;
    const unsigned ldsw = (unsigned)wid * 1024u;
    const int aoff = lds_byte(wr * 64 + fr, fq * 8), boff = lds_byte(wc * 32 + fr, fq * 8);
#define PG8_SA(b, h) (((b) * 2 + (h)) * HTB)
#define PG8_SB(b, h) ((4 + (b) * 2 + (h)) * HTB)
#define PG8_STAGE(bufoff, gbase, voff) do { _Pragma("unroll") for (int _i = 0; _i < 2; ++_i) \
        __builtin_amdgcn_global_load_lds((const unsigned*)((const char*)(gbase) + (voff)[_i]), (PG8_LAS unsigned*)(lds + (bufoff) + ldsw + _i * 8192), 16, 0, 0); } while (0)
#define PG8_LDA(dst, b, h) do { _Pragma("unroll") for (int m = 0; m < 4; ++m) _Pragma("unroll") for (int k = 0; k < 2; ++k) dst[m][k] = *(const PG8_LAS bf16x8*)(lds + PG8_SA(b, h) + aoff + m * 2048 + k * 1024); } while (0)
#define PG8_LDB(dst, b, h) do { _Pragma("unroll") for (int n = 0; n < 2; ++n) _Pragma("unroll") for (int k = 0; k < 2; ++k) dst[n][k] = *(const PG8_LAS bf16x8*)(lds + PG8_SB(b, h) + boff + n * 2048 + k * 1024); } while (0)
#define PG8_MMA(ai, bj, At, Bt) do { __builtin_amdgcn_s_setprio(1); _Pragma("unroll") for (int k = 0; k < 2; ++k) _Pragma("unroll") for (int m = 0; m < 4; ++m) _Pragma("unroll") for (int n = 0; n < 2; ++n) \
        acc[ai][bj][m][n] = __builtin_amdgcn_mfma_f32_16x16x32_bf16(Bt[n][k], At[m][k], acc[ai][bj][m][n], 0, 0, 0); __builtin_amdgcn_s_setprio(0); } while (0)
#define PG8_WAIT_V(n) asm volatile("s_waitcnt vmcnt(" #n ")" ::: "memory")
#define PG8_WAIT_L(n) asm volatile("s_waitcnt lgkmcnt(" #n ")" ::: "memory")
#define PG8_BAR __builtin_amdgcn_s_barrier()
#define PG8_SCHED __builtin_amdgcn_sched_barrier(0)
    Unit cur, nxt; int ui = 0;
    if (!S.next(0, cur)) return;
    f32x4 acc[2][2][4][2];
#pragma unroll
    for (int a = 0; a < 2; ++a)
#pragma unroll
        for (int b = 0; b < 2; ++b)
#pragma unroll
            for (int m = 0; m < 4; ++m)
#pragma unroll
                for (int n = 0; n < 2; ++n) acc[a][b][m][n] = (f32x4){0.f, 0.f, 0.f, 0.f};
    bf16x8 At[4][2], B0[2][2], B1[2][2];
    unsigned long long rsq64 = 0ull;
    PG8_LAS float* const rstab = (PG8_LAS float*)(lds + STAGE_BYTES);
    const char* cA = (const char*)g.A + (size_t)cur.pm * tstep; const char* cB = (const char*)g.Bt + (size_t)cur.pn * tstep;
    S.a_ready(cur);
    if constexpr (SP2) {
        PG8_STAGE(PG8_SB(0, 0), cB, voffB); PG8_STAGE(PG8_SB(0, 1), cB + hstep, voffB); PG8_STAGE(PG8_SA(0, 0), cA, voffA); PG8_STAGE(PG8_SA(0, 1), cA + hstep, voffA);
        if (wr == 1) PG8_BAR;
        PG8_WAIT_V(2); PG8_BAR;
        PG8_STAGE(PG8_SB(1, 0), cB + kstep, voffB); PG8_STAGE(PG8_SA(1, 0), cA + kstep, voffA); PG8_STAGE(PG8_SB(1, 1), cB + hstep + kstep, voffB);
        PG8_WAIT_V(6); PG8_BAR;
    } else {
        PG8_STAGE(PG8_SB(0, 0), cB, voffB); PG8_STAGE(PG8_SA(0, 0), cA, voffA); PG8_STAGE(PG8_SB(0, 1), cB + hstep, voffB); PG8_STAGE(PG8_SA(0, 1), cA + hstep, voffA);
        if (wr == 1) PG8_BAR;
        PG8_WAIT_V(4); PG8_BAR;
        PG8_STAGE(PG8_SB(1, 0), cB + kstep, voffB); PG8_STAGE(PG8_SA(1, 0), cA + kstep, voffA); PG8_STAGE(PG8_SB(1, 1), cB + hstep + kstep, voffB);
        PG8_WAIT_V(6); PG8_BAR;
    }
    for (;;) {
        const bool has_next = S.next(ui + 1, nxt);
        const char* nA = has_next ? (const char*)g.A + (size_t)nxt.pm * tstep : cA; const char* nB = has_next ? (const char*)g.Bt + (size_t)nxt.pn * tstep : cB;
        for (int t = 0; t < nt; t += 2) {
            const bool last = (t == nt - 2);
            const char* a1 = cA + (size_t)(t + 1) * kstep;
            const char* a2 = last ? nA : cA + (size_t)(t + 2) * kstep; const char* b2 = last ? nB : cB + (size_t)(t + 2) * kstep;
            const char* a3 = a2 + kstep; const char* b3 = b2 + kstep;
            if (last && has_next) S.a_ready(nxt);
            if constexpr (Epi::ROWSCALE) { if (last && wr == 0) { const unsigned long long* rp = E.ss + cur.pm * BM + tid;
                asm volatile("global_load_dwordx2 %0, %1, off" : "+v"(rsq64) : "v"(rp) : "memory"); } }
            if constexpr (SP2) {
            PG8_LDB(B0, 0, 0); PG8_LDB(B1, 0, 1); PG8_SCHED; PG8_LDA(At, 0, 0); PG8_STAGE(PG8_SA(1, 1), a1 + hstep, voffA);
            PG8_WAIT_V(8); PG8_WAIT_L(0); PG8_BAR; PG8_MMA(0, 0, At, B0); PG8_MMA(0, 1, At, B1); PG8_BAR; PG8_SCHED;
            PG8_LDA(At, 0, 1); PG8_STAGE(PG8_SB(0, 0), b2, voffB); PG8_STAGE(PG8_SB(0, 1), b2 + hstep, voffB); PG8_STAGE(PG8_SA(0, 0), a2, voffA);
            PG8_WAIT_V(8); PG8_WAIT_L(0); PG8_BAR; PG8_MMA(1, 0, At, B0); PG8_MMA(1, 1, At, B1); PG8_BAR; PG8_SCHED;
            PG8_LDB(B0, 1, 0); PG8_LDB(B1, 1, 1); PG8_SCHED; PG8_LDA(At, 1, 0); PG8_STAGE(PG8_SA(0, 1), a2 + hstep, voffA);
            PG8_WAIT_V(8); PG8_WAIT_L(0); PG8_BAR; PG8_MMA(0, 0, At, B0); PG8_MMA(0, 1, At, B1); PG8_BAR; PG8_SCHED;
            if constexpr (Epi::ROWSCALE) { if (last && wr == 0) {
                const float ssum = (float)rsq64 * (1.0f / 16777216.0f);
                rstab[(((tid >> 6) & 1) * 16 + (tid & 15)) * 8 + (tid >> 7) * 4 + ((tid >> 4) & 3)] = __builtin_amdgcn_rsqf(ssum * (1.f / 2048.f) + 1e-6f); } }
            PG8_LDA(At, 1, 1); PG8_STAGE(PG8_SB(1, 0), b3, voffB); PG8_STAGE(PG8_SB(1, 1), b3 + hstep, voffB); PG8_STAGE(PG8_SA(1, 0), a3, voffA);
            PG8_WAIT_V(8); PG8_WAIT_L(0); PG8_BAR; PG8_MMA(1, 0, At, B0); PG8_MMA(1, 1, At, B1); PG8_BAR; PG8_SCHED;
            } else {
            PG8_LDB(B0, 0, 0); PG8_SCHED; PG8_LDA(At, 0, 0); PG8_STAGE(PG8_SA(1, 1), a1 + hstep, voffA);
            PG8_WAIT_L(8); PG8_BAR; PG8_WAIT_L(0); PG8_MMA(0, 0, At, B0); PG8_BAR; PG8_SCHED;
            PG8_LDB(B1, 0, 1); PG8_STAGE(PG8_SB(0, 0), b2, voffB);
            PG8_BAR; PG8_WAIT_L(0); PG8_MMA(0, 1, At, B1); PG8_BAR;
            PG8_LDA(At, 0, 1); PG8_STAGE(PG8_SA(0, 0), a2, voffA);
            PG8_BAR; PG8_WAIT_L(0); PG8_MMA(1, 0, At, B0); PG8_BAR; PG8_SCHED;
            PG8_STAGE(PG8_SB(0, 1), b2 + hstep, voffB);
            PG8_WAIT_V(6); PG8_BAR; PG8_MMA(1, 1, At, B1); PG8_BAR;
            PG8_LDB(B0, 1, 0); PG8_SCHED; PG8_LDA(At, 1, 0); PG8_STAGE(PG8_SA(0, 1), a2 + hstep, voffA);
            PG8_WAIT_L(8); PG8_BAR; PG8_WAIT_L(0); PG8_MMA(0, 0, At, B0); PG8_BAR; PG8_SCHED;
            PG8_LDB(B1, 1, 1); PG8_STAGE(PG8_SB(1, 0), b3, voffB);
            PG8_BAR; PG8_WAIT_L(0); PG8_MMA(0, 1, At, B1); PG8_BAR;
            PG8_LDA(At, 1, 1); PG8_STAGE(PG8_SA(1, 0), a3, voffA);
            PG8_BAR; PG8_WAIT_L(0); PG8_MMA(1, 0, At, B0); PG8_BAR; PG8_SCHED;
            PG8_STAGE(PG8_SB(1, 1), b3 + hstep, voffB);
            PG8_WAIT_V(6); PG8_BAR; PG8_MMA(1, 1, At, B1); PG8_BAR;
            }
        }
        if constexpr (ALIGN_EPI) { if (wr == 0) PG8_BAR; }
        if constexpr (!Epi::AFTER_DRAIN) { if constexpr (Epi::ROWSCALE) {
            const f32x4 ra = *(const PG8_LAS f32x4*)(rstab + (wr * 16 + fr) * 8), rb = *(const PG8_LAS f32x4*)(rstab + (wr * 16 + fr) * 8 + 4);
            const float rs[8] = {ra[0], ra[1], ra[2], ra[3], rb[0], rb[1], rb[2], rb[3]};
            if constexpr (Epi::NEEDS_LDS) E(acc, cur, wr, wc, fr, fq, rs, (PG8_LAS float*)(lds + XCH_OFF)); else E(acc, cur, wr, wc, fr, fq, rs); } else E(acc, cur, wr, wc, fr, fq); S.done(cur); }
        if (!has_next) break;
#pragma unroll
        for (int a = 0; a < 2; ++a)
#pragma unroll
            for (int b = 0; b < 2; ++b)
#pragma unroll
                for (int m = 0; m < 4; ++m)
#pragma unroll
                    for (int n = 0; n < 2; ++n) acc[a][b][m][n] = (f32x4){0.f, 0.f, 0.f, 0.f};
        cur = nxt; cA = nA; cB = nB; ++ui;
        if constexpr (ALIGN_EPI) { if (wr == 1) PG8_BAR; }
    }
    PG8_WAIT_V(0);
    if constexpr (!ALIGN_EPI) { if (wr == 0) PG8_BAR; }
    PG8_BAR;
    if constexpr (Epi::AFTER_DRAIN) { E.fused(acc, cur, wr, wc, fr, fq, lds, wid, lane); S.done(cur); }
#undef PG8_SA
#undef PG8_SB
#undef PG8_STAGE
#undef PG8_LDA
#undef PG8_LDB
#undef PG8_MMA
#undef PG8_WAIT_V
#undef PG8_WAIT_L
#undef PG8_BAR
#undef PG8_SCHED
}
}
namespace pg8 {
struct EpiSwiGLU {
    static constexpr bool PERM = true, AFTER_DRAIN = false, ROWSCALE = true, NEEDS_LDS = false;
    bf16_t* O; int ldc; const unsigned long long* ss;
    __device__ __forceinline__ void operator()(const f32x4 (&acc)[2][2][4][2], const Unit& u, int wr, int wc, int fr, int fq, const float (&rs)[8]) const {
        const int row0 = u.pm * BM + wr * 64 + fr, col0 = u.pn * HALF + wc * 32 + 8 * fq;
#pragma unroll
        for (int ai = 0; ai < 2; ++ai)
#pragma unroll
            for (int m = 0; m < 4; ++m) { bf16_t* rowp = O + (size_t)(row0 + ai * HALF + m * 16) * ldc + col0;
                const float rstd = rs[ai * 4 + m];
                float h[8];
#pragma unroll
                for (int n = 0; n < 2; ++n)
#pragma unroll
                    for (int j = 0; j < 4; ++j) { const float g = acc[ai][0][m][n][j] * rstd, up = acc[ai][1][m][n][j] * rstd;
                        h[4 * n + j] = g * __builtin_amdgcn_rcpf(1.0f + __expf(-g)) * up; }
                u32x4 w; w.x = cvt_pk_bf16(h[0], h[1]); w.y = cvt_pk_bf16(h[2], h[3]); w.z = cvt_pk_bf16(h[4], h[5]); w.w = cvt_pk_bf16(h[6], h[7]);
                __builtin_nontemporal_store(w, (u32x4*)rowp); }
    }
};
struct EpiResid {
    static constexpr bool PERM = true, AFTER_DRAIN = false, ROWSCALE = false;
    const void* base; void* out; unsigned long long* ssq; int base_f32, out_f32; float scale;
    static constexpr int row_off = 0;
    static __device__ __forceinline__ void row_sum(float t, int j, int fq, float& ta, float& tb) {
        { const auto r = __builtin_amdgcn_permlane16_swap(__float_as_uint(t), __float_as_uint(t), false, false); t = __uint_as_float(r[0]) + __uint_as_float(r[1]); }
        { const auto r = __builtin_amdgcn_permlane32_swap(__float_as_uint(t), __float_as_uint(t), false, false); t = __uint_as_float(r[0]) + __uint_as_float(r[1]); }
        if (j & 1) tb = (fq == (j >> 1)) ? t : tb; else ta = (fq == (j >> 1)) ? t : ta;
    }
    __device__ __forceinline__ void operator()(const f32x4 (&acc)[2][2][4][2], const Unit& u, int wr, int wc, int fr, int fq) const {
        const int row0 = u.pm * BM + wr * 64 + fr, col0 = u.pn * BM + wc * 32 + 8 * fq;
        const unsigned e0 = (unsigned)((row_off + row0) * 2048 + col0);
        const bool bf = base_f32 != 0, of = out_f32 != 0;
        float ta = 0.f, tb = 0.f;
        if (!bf) {
            u32x4 raw[2][4][2];
#pragma unroll
            for (int ai = 0; ai < 2; ++ai)
#pragma unroll
                for (int m = 0; m < 4; ++m)
#pragma unroll
                    for (int bj = 0; bj < 2; ++bj) raw[ai][m][bj] = *(const u32x4*)((const bf16_t*)base + e0 + (unsigned)((ai * HALF + m * 16) * 2048 + bj * HALF));
#pragma unroll
            for (int ai = 0; ai < 2; ++ai)
#pragma unroll
                for (int m = 0; m < 4; ++m) { float rsum = 0.f;
#pragma unroll
                    for (int bj = 0; bj < 2; ++bj) { const unsigned eo = e0 + (unsigned)((ai * HALF + m * 16) * 2048 + bj * HALF); const u32x4 w = raw[ai][m][bj];
                        const f32x4 b0 = (f32x4){__uint_as_float(w.x << 16), __uint_as_float(w.x & 0xffff0000u), __uint_as_float(w.y << 16), __uint_as_float(w.y & 0xffff0000u)};
                        const f32x4 b1 = (f32x4){__uint_as_float(w.z << 16), __uint_as_float(w.z & 0xffff0000u), __uint_as_float(w.w << 16), __uint_as_float(w.w & 0xffff0000u)};
                        const f32x4 v0 = b0 + acc[ai][bj][m][0] * scale, v1 = b1 + acc[ai][bj][m][1] * scale;
                        rsum += (v0[0] * v0[0] + v0[1] * v0[1]) + (v0[2] * v0[2] + v0[3] * v0[3]) + (v1[0] * v1[0] + v1[1] * v1[1]) + (v1[2] * v1[2] + v1[3] * v1[3]);
                        if (of) { __builtin_nontemporal_store(v0, (f32x4*)((float*)out + eo)); __builtin_nontemporal_store(v1, (f32x4*)((float*)out + eo + 4)); }
                        else { u32x4 o; o.x = cvt_pk_bf16(v0[0], v0[1]); o.y = cvt_pk_bf16(v0[2], v0[3]); o.z = cvt_pk_bf16(v1[0], v1[1]); o.w = cvt_pk_bf16(v1[2], v1[3]);
                            *(u32x4*)((bf16_t*)out + eo) = o; } }
                    row_sum(rsum, ai * 4 + m, fq, ta, tb); }
        } else {
#pragma unroll
            for (int ai = 0; ai < 2; ++ai) {
                f32x4 b0[4][2], b1[4][2];
#pragma unroll
                for (int m = 0; m < 4; ++m)
#pragma unroll
                    for (int bj = 0; bj < 2; ++bj) { const unsigned eo = e0 + (unsigned)((ai * HALF + m * 16) * 2048 + bj * HALF);
                        b0[m][bj] = __builtin_nontemporal_load((const f32x4*)((const float*)base + eo)); b1[m][bj] = __builtin_nontemporal_load((const f32x4*)((const float*)base + eo + 4)); }
#pragma unroll
                for (int m = 0; m < 4; ++m) { float rsum = 0.f;
#pragma unroll
                    for (int bj = 0; bj < 2; ++bj) { const unsigned eo = e0 + (unsigned)((ai * HALF + m * 16) * 2048 + bj * HALF);
                        const f32x4 v0 = b0[m][bj] + acc[ai][bj][m][0] * scale, v1 = b1[m][bj] + acc[ai][bj][m][1] * scale;
                        rsum += (v0[0] * v0[0] + v0[1] * v0[1]) + (v0[2] * v0[2] + v0[3] * v0[3]) + (v1[0] * v1[0] + v1[1] * v1[1]) + (v1[2] * v1[2] + v1[3] * v1[3]);
                        if (of) { __builtin_nontemporal_store(v0, (f32x4*)((float*)out + eo)); __builtin_nontemporal_store(v1, (f32x4*)((float*)out + eo + 4)); }
                        else { u32x4 o; o.x = cvt_pk_bf16(v0[0], v0[1]); o.y = cvt_pk_bf16(v0[2], v0[3]); o.z = cvt_pk_bf16(v1[0], v1[1]); o.w = cvt_pk_bf16(v1[2], v1[3]);
                            *(u32x4*)((bf16_t*)out + eo) = o; } }
                    row_sum(rsum, ai * 4 + m, fq, ta, tb); }
                __builtin_amdgcn_sched_barrier(0);
            }
        }
        { unsigned long long* sp = ssq + row0 + (fq >> 1) * HALF + (fq & 1) * 32;
            __hip_atomic_fetch_add(sp, (unsigned long long)(ta * 16777216.0f), __ATOMIC_RELAXED, __HIP_MEMORY_SCOPE_AGENT);
            __hip_atomic_fetch_add(sp + 16, (unsigned long long)(tb * 16777216.0f), __ATOMIC_RELAXED, __HIP_MEMORY_SCOPE_AGENT); }
    }
};
struct EpiZ {
    static constexpr bool PERM = true, AFTER_DRAIN = false, ROWSCALE = true, NEEDS_LDS = true;
    bf16_t* Z; const unsigned long long* ss; const float* qg; const float* kg; int ldz;
    __device__ __forceinline__ void operator()(const f32x4 (&acc)[2][2][4][2], const Unit& u, int wr, int wc, int fr, int fq, const float (&rs)[8], PG8_LAS float* xch) const {
        const int row0 = u.pm * BM + wr * 64 + fr;
        const int col0 = u.pn * BM + wc * 32 + 8 * fq;
        if (u.pn < 4 || u.pn >= 10) {
#pragma unroll
            for (int ai = 0; ai < 2; ++ai)
#pragma unroll
                for (int m = 0; m < 4; ++m) { bf16_t* rowp = Z + (size_t)(row0 + ai * HALF + m * 16) * ldz + col0;
                    const float rstd = rs[ai * 4 + m];
#pragma unroll
                    for (int bj = 0; bj < 2; ++bj) { const f32x4 v0 = acc[ai][bj][m][0] * rstd, v1 = acc[ai][bj][m][1] * rstd;
                        u32x4 w; w.x = cvt_pk_bf16(v0[0], v0[1]); w.y = cvt_pk_bf16(v0[2], v0[3]); w.z = cvt_pk_bf16(v1[0], v1[1]); w.w = cvt_pk_bf16(v1[2], v1[3]);
                        __builtin_nontemporal_store(w, (u32x4*)(rowp + bj * HALF)); } }
            return;
        }
        asm volatile("" : "+v"(fr), "+v"(fq));
        const bool isq = u.pn < 7;
        const float* gp = (isq ? qg : kg) + wc * 32 + 8 * fq;
        const f32x4 g0 = *(const f32x4*)gp, g1 = *(const f32x4*)(gp + 4);
        float keep[2][2];
#pragma unroll
        for (int ai = 0; ai < 2; ++ai)
#pragma unroll
            for (int m = 0; m < 4; ++m) { const float rstd = rs[ai * 4 + m];
#pragma unroll
                for (int bj = 0; bj < 2; ++bj) { const f32x4 v0 = acc[ai][bj][m][0] * rstd, v1 = acc[ai][bj][m][1] * rstd;
                    float t = (v0[0] * v0[0] + v0[1] * v0[1]) + (v0[2] * v0[2] + v0[3] * v0[3]) + (v1[0] * v1[0] + v1[1] * v1[1]) + (v1[2] * v1[2] + v1[3] * v1[3]);
                    { const auto r = __builtin_amdgcn_permlane16_swap(__float_as_uint(t), __float_as_uint(t), false, false); t = __uint_as_float(r[0]) + __uint_as_float(r[1]); }
                    { const auto r = __builtin_amdgcn_permlane32_swap(__float_as_uint(t), __float_as_uint(t), false, false); t = __uint_as_float(r[0]) + __uint_as_float(r[1]); }
                    if (m == 0) keep[ai][bj] = t; else keep[ai][bj] = (fq == m) ? t : keep[ai][bj]; } }
#pragma unroll
        for (int ai = 0; ai < 2; ++ai)
#pragma unroll
            for (int bj = 0; bj < 2; ++bj) xch[(ai * HALF + wr * 64 + fq * 16 + fr) * 8 + bj * 4 + wc] = keep[ai][bj];
        asm volatile("s_waitcnt lgkmcnt(0)" ::: "memory");
        __builtin_amdgcn_s_barrier();
        const float qscale = isq ? 0.08838834764831845f : 1.0f;
#pragma unroll
        for (int ai = 0; ai < 2; ++ai)
#pragma unroll
            for (int m = 0; m < 4; ++m) { const int rt = ai * HALF + wr * 64 + m * 16 + fr; bf16_t* rowp = Z + (size_t)(u.pm * BM + rt) * ldz + col0;
                const float rstd = rs[ai * 4 + m];
#pragma unroll
                for (int bj = 0; bj < 2; ++bj) {
                    const f32x4 px = *(const PG8_LAS f32x4*)(xch + rt * 8 + bj * 4);
                    const float rq = __builtin_amdgcn_rsqf(((px[0] + px[1]) + (px[2] + px[3])) * (1.f / 128.f) + 1e-6f) * rstd * qscale;
                    f32x4 v0 = acc[ai][bj][m][0] * rq * g0, v1 = acc[ai][bj][m][1] * rq * g1;
                    u32x4 w; w.x = cvt_pk_bf16(v0[0], v0[1]); w.y = cvt_pk_bf16(v0[2], v0[3]); w.z = cvt_pk_bf16(v1[0], v1[1]); w.w = cvt_pk_bf16(v1[2], v1[3]);
                    __builtin_nontemporal_store(w, (u32x4*)(rowp + bj * HALF)); } }
    }
};
}
constexpr int NWAVES = 8;
constexpr int BATCH = 4, SEQ = 8192, DM = 2048, DFF = 5632, DEPTH = 4;
constexpr int M = BATCH * SEQ;
constexpr int NIN = 5648, NZ = 5632, NINP = 5888;
constexpr int ZLD = NZ;
constexpr int ZC_AU = 0, ZC_AV = 512, ZC_BQ = 1024, ZC_BK = 1792, ZC_BV = 2560, ZC_CQ = 3328, ZC_CK = 3712, ZC_CV = 4096, ZC_CG = 4864;
constexpr int YC_A = 0, YC_B = 512, YC_C = 1280;
constexpr int NCHUNK = M / 64;
constexpr float EPS = 1e-6f;

constexpr size_t MiB = 1u << 20;
constexpr size_t WS_CTL = 0, CTL_ZERO_BYTES = 1 * MiB;
constexpr size_t WS_ROPE = 1 * MiB;
constexpr size_t WS_DEC = 4 * MiB;
constexpr size_t WS_LSE = 5 * MiB;
constexpr size_t WS_W = 8 * MiB;
constexpr size_t W_GU = (size_t)2 * DFF * DM * 2, W_D = (size_t)DM * DFF * 2, W_IN = (size_t)NINP * DM * 2, W_OUT = (size_t)DM * DM * 2;
constexpr size_t WL_GU0 = 0, WL_D0 = WL_GU0 + W_GU, WL_GU1 = WL_D0 + W_D, WL_D1 = WL_GU1 + W_GU, WL_IN = WL_D1 + W_D, WL_OUT = WL_IN + W_IN, W_LAYER = WL_OUT + W_OUT;
constexpr size_t WS_H = WS_W + DEPTH * W_LAYER;
constexpr size_t WS_HZ = WS_H + (size_t)M * DM * 2;
constexpr size_t WS_Y = WS_HZ + (size_t)M * DFF * 2;
constexpr size_t WS_OG = WS_Y + (size_t)M * DM * 2;
constexpr size_t WS_QD = WS_OG + (size_t)3 * M * 768 * 2;
constexpr size_t WS_KD = WS_QD + (size_t)M * 384 * 2;
constexpr size_t WS_SB = WS_KD + (size_t)M * 384 * 2;
constexpr size_t WS_SS = WS_SB + (size_t)NCHUNK * 6 * 8192 * 2;
constexpr size_t WS_END = WS_SS + (size_t)13 * M * 8;
constexpr float SS_SCALE = 16777216.0f, SS_INV = 1.0f / 16777216.0f;
static_assert(W_LAYER == 163 * MiB && WS_H == 660 * MiB && (size_t)NCHUNK * 6 * 128 * 64 * 4 <= (size_t)M * DM * 2, "ws map");
constexpr int CW_BAR = 4096;

constexpr int SCR_BYTES = 139264;
constexpr int LDSCTL_OFF = SCR_BYTES;
constexpr int LDSX_OFF = 143360;
constexpr int LDS_BYTES = 151552;
static_assert(LDSX_OFF == pg8::XCH_OFF, "lds");
static_assert(pg8::STAGE_BYTES <= SCR_BYTES, "lds");

#define GAS __attribute__((address_space(1)))
#define LAS __attribute__((address_space(3)))
typedef unsigned short bf16;
typedef unsigned v4u __attribute__((ext_vector_type(4)));
typedef unsigned v2u __attribute__((ext_vector_type(2)));
typedef float f32x4 __attribute__((ext_vector_type(4)));
typedef short bf16x8 __attribute__((ext_vector_type(8)));
typedef short s16x4 __attribute__((ext_vector_type(4)));
#define LDS_WAIT() asm volatile("s_waitcnt lgkmcnt(0)" ::: "memory")
__device__ __forceinline__ float bflo(unsigned w) { return __uint_as_float(w << 16); }
__device__ __forceinline__ float bfhi(unsigned w) { return __uint_as_float(w & 0xffff0000u); }
__device__ __forceinline__ float bf1(bf16 b) { return __uint_as_float(((unsigned)b) << 16); }
__device__ __forceinline__ unsigned pk2(float lo, float hi) { return pg8::cvt_pk_bf16(lo, hi); }
__device__ __forceinline__ bf16 f2bf(float f) { return (bf16)(pg8::cvt_pk_bf16(f, 0.f) & 0xffffu); }
__device__ __forceinline__ void unpack8(const v4u w, float (&f)[8]) { f[0] = bflo(w.x); f[1] = bfhi(w.x); f[2] = bflo(w.y); f[3] = bfhi(w.y); f[4] = bflo(w.z); f[5] = bfhi(w.z); f[6] = bflo(w.w); f[7] = bfhi(w.w); }
__device__ __forceinline__ v4u pack8(const float (&f)[8]) { v4u w; w.x = pk2(f[0], f[1]); w.y = pk2(f[2], f[3]); w.z = pk2(f[4], f[5]); w.w = pk2(f[6], f[7]); return w; }
__device__ __forceinline__ float gelu_tanh(float x) {
    const float u = 0.7978845608028654f * (x + 0.044715f * x * x * x);
    const float e = __expf(2.0f * u);
    const float th = 1.0f - 2.0f * __builtin_amdgcn_rcpf(1.0f + e);
    return 0.5f * x * (1.0f + th);
}
__device__ __forceinline__ float silu_f(float x) { return x * __builtin_amdgcn_rcpf(1.0f + __expf(-x)); }
__device__ __forceinline__ bf16x8 lds_row8(const LAS unsigned char* p) { return *(const LAS bf16x8*)p; }
typedef short v4i16_t __attribute__((ext_vector_type(4)));
__device__ __forceinline__ s16x4 lds_tr4(const LAS unsigned char* p) { return __builtin_bit_cast(s16x4, __builtin_amdgcn_ds_read_tr16_b64_v4i16((LAS v4i16_t*)p)); }
__device__ __forceinline__ bf16x8 cat8(s16x4 lo, s16x4 hi) { return __builtin_shufflevector(lo, hi, 0, 1, 2, 3, 4, 5, 6, 7); }
#define MFMA16(a, b, c) __builtin_amdgcn_mfma_f32_16x16x32_bf16((a), (b), (c), 0, 0, 0)
__device__ __forceinline__ v4u widen_pair(v2u a, v2u b) {
    const auto rx = __builtin_amdgcn_permlane16_swap(a.x, b.x, false, false); const auto ry = __builtin_amdgcn_permlane16_swap(a.y, b.y, false, false);
    v4u w; w.x = rx[0]; w.y = ry[0]; w.z = rx[1]; w.w = ry[1]; return w;
}
__device__ __forceinline__ void unwiden_pair(v4u w, v2u& a, v2u& b) {
    const auto rx = __builtin_amdgcn_permlane16_swap(w.x, w.z, false, false); const auto ry = __builtin_amdgcn_permlane16_swap(w.y, w.w, false, false);
    a.x = rx[0]; a.y = ry[0]; b.x = rx[1]; b.y = ry[1];
}
__device__ __forceinline__ int wide_col(int g4) { return (g4 & 1) ? 16 + 4 * (g4 - 1) : 4 * g4; }

#define XB_TMO      128
#define XB_XCNT(j)  (256  + 64 * (j))
#define XB_XSUB(j)  (1280 + 64 * (j))
#define XB_XGEN(j)  (2304 + 64 * (j))
#define XB_TOP      3328
#define XB_TOPGEN   3392
#define XCD_BAR_WORDS 3456
#define XB_SPIN_CAP (1u << 21)

__device__ __forceinline__ unsigned xb_ld(unsigned* p)              { return __hip_atomic_load(p, __ATOMIC_RELAXED, __HIP_MEMORY_SCOPE_AGENT); }
__device__ __forceinline__ unsigned xb_add(unsigned* p, unsigned v) { return __hip_atomic_fetch_add(p, v, __ATOMIC_RELAXED, __HIP_MEMORY_SCOPE_AGENT); }
__device__ __forceinline__ unsigned xb_xcc_id() { return (unsigned)__builtin_amdgcn_s_getreg((3 << 11) | 20) & 0xFu; }
#define XB_SPIN(cond, bar) do { unsigned _sp = 0; while (cond) { __builtin_amdgcn_s_sleep(1); \
    if ((++_sp & 255u) == 0u) { if (xb_ld(&(bar)[XB_TMO])) break; if (_sp > XB_SPIN_CAP) { atomicAdd(&(bar)[XB_TMO], 1u); break; } } } } while (0)

struct XcdBarrier {
    unsigned* bar; unsigned x;
    volatile LAS unsigned* st;
};

__device__ __forceinline__ XcdBarrier xcd_barrier_post(unsigned* bar, volatile LAS unsigned* st) {
    XcdBarrier b; b.bar = bar; b.x = xb_xcc_id(); b.st = st;
    if (threadIdx.x == 0) (void)xb_add(&bar[XB_XCNT(b.x)], 1u);
    return b;
}
__device__ __forceinline__ void xcd_barrier_complete(unsigned* bar, unsigned x, unsigned& nloc, unsigned& nx) {
    const unsigned G = gridDim.x * gridDim.y * gridDim.z;
    unsigned sum, cnt, mine, sp = 0u;
    for (;;) {
        sum = 0u; cnt = 0u; mine = 0u;
#pragma unroll
        for (unsigned j = 0; j < 16; ++j) { const unsigned c = xb_ld(&bar[XB_XCNT(j)]); sum += c; cnt += (c > 0u) ? 1u : 0u; mine = (j == x) ? c : mine; }
        if (sum == G) break;
        __builtin_amdgcn_s_sleep(1);
        if ((++sp & 255u) == 0u) { if (xb_ld(&bar[XB_TMO])) break; if (sp > XB_SPIN_CAP) { atomicAdd(&bar[XB_TMO], 1u); break; } }
    }
    nloc = mine > 0u ? mine : 1u; nx = cnt > 0u ? cnt : 1u;
}

__device__ __forceinline__ void xcd_barrier(const XcdBarrier& b) {
    asm volatile("s_waitcnt vmcnt(0)" ::: "memory");
    __syncthreads();
    if (threadIdx.x == 0) {
        unsigned* bar = b.bar;
        __builtin_amdgcn_s_waitcnt(0);
        unsigned nloc = b.st[0], nx = b.st[1];
        if (nloc == 0u) { xcd_barrier_complete(bar, b.x, nloc, nx); b.st[0] = nloc; b.st[1] = nx; }
        const unsigned old = xb_add(&bar[XB_XSUB(b.x)], 1u);
        const unsigned gen = old / nloc;
        if (old + 1u == (gen + 1u) * nloc) {
            __builtin_amdgcn_fence(__ATOMIC_RELEASE, "agent");
            asm volatile("s_waitcnt vmcnt(0)" ::: "memory");
            const unsigned og = xb_add(&bar[XB_TOP], 1u);
            const unsigned tg = og / nx;
            if (og + 1u == (tg + 1u) * nx) xb_add(&bar[XB_TOPGEN], 1u);
            else XB_SPIN(xb_ld(&bar[XB_TOPGEN]) == tg, bar);
            __builtin_amdgcn_fence(__ATOMIC_ACQUIRE, "agent");
            xb_add(&bar[XB_XGEN(b.x)], 1u);
            asm volatile("s_waitcnt vmcnt(0)" ::: "memory");
        } else {
            XB_SPIN(xb_ld(&bar[XB_XGEN(b.x)]) == gen, bar);
            __builtin_amdgcn_fence(__ATOMIC_ACQUIRE, "agent");
            asm volatile("s_waitcnt vmcnt(0)" ::: "memory");
        }
    }
    __syncthreads();
}

struct Args {
    const float* in[16]; float* out; unsigned char* ws;
    float inv_freq[16];
};

__device__ __forceinline__ void transpose_item(const float* __restrict__ W, int ldw, int nvalid, int k0, int n0, bf16* __restrict__ WT, int ldt, int dst_row0, LAS float* scr, int lane, const float* __restrict__ gk = nullptr) {
    const int nq = lane & 15, kq = lane >> 4;
    const int nc = n0 + 4 * nq; const bool okc = nc < nvalid;
    const float* wp = W + (size_t)(k0 + kq) * ldw + nc;
    f32x4 v[16];
#pragma unroll
    for (int i = 0; i < 16; ++i) v[i] = okc ? __builtin_nontemporal_load((const f32x4*)(wp + (size_t)(4 * i) * ldw)) : (f32x4){0.f, 0.f, 0.f, 0.f};
    if (gk) {
        float gv[16];
#pragma unroll
        for (int i = 0; i < 16; ++i) gv[i] = gk[k0 + kq + 4 * i];
#pragma unroll
        for (int i = 0; i < 16; ++i) v[i] *= gv[i];
    }
    LAS float* sw = scr + (4 * nq) * 65 + kq;
#pragma unroll
    for (int i = 0; i < 16; ++i) { sw[4 * i] = v[i].x; sw[65 + 4 * i] = v[i].y; sw[130 + 4 * i] = v[i].z; sw[195 + 4 * i] = v[i].w; }
    LDS_WAIT(); asm volatile("" ::: "memory");
    const int c = lane & 7;
#pragma unroll
    for (int j = 0; j < 8; ++j) { const int n = (lane >> 3) + 8 * j; const LAS float* s = scr + n * 65 + 8 * c;
        v4u o; o.x = pk2(s[0], s[1]); o.y = pk2(s[2], s[3]); o.z = pk2(s[4], s[5]); o.w = pk2(s[6], s[7]);
        *(v4u*)(WT + (size_t)(dst_row0 + n) * ldt + k0 + 8 * c) = o; }
    LDS_WAIT(); asm volatile("" ::: "memory");
}
constexpr int IT_GU = (DM / 64) * (DFF / 64);
constexpr int IT_D = (DFF / 64) * (DM / 64);
constexpr int IT_IN = (DM / 64) * (NINP / 64);
constexpr int IT_OUT = (DM / 64) * (DM / 64);
constexpr int IT_LAYER = 2 * (2 * IT_GU + IT_D) + IT_IN + IT_OUT;

typedef const __attribute__((address_space(4))) Args* ArgPc;
__device__ __forceinline__ void prologue(ArgPc Ap, unsigned char* ws, LAS unsigned char* lds, int gw, int ngw, int wave, int lane, int gtid, int ngt) {
    LAS float* scr = (LAS float*)(lds + wave * 16640);
    for (int it = gw; it < DEPTH * IT_LAYER; it += ngw) {
        const int l = it / IT_LAYER; int r = it - l * IT_LAYER;
        unsigned char* wl = ws + WS_W + (size_t)l * W_LAYER;
        if (r < 2 * (2 * IT_GU + IT_D)) {
            const int f = r / (2 * IT_GU + IT_D); r -= f * (2 * IT_GU + IT_D);
            const size_t wsel = (size_t)(l * 2 + f);
            if (r < 2 * IT_GU) {
                const int up = r / IT_GU; r -= up * IT_GU;
                const float* W = (up ? Ap->in[3] : Ap->in[2]) + wsel * DM * DFF;
                const int kb = r / (DFF / 64), nb = r % (DFF / 64), n0 = nb * 64;
                bf16* WT = (bf16*)(wl + (f ? WL_GU1 : WL_GU0));
                transpose_item(W, DFF, DFF, kb * 64, n0, WT, DM, 256 * (n0 >> 7) + (n0 & 127) + 128 * up, scr, lane, Ap->in[1] + wsel * DM);
            } else {
                r -= 2 * IT_GU;
                const float* W = Ap->in[4] + wsel * DFF * DM;
                const int kb = r / (DM / 64), nb = r % (DM / 64);
                bf16* WT = (bf16*)(wl + (f ? WL_D1 : WL_D0));
                transpose_item(W, DM, DM, kb * 64, nb * 64, WT, DFF, nb * 64, scr, lane);
            }
        } else {
            r -= 2 * (2 * IT_GU + IT_D);
            if (r < IT_IN) {
                const float* W = Ap->in[6] + (size_t)l * DM * NIN;
                const int kb = r / (NINP / 64), nb = r % (NINP / 64);
                transpose_item(W, NIN, NIN, kb * 64, nb * 64, (bf16*)(wl + WL_IN), DM, nb * 64, scr, lane, Ap->in[5] + (size_t)l * DM);
            } else {
                r -= IT_IN;
                const float* W = Ap->in[15] + (size_t)l * DM * DM;
                const int kb = r / (DM / 64), nb = r % (DM / 64);
                transpose_item(W, DM, DM, kb * 64, nb * 64, (bf16*)(wl + WL_OUT), DM, nb * 64, scr, lane);
            }
        }
    }
    { unsigned long long* ss = (unsigned long long*)(ws + WS_SS); for (int i = gtid; i < 13 * M; i += ngt) ss[i] = 0ull; }
    float* rc = (float*)(ws + WS_ROPE); float* rs = rc + SEQ * 16;
    for (int i = gtid; i < SEQ * 16; i += ngt) {
        const int pos = i >> 4, k = i & 15;
        const float angf = (float)pos * Ap->inv_freq[k];
        const double a = (double)angf;
        const double q = __builtin_rint(a * 0.63661977236758134308);
        double x = __builtin_fma(-q, 1.57079632679489655800e+00, a); x = __builtin_fma(-q, 6.12323399573676603587e-17, x);
        const double x2 = x * x;
        double sp = 1.0 / 6227020800.0; sp = sp * x2 - 1.0 / 39916800.0; sp = sp * x2 + 1.0 / 362880.0; sp = sp * x2 - 1.0 / 5040.0; sp = sp * x2 + 1.0 / 120.0; sp = sp * x2 - 1.0 / 6.0; sp = sp * x2 + 1.0; sp *= x;
        double cp = 1.0 / 87178291200.0; cp = -cp; cp = cp * x2 + 1.0 / 479001600.0; cp = cp * x2 - 1.0 / 3628800.0; cp = cp * x2 + 1.0 / 40320.0; cp = cp * x2 - 1.0 / 720.0; cp = cp * x2 + 1.0 / 24.0; cp = cp * x2 - 0.5; cp = cp * x2 + 1.0;
        const int qi = ((int)q) & 3;
        const double sv = (qi == 0) ? sp : (qi == 1) ? cp : (qi == 2) ? -sp : -cp;
        const double cv = (qi == 0) ? cp : (qi == 1) ? -sp : (qi == 2) ? -cp : sp;
        rc[i] = (float)cv; rs[i] = (float)sv;
    }
}

__device__ __forceinline__ float wave_sum(float v) {
#pragma unroll
    for (int o = 1; o < 64; o <<= 1) v += __shfl_xor(v, o);
    return v;
}
__device__ __forceinline__ void conv_phase(const float* __restrict__ x, bf16* __restrict__ xb, unsigned long long* __restrict__ ss, int gw, int ngw, int lane) {
    for (int m = gw; m < M; m += ngw) {
        const f32x4* xr = (const f32x4*)(x + (size_t)m * DM) + lane;
        f32x4 v[8]; float s = 0.f;
#pragma unroll
        for (int j = 0; j < 8; ++j) { v[j] = xr[64 * j]; s += (v[j].x * v[j].x + v[j].y * v[j].y) + (v[j].z * v[j].z + v[j].w * v[j].w); }
        s = wave_sum(s);
        v2u* o = (v2u*)(xb + (size_t)m * DM) + lane;
#pragma unroll
        for (int j = 0; j < 8; ++j) { v2u w; w.x = pk2(v[j].x, v[j].y); w.y = pk2(v[j].z, v[j].w); o[64 * j] = w; }
        if (lane == 0) ss[m] = (unsigned long long)(s * SS_SCALE);
    }
}


constexpr int LD128 = 272;
constexpr int LD64 = 144;
struct GmlpIn { f32x4 w0[4], w1[4], g0, g1; v4u vw[4], upv[4]; float bias; };
__device__ __forceinline__ void gmlp_load(const bf16* __restrict__ z, const float* __restrict__ sgw, const float* __restrict__ sgb, const float* __restrict__ sgn, int um, int tid, int w, int lane, GmlpIn& I) {
    const int g = um & 3, cn = um >> 2; const size_t R0 = (size_t)cn * 128;
    const int c16 = lane & 15, g4 = lane >> 4;
    const bf16* up0 = z + (R0 + 16 * w + c16) * ZLD + ZC_AU + 128 * g + wide_col(g4);
#pragma unroll
    for (int q = 0; q < 4; ++q) I.upv[q] = *(const v4u*)(up0 + 32 * q);
#pragma unroll
    for (int it = 0; it < 4; ++it) {
        const int c = tid + 512 * it, t = c >> 4, ch = c & 15;
        const float* wp = sgw + ((size_t)(g * 128 + t)) * 128 + 8 * ch;
        I.w0[it] = *(const f32x4*)wp; I.w1[it] = *(const f32x4*)(wp + 4);
        I.vw[it] = *(const v4u*)(z + (R0 + t) * ZLD + ZC_AV + 128 * g + 8 * ch);
    }
    const float* gp = sgn + 128 * g + 8 * (tid & 15);
    I.g0 = *(const f32x4*)gp; I.g1 = *(const f32x4*)(gp + 4);
    I.bias = sgb[g * 128 + 16 * w + c16];
}
__device__ __forceinline__ void gmlp_unit(LAS unsigned char* lds, const bf16* __restrict__ z, const float* __restrict__ sgw, const float* __restrict__ sgb, const float* __restrict__ sgn,
                                          bf16* __restrict__ y, int um, int tid, int w, int lane, GmlpIn& I, bool has_next) {
    const int g = um & 3, cn = um >> 2; const size_t R0 = (size_t)cn * 128;
    const int c16 = lane & 15, g4 = lane >> 4, q4 = c16 >> 2, p4 = lane & 3;
    LAS unsigned char* WM = lds; LAS unsigned char* VN = lds + 128 * LD128;
    const float gg[8] = {I.g0.x, I.g0.y, I.g0.z, I.g0.w, I.g1.x, I.g1.y, I.g1.z, I.g1.w};
#pragma unroll
    for (int it = 0; it < 4; ++it) {
        const int c = tid + 512 * it, t = c >> 4, ch = c & 15;
        const f32x4 w0 = I.w0[it], w1 = I.w1[it];
        float f[8] = {w0.x, w0.y, w0.z, w0.w, w1.x, w1.y, w1.z, w1.w};
#pragma unroll
        for (int e = 0; e < 8; ++e) f[e] = (8 * ch + e <= t) ? f[e] : 0.f;
        *(LAS v4u*)(WM + t * LD128 + ch * 16) = pack8(f);
        float v[8]; unpack8(I.vw[it], v); float ss = 0.f;
#pragma unroll
        for (int e = 0; e < 8; ++e) { v[e] = gelu_tanh(v[e]); ss += v[e] * v[e]; }
        ss += __shfl_xor(ss, 1); ss += __shfl_xor(ss, 2); ss += __shfl_xor(ss, 4); ss += __shfl_xor(ss, 8);
        const float rstd = rsqrtf(ss * (1.f / 128.f) + EPS);
#pragma unroll
        for (int e = 0; e < 8; ++e) v[e] = v[e] * rstd * gg[e];
        *(LAS v4u*)(VN + t * LD128 + ch * 16) = pack8(v);
    }
    v4u upv[4]; const float bias = I.bias;
#pragma unroll
    for (int q = 0; q < 4; ++q) upv[q] = I.upv[q];
    if (has_next) gmlp_load(z, sgw, sgb, sgn, um + 1, tid, w, lane, I);
    __syncthreads();
    f32x4 acc[8];
#pragma unroll
    for (int ct = 0; ct < 8; ++ct) acc[ct] = (f32x4){0.f, 0.f, 0.f, 0.f};
    const int nks = (w >> 1) + 1;
#pragma unroll
    for (int ks = 0; ks < 4; ++ks) {
        if (ks < nks) {
            const bf16x8 af = lds_row8(WM + (16 * w + c16) * LD128 + (32 * ks + 8 * g4) * 2);
            const LAS unsigned char* vb = VN + (32 * ks + 8 * g4 + q4) * LD128 + (4 * p4) * 2;
#pragma unroll
            for (int ct = 0; ct < 8; ++ct) {
                const bf16x8 bfr = cat8(lds_tr4(vb + ct * 32), lds_tr4(vb + 4 * LD128 + ct * 32));
                acc[ct] = MFMA16(bfr, af, acc[ct]);
            }
        }
    }
    const int t = 16 * w + c16;
    bf16* yp = y + (R0 + t) * DM + YC_A + 128 * g + wide_col(g4);
#pragma unroll
    for (int ct = 0; ct < 8; ct += 2) {
        v2u o[2], uu[2]; unwiden_pair(upv[ct >> 1], uu[0], uu[1]);
#pragma unroll
        for (int q = 0; q < 2; ++q) { const int c = ct + q;
            const v2u uw = uu[q];
            const float u0 = gelu_tanh(bflo(uw.x)), u1 = gelu_tanh(bfhi(uw.x)), u2 = gelu_tanh(bflo(uw.y)), u3 = gelu_tanh(bfhi(uw.y));
            o[q].x = pk2(u0 * (acc[c][0] + bias), u1 * (acc[c][1] + bias)); o[q].y = pk2(u2 * (acc[c][2] + bias), u3 * (acc[c][3] + bias)); }
        *(v4u*)(yp + 16 * ct) = widen_pair(o[0], o[1]);
    }
    __syncthreads();
}

__device__ __forceinline__ void qk_prepass(bf16* __restrict__ z, const float* __restrict__ qgain, const float* __restrict__ kgain, const float* __restrict__ ropec, const float* __restrict__ ropes,
                                           int gw, int ngw, int lane) {
    const int ch = lane & 15;
    const f32x4 q0 = *(const f32x4*)(qgain + 8 * ch), q1 = *(const f32x4*)(qgain + 8 * ch + 4), k0 = *(const f32x4*)(kgain + 8 * ch), k1 = *(const f32x4*)(kgain + 8 * ch + 4);
    const float qg[8] = {q0.x, q0.y, q0.z, q0.w, q1.x, q1.y, q1.z, q1.w}, kg[8] = {k0.x, k0.y, k0.z, k0.w, k1.x, k1.y, k1.z, k1.w};
    const float sg = (ch < 2) ? -1.f : 1.f;
    for (int m = gw; m < M; m += ngw) {
        bf16* zr = z + (size_t)m * ZLD + ZC_BQ + 8 * lane;
        const int t = m & (SEQ - 1);
        v4u w[3];
#pragma unroll
        for (int it = 0; it < 3; ++it) w[it] = *(const v4u*)(zr + 512 * it);
        float cc[8], sn[8];
        {
            const float* cp = ropec + t * 16 + 8 * (ch & 1); const float* sp = ropes + t * 16 + 8 * (ch & 1);
            const f32x4 c0 = *(const f32x4*)cp, c1 = *(const f32x4*)(cp + 4), s0 = *(const f32x4*)sp, s1 = *(const f32x4*)(sp + 4);
            cc[0] = c0.x; cc[1] = c0.y; cc[2] = c0.z; cc[3] = c0.w; cc[4] = c1.x; cc[5] = c1.y; cc[6] = c1.z; cc[7] = c1.w;
            sn[0] = s0.x; sn[1] = s0.y; sn[2] = s0.z; sn[3] = s0.w; sn[4] = s1.x; sn[5] = s1.y; sn[6] = s1.z; sn[7] = s1.w;
        }
#pragma unroll
        for (int it = 0; it < 3; ++it) {
            const bool isq = (4 * it + (lane >> 4)) < 6;
            float f[8]; unpack8(w[it], f); float ss = 0.f;
#pragma unroll
            for (int e = 0; e < 8; ++e) ss += f[e] * f[e];
            ss += __shfl_xor(ss, 1); ss += __shfl_xor(ss, 2); ss += __shfl_xor(ss, 4); ss += __shfl_xor(ss, 8);
            const float rstd = rsqrtf(ss * (1.f / 128.f) + EPS);
#pragma unroll
            for (int e = 0; e < 8; ++e) f[e] = f[e] * rstd * (isq ? qg[e] : kg[e]);
            float pr[8];
#pragma unroll
            for (int e = 0; e < 8; ++e) pr[e] = __shfl_xor(f[e], 2);
            if (ch < 4) {
#pragma unroll
                for (int e = 0; e < 8; ++e) f[e] = f[e] * cc[e] + sg * pr[e] * sn[e];
            }
            const float sc = isq ? 0.08838834764831845f : 1.0f;
#pragma unroll
            for (int e = 0; e < 8; ++e) f[e] *= sc;
            *(v4u*)(zr + 512 * it) = pack8(f);
        }
    }
}
__device__ __forceinline__ void rope_prepass(bf16* __restrict__ z, const float* __restrict__ ropec, const float* __restrict__ ropes, int gw, int ngw, int lane) {
    const int c4 = lane & 3; const bool act = lane < 48;
    const float sg = (c4 < 2) ? -1.f : 1.f;
    const int loff = ZC_BQ + (act ? (lane >> 2) : 0) * 128 + 8 * c4, toff = 8 * (c4 & 1);
    for (int m0 = gw * 4; m0 < M; m0 += ngw * 4) {
        v4u w[4]; f32x4 cc[4][2], sn[4][2];
#pragma unroll
        for (int r = 0; r < 4; ++r) { const int m = m0 + r, t = m & (SEQ - 1);
            w[r] = *(const v4u*)(z + (size_t)m * ZLD + loff);
            cc[r][0] = *(const f32x4*)(ropec + t * 16 + toff); cc[r][1] = *(const f32x4*)(ropec + t * 16 + toff + 4);
            sn[r][0] = *(const f32x4*)(ropes + t * 16 + toff); sn[r][1] = *(const f32x4*)(ropes + t * 16 + toff + 4); }
#pragma unroll
        for (int r = 0; r < 4; ++r) {
            float f[8]; unpack8(w[r], f);
            const float c[8] = {cc[r][0].x, cc[r][0].y, cc[r][0].z, cc[r][0].w, cc[r][1].x, cc[r][1].y, cc[r][1].z, cc[r][1].w};
            const float s[8] = {sn[r][0].x, sn[r][0].y, sn[r][0].z, sn[r][0].w, sn[r][1].x, sn[r][1].y, sn[r][1].z, sn[r][1].w};
#pragma unroll
            for (int e = 0; e < 8; ++e) { const float pr = __shfl_xor(f[e], 2); f[e] = f[e] * c[e] + sg * pr * s[e]; }
            if (act) *(v4u*)(z + (size_t)(m0 + r) * ZLD + loff) = pack8(f);
        }
    }
}
struct AttnDesc { int gi, dil, h, r, nb; size_t rowbase; };
__device__ __forceinline__ AttnDesc attn_decode(int gi, int ub) {
    AttnDesc d; d.gi = gi; int rem = ub;
    d.dil = (gi == 0) ? 1 : (gi == 1) ? 4 : 16; const int lg = (gi == 0) ? 6 : (gi == 1) ? 4 : 2;
    const int b = rem / 384; rem -= b * 384; d.h = rem >> 6; rem &= 63;
    d.r = rem >> lg; d.nb = rem & ((1 << lg) - 1); d.rowbase = (size_t)b * SEQ; return d;
}
struct AttnRegs { v4u k[4], v[4], pk[4], pv[4], q[4]; };
template <int PART>
__device__ __forceinline__ void attn_issue(const bf16* __restrict__ z, const AttnDesc& d, bool need_prev, AttnRegs& R, int tid, int w, int lane) {
    const int ch = tid & 15, row0 = tid >> 4;
    if constexpr (PART != 2) {
#pragma unroll
        for (int it = 0; it < 4; ++it) {
            const int t = (128 * d.nb + row0 + 32 * it) * d.dil + d.r;
            const bf16* zr = z + (d.rowbase + t) * ZLD + 128 * d.h + 8 * ch;
            if constexpr (PART != 1) R.k[it] = *(const v4u*)(zr + ZC_BK);
            if constexpr (PART != 0) R.v[it] = *(const v4u*)(zr + ZC_BV);
        }
        if (need_prev) {
#pragma unroll
            for (int it = 0; it < 4; ++it) {
                const int t = (128 * (d.nb - 1) + row0 + 32 * it) * d.dil + d.r;
                const bf16* zr = z + (d.rowbase + t) * ZLD + 128 * d.h + 8 * ch;
                if constexpr (PART != 1) R.pk[it] = *(const v4u*)(zr + ZC_BK);
                if constexpr (PART != 0) R.pv[it] = *(const v4u*)(zr + ZC_BV);
            }
        }
    }
    if constexpr (PART == 2 || PART == -1) {
        const int tq = (128 * d.nb + 16 * w + (lane & 15)) * d.dil + d.r;
        const bf16* zq = z + (d.rowbase + tq) * ZLD + ZC_BQ + 128 * d.h + 8 * (lane >> 4);
#pragma unroll
        for (int ks = 0; ks < 4; ++ks) R.q[ks] = *(const v4u*)(zq + 32 * ks);
    }
}
__device__ __forceinline__ void attn_stage(LAS unsigned char* lds, const AttnRegs& R, int nb, bool had_prev, int tid) {
    LAS unsigned char* KS = lds; LAS unsigned char* VS = lds + 256 * LD128;
    const int ch = tid & 15, row0 = tid >> 4;
    const int vsw = 32 * ((ch >> 1) ^ (row0 & 7)) + 16 * (ch & 1);
    const int sc = (nb & 1) * 128, sp = ((nb + 1) & 1) * 128;
#pragma unroll
    for (int it = 0; it < 4; ++it) {
        const int row = sc + row0 + 32 * it;
        *(LAS v4u*)(KS + row * LD128 + ch * 16) = R.k[it];
        *(LAS v4u*)(VS + 256 * row + vsw) = R.v[it];
    }
    if (had_prev) {
#pragma unroll
        for (int it = 0; it < 4; ++it) {
            const int row = sp + row0 + 32 * it;
            *(LAS v4u*)(KS + row * LD128 + ch * 16) = R.pk[it];
            *(LAS v4u*)(VS + 256 * row + vsw) = R.pv[it];
        }
    } else if (nb == 0) {
#pragma unroll
        for (int it = 0; it < 4; ++it) *(LAS v4u*)(VS + 256 * (sp + row0 + 32 * it) + vsw) = (v4u){0u, 0u, 0u, 0u};
    }
}
struct AttnOut { v4u o[4]; float lv; bf16* op; float* lp; };
__device__ __forceinline__ void attn_store(const AttnOut& r, int lane) {
#pragma unroll
    for (int q = 0; q < 4; ++q) *(v4u*)(r.op + 32 * q) = r.o[q];
    if ((lane >> 4) == 0) *r.lp = r.lv;
}
__device__ __forceinline__ void attn_compute(LAS unsigned char* lds, const AttnDesc& d, const bf16x8 (&qf)[4], bf16* __restrict__ og, float* __restrict__ lse, int w, int lane,
                                             const bf16* __restrict__ z, const AttnDesc& dn, bool npn, bool has_next, AttnRegs& R, int tid, AttnOut& res) {
    const int c16 = lane & 15, g4 = lane >> 4, q4 = c16 >> 2, p4 = lane & 3;
    const LAS unsigned char* KS = lds; const LAS unsigned char* VS = lds + 256 * LD128;
    const int qi = 16 * w + c16; const int tq = (128 * d.nb + qi) * d.dil + d.r;
    f32x4 sc[9];
#pragma unroll
    for (int j = 0; j < 9; ++j) {
        sc[j] = (f32x4){0.f, 0.f, 0.f, 0.f};
        const int kt = w + j; const int lrow = ((d.nb + (kt >> 3) + 1) & 1) * 128 + (kt & 7) * 16;
        const LAS unsigned char* kp = KS + (lrow + c16) * LD128 + 16 * g4;
#pragma unroll
        for (int ks = 0; ks < 4; ++ks) sc[j] = MFMA16(lds_row8(kp + 64 * ks), qf[ks], sc[j]);
    }
    __builtin_amdgcn_sched_barrier(0);
    if (has_next) attn_issue<0>(z, dn, npn, R, tid, w, lane);
    __builtin_amdgcn_sched_barrier(0);
    float mx = -1e30f;
#pragma unroll
    for (int j = 0; j < 9; ++j)
#pragma unroll
        for (int e = 0; e < 4; ++e) { const int kj = 16 * (w + j) + 4 * g4 + e; const int dist = qi + 128 - kj;
            const bool valid = (dist >= 0) && (dist <= 128) && (d.nb > 0 || kj >= 128);
            sc[j][e] = valid ? sc[j][e] : -1e30f; mx = fmaxf(mx, sc[j][e]); }
    mx = fmaxf(mx, __shfl_xor(mx, 16)); mx = fmaxf(mx, __shfl_xor(mx, 32));
    __builtin_amdgcn_sched_barrier(0);
    if (has_next) attn_issue<1>(z, dn, npn, R, tid, w, lane);
    __builtin_amdgcn_sched_barrier(0);
    float l = 0.f;
#pragma unroll
    for (int j = 0; j < 9; ++j)
#pragma unroll
        for (int e = 0; e < 4; ++e) { const float p = __expf(sc[j][e] - mx); sc[j][e] = p; l += p; }
    l += __shfl_xor(l, 16); l += __shfl_xor(l, 32);
    __builtin_amdgcn_sched_barrier(0);
    if (has_next) attn_issue<2>(z, dn, npn, R, tid, w, lane);
    __builtin_amdgcn_sched_barrier(0);
    const int xr = 4 * (g4 & 1) + q4;
    f32x4 oa[8];
#pragma unroll
    for (int ct = 0; ct < 8; ++ct) oa[ct] = (f32x4){0.f, 0.f, 0.f, 0.f};
#pragma unroll
    for (int s = 0; s < 5; ++s) {
        v4u pw; pw.x = pk2(sc[2 * s][0], sc[2 * s][1]); pw.y = pk2(sc[2 * s][2], sc[2 * s][3]);
        if (s < 4) { pw.z = pk2(sc[2 * s + 1][0], sc[2 * s + 1][1]); pw.w = pk2(sc[2 * s + 1][2], sc[2 * s + 1][3]); } else { pw.z = 0u; pw.w = 0u; }
        const bf16x8 pf = __builtin_bit_cast(bf16x8, pw);
        const int kt0 = w + 2 * s, kt1 = (w + 2 * s + 1 > 15) ? 15 : (w + 2 * s + 1);
        const int lr0 = ((d.nb + (kt0 >> 3) + 1) & 1) * 128 + (kt0 & 7) * 16, lr1 = ((d.nb + (kt1 >> 3) + 1) & 1) * 128 + (kt1 & 7) * 16;
        const LAS unsigned char* v0 = VS + (lr0 + 4 * g4 + q4) * 256 + 8 * p4;
        const LAS unsigned char* v1 = VS + (lr1 + 4 * g4 + q4) * 256 + 8 * p4;
#pragma unroll
        for (int ct = 0; ct < 8; ++ct) oa[ct] = MFMA16(cat8(lds_tr4(v0 + 32 * (ct ^ xr)), lds_tr4(v1 + 32 * (ct ^ xr))), pf, oa[ct]);
    }
    const float inv = 1.0f / l;
    const size_t orow = (size_t)d.gi * M + d.rowbase + tq;
    res.op = og + orow * 768 + 128 * d.h + wide_col(g4);
#pragma unroll
    for (int ct = 0; ct < 8; ct += 2) { v2u o0, o1; o0.x = pk2(oa[ct][0] * inv, oa[ct][1] * inv); o0.y = pk2(oa[ct][2] * inv, oa[ct][3] * inv);
        o1.x = pk2(oa[ct + 1][0] * inv, oa[ct + 1][1] * inv); o1.y = pk2(oa[ct + 1][2] * inv, oa[ct + 1][3] * inv);
        res.o[ct >> 1] = widen_pair(o0, o1); }
    res.lp = lse + orow * 6 + d.h; res.lv = mx + __logf(l);
}
__device__ __forceinline__ void attn_phase(LAS unsigned char* lds, const bf16* __restrict__ z, bf16* __restrict__ og, float* __restrict__ lse, int vc, int G, int tid, int w, int lane) {
    const int nrounds = (256 - vc + G - 1) / G;
    const int nit = nrounds * 18;
    AttnRegs R; AttnDesc d = attn_decode(0, 6 * vc); bool np = d.nb > 0;
    AttnOut res; res.op = og; res.lp = lse; res.lv = 0.f;
#pragma unroll
    for (int q = 0; q < 4; ++q) res.o[q] = (v4u){0u, 0u, 0u, 0u};
    if (nit > 0) attn_issue<-1>(z, d, np, R, tid, w, lane);
    for (int it = 0; it < nit; ++it) {
        asm volatile("" : "+s"(w), "+v"(tid));
        lane = tid & 63;
        attn_stage(lds, R, d.nb, np, tid);
        if (it > 0) attn_store(res, lane);
        bf16x8 qf[4];
#pragma unroll
        for (int ks = 0; ks < 4; ++ks) qf[ks] = __builtin_bit_cast(bf16x8, R.q[ks]);
        const AttnDesc dc = d;
        __syncthreads();
        const bool has_next = it + 1 < nit;
        if (has_next) { const int n = it + 1, j = n % 6, gi = (n / 6) % 3, seg = vc + (n / 18) * G;
            d = attn_decode(gi, 6 * seg + j); np = (j == 0) && d.nb > 0; }
        attn_compute(lds, dc, qf, og, lse, w, lane, z, d, np, has_next, R, tid, res);
        __syncthreads();
    }
    if (nit > 0) attn_store(res, lane);
}

__device__ __forceinline__ int t64_f(int row) { return ((row >> 1) & 1) | (((row >> 3) & 1) << 1); }
__device__ __forceinline__ int t64_off(int row, int ch) { return 128 * row + 32 * ((ch >> 1) ^ t64_f(row)) + 16 * (ch & 1); }
__device__ __forceinline__ float log_sigmoid_f(float x) { return fminf(x, 0.f) - __logf(1.0f + __expf(-fabsf(x))); }

__device__ __forceinline__ void gla_r_wave(LAS float* rtab, const bf16* __restrict__ h, const bf16* __restrict__ wrt, const unsigned long long* __restrict__ ss, int slab, int w, int lane, LAS unsigned char* wl) {
    const int c16 = lane & 15, g4 = lane >> 4;
    const bf16* hp = h + ((size_t)slab * 128 + 16 * w + c16) * DM + 8 * g4; const bf16* wp = wrt + (size_t)c16 * DM + 8 * g4;
    {
        v4u bw[8];
#pragma unroll
        for (int i = 0; i < 8; ++i) bw[i] = *(const v4u*)(wp + 32 * (8 * w + i));
#pragma unroll
        for (int i = 0; i < 8; ++i) *(LAS v4u*)(wl + ((8 * w + i) * 64 + lane) * 16) = bw[i];
    }
    v4u a[8];
#pragma unroll
    for (int i = 0; i < 8; ++i) a[i] = *(const v4u*)(hp + 32 * i);
    __syncthreads();
    f32x4 acc = (f32x4){0.f, 0.f, 0.f, 0.f};
#pragma unroll
    for (int ks0 = 0; ks0 < 64; ks0 += 8) {
        v4u an[8];
        if (ks0 + 8 < 64) {
#pragma unroll
            for (int i = 0; i < 8; ++i) an[i] = *(const v4u*)(hp + 32 * (ks0 + 8 + i));
        }
#pragma unroll
        for (int i = 0; i < 8; ++i) { const v4u b = *(const LAS v4u*)(wl + ((ks0 + i) * 64 + lane) * 16);
            acc = MFMA16(__builtin_bit_cast(bf16x8, b), __builtin_bit_cast(bf16x8, a[i]), acc); }
        if (ks0 + 8 < 64) {
#pragma unroll
            for (int i = 0; i < 8; ++i) a[i] = an[i];
        }
    }
    acc *= __builtin_amdgcn_rsqf((float)ss[slab * 128 + 16 * w + c16] * SS_INV * (1.f / DM) + EPS);
    *(LAS f32x4*)(rtab + (16 * w + c16) * 16 + 4 * g4) = acc;
}
__device__ __forceinline__ void gla_g1_wave(LAS unsigned char* wl, const bf16* __restrict__ z, const LAS float* rch, const float* __restrict__ wg, const float* __restrict__ bg,
                                            float* __restrict__ UT, float* __restrict__ dec, bf16* __restrict__ QD, bf16* __restrict__ KD, int chunk, int h, int lane) {
    const size_t R0 = (size_t)chunk * 64;
    const int c16 = lane & 15, g4 = lane >> 4, q4 = c16 >> 2, p4 = lane & 3;
    const bf16* zk = z + R0 * ZLD + ZC_CK + 64 * h + lane; const bf16* zq = z + R0 * ZLD + ZC_CQ + 64 * h + lane;
    bf16 kr[16], qr[16];
#pragma unroll
    for (int i = 0; i < 16; ++i) { kr[i] = zk[(size_t)i * ZLD]; qr[i] = zq[(size_t)i * ZLD]; }
    const bf16* zv = z + (R0 + (lane >> 3)) * ZLD + ZC_CV + 128 * h + 8 * (lane & 7);
    v4u vr[8];
#pragma unroll
    for (int it = 0; it < 8; ++it) vr[it] = *(const v4u*)(zv + (size_t)(8 * it) * ZLD);
    float bl[64]; float blast;
    {
        float wcol[16], rr[16];
#pragma unroll
        for (int i = 0; i < 16; ++i) { wcol[i] = wg[i * 384 + 64 * h + lane]; rr[i] = rch[64 * i + lane]; }
        const float bias = bg[64 * h + lane];
        float run = 0.f;
#pragma unroll
        for (int j = 0; j < 64; ++j) {
            float x = bias;
#pragma unroll
            for (int i = 0; i < 16; ++i) x += __int_as_float(__builtin_amdgcn_readlane(__float_as_int(rr[j >> 2]), (j & 3) * 16 + i)) * wcol[i];
            run += log_sigmoid_f(x) * (1.f / 16.f); bl[j] = run;
        }
        blast = run;
    }
    const float elast = __expf(blast);
    dec[((size_t)chunk * 6 + h) * 64 + lane] = elast;
    LAS unsigned char* KT = wl; LAS unsigned char* VH = wl + 8192;
    bf16* qdp = QD + R0 * 384 + 64 * h + lane; bf16* kdp = KD + R0 * 384 + 64 * h + lane;
#pragma unroll
    for (int bt = 0; bt < 4; ++bt) {
        bf16 kn[16], qn[16];
        if (bt < 3) {
#pragma unroll
            for (int i = 0; i < 16; ++i) { kn[i] = zk[(size_t)(16 * (bt + 1) + i) * ZLD]; qn[i] = zq[(size_t)(16 * (bt + 1) + i) * ZLD]; }
        }
#pragma unroll
        for (int i = 0; i < 16; ++i) { const int j = 16 * bt + i;
            const float e = __expf(bl[j]), ei = __expf(-bl[j]);
            const float kv = bf1(kr[i]), qv = bf1(qr[i]);
            const float kd = kv * ei;
            qdp[(size_t)j * 384] = f2bf(qv * 0.125f * e);
            kdp[(size_t)j * 384] = f2bf(kd);
            *(LAS bf16*)(KT + 128 * j + 32 * ((lane >> 4) ^ t64_f(j)) + 2 * (lane & 15)) = f2bf(kd * elast);
        }
        if (bt < 3) {
#pragma unroll
            for (int i = 0; i < 16; ++i) { kr[i] = kn[i]; qr[i] = qn[i]; }
        }
    }
    float* up = UT + ((size_t)chunk * 6 + h) * 8192 + (size_t)c16 * 64 + 4 * g4;
#pragma unroll
    for (int vh = 0; vh < 2; ++vh) {
#pragma unroll
        for (int it = 0; it < 8; ++it) { const int row = (lane >> 3) + 8 * it; *(LAS v4u*)(VH + t64_off(row, lane & 7)) = vr[it]; }
        if (vh == 0) {
#pragma unroll
            for (int it = 0; it < 8; ++it) vr[it] = *(const v4u*)(zv + (size_t)(8 * it) * ZLD + 64);
        }
        asm volatile("s_waitcnt lgkmcnt(0)" ::: "memory");
        f32x4 acc[4][4];
#pragma unroll
        for (int vt = 0; vt < 4; ++vt)
#pragma unroll
            for (int kt = 0; kt < 4; ++kt) acc[vt][kt] = (f32x4){0.f, 0.f, 0.f, 0.f};
#pragma unroll
        for (int ks = 0; ks < 2; ++ks) {
            const int row = 32 * ks + 8 * g4 + q4; const int fr = t64_f(row);
            bf16x8 af[4], bfr[4];
#pragma unroll
            for (int t = 0; t < 4; ++t) {
                const int o = 128 * row + 32 * (t ^ fr) + 8 * p4;
                af[t] = cat8(lds_tr4(VH + o), lds_tr4(VH + o + 512));
                bfr[t] = cat8(lds_tr4(KT + o), lds_tr4(KT + o + 512));
            }
#pragma unroll
            for (int vt = 0; vt < 4; ++vt)
#pragma unroll
                for (int kt = 0; kt < 4; ++kt) acc[vt][kt] = MFMA16(bfr[kt], af[vt], acc[vt][kt]);
        }
#pragma unroll
        for (int vt = 0; vt < 4; ++vt)
#pragma unroll
            for (int kt = 0; kt < 4; ++kt) *(f32x4*)(up + (size_t)(64 * vh + 16 * vt) * 64 + 16 * kt) = acc[vt][kt];
        asm volatile("s_waitcnt lgkmcnt(0)" ::: "memory");
    }
}
__device__ __forceinline__ void gla_scan(const float* __restrict__ UT, const float* __restrict__ dec, bf16* __restrict__ SB, int gtid, int ngt) {
    for (int e = gtid; e < BATCH * 6 * 8192; e += ngt) {
        const int kk = e & 63, hv = e >> 6; const int b = hv / (6 * 128), hvr = hv - b * (6 * 128); const int h = hvr >> 7;
        const size_t o0 = (size_t)b * 128 * 6 * 8192 + (size_t)hvr * 64 + kk;
        const float* up = UT + o0; bf16* sp = SB + o0;
        const float* dp = dec + (size_t)b * 128 * 384 + h * 64 + kk;
        float st = 0.f;
        for (int n0 = 0; n0 < 128; n0 += 16) {
            float uv[16], dv[16];
#pragma unroll
            for (int i = 0; i < 16; ++i) { uv[i] = up[(size_t)(n0 + i) * 6 * 8192]; dv[i] = dp[(size_t)(n0 + i) * 384]; }
#pragma unroll
            for (int i = 0; i < 16; ++i) { sp[(size_t)(n0 + i) * 6 * 8192] = f2bf(st); st = dv[i] * st + uv[i]; }
        }
    }
}
__device__ __forceinline__ void gla_g3_wave(LAS unsigned char* wl, const bf16* __restrict__ z, const bf16* __restrict__ QD, const bf16* __restrict__ KD, const bf16* __restrict__ SB,
                                            const float* __restrict__ outg, bf16* __restrict__ y, int chunk, int h, int lane) {
    const size_t R0 = (size_t)chunk * 64;
    const int c16 = lane & 15, g4 = lane >> 4, q4 = c16 >> 2, p4 = lane & 3;
    {
        const bf16* zv = z + (R0 + (lane >> 4)) * ZLD + ZC_CV + 128 * h + 8 * (lane & 15);
        const int ch = lane & 15;
#pragma unroll
        for (int half = 0; half < 2; ++half) {
            v4u vr[8];
#pragma unroll
            for (int it = 0; it < 8; ++it) vr[it] = *(const v4u*)(zv + (size_t)(4 * (8 * half + it)) * ZLD);
#pragma unroll
            for (int it = 0; it < 8; ++it) { const int row = (lane >> 4) + 4 * (8 * half + it);
                *(LAS v4u*)(wl + 256 * row + 32 * ((ch >> 1) ^ (row & 7)) + 16 * (ch & 1)) = vr[it]; }
        }
    }
    bf16x8 qf[4][2], kf[4][2];
    {
        const bf16* qp = QD + (R0 + c16) * 384 + 64 * h + 8 * g4; const bf16* kp = KD + (R0 + c16) * 384 + 64 * h + 8 * g4;
#pragma unroll
        for (int t = 0; t < 4; ++t)
#pragma unroll
            for (int ks = 0; ks < 2; ++ks) { qf[t][ks] = __builtin_bit_cast(bf16x8, *(const v4u*)(qp + (size_t)(16 * t) * 384 + 32 * ks));
                                             kf[t][ks] = __builtin_bit_cast(bf16x8, *(const v4u*)(kp + (size_t)(16 * t) * 384 + 32 * ks)); }
    }
    bf16x8 pf[4][2];
#pragma unroll
    for (int it = 0; it < 4; ++it) {
        unsigned pw[4][2];
#pragma unroll
        for (int jt = 0; jt < 4; ++jt) {
            if (jt <= it) {
                f32x4 a = (f32x4){0.f, 0.f, 0.f, 0.f};
#pragma unroll
                for (int ks = 0; ks < 2; ++ks) a = MFMA16(kf[jt][ks], qf[it][ks], a);
                if (jt == it) { const int d0 = c16 - 4 * g4;
                    a[0] = (0 <= d0) ? a[0] : 0.f; a[1] = (1 <= d0) ? a[1] : 0.f; a[2] = (2 <= d0) ? a[2] : 0.f; a[3] = (3 <= d0) ? a[3] : 0.f; }
                pw[jt][0] = pk2(a[0], a[1]); pw[jt][1] = pk2(a[2], a[3]);
            } else { pw[jt][0] = 0u; pw[jt][1] = 0u; }
        }
#pragma unroll
        for (int s = 0; s < 2; ++s) { v4u w4; w4.x = pw[2 * s][0]; w4.y = pw[2 * s][1]; w4.z = pw[2 * s + 1][0]; w4.w = pw[2 * s + 1][1]; pf[it][s] = __builtin_bit_cast(bf16x8, w4); }
    }
    asm volatile("s_waitcnt lgkmcnt(0)" ::: "memory");
    f32x4 acc[4][8];
#pragma unroll
    for (int it = 0; it < 4; ++it)
#pragma unroll
        for (int ct = 0; ct < 8; ++ct) acc[it][ct] = (f32x4){0.f, 0.f, 0.f, 0.f};
    const int xr = 4 * (g4 & 1) + q4;
    const LAS unsigned char* vb = wl + 256 * (4 * g4 + q4) + 8 * p4;
#pragma unroll
    for (int ct = 0; ct < 8; ++ct) {
        const int co = 32 * (ct ^ xr);
#pragma unroll
        for (int s = 0; s < 2; ++s) {
            const bf16x8 vf = cat8(lds_tr4(vb + 256 * (32 * s) + co), lds_tr4(vb + 256 * (32 * s + 16) + co));
#pragma unroll
            for (int it = 0; it < 4; ++it) if (2 * s <= it) acc[it][ct] = MFMA16(vf, pf[it][s], acc[it][ct]);
        }
        const bf16* sp = SB + ((size_t)chunk * 6 + h) * 8192 + (size_t)(16 * ct + c16) * 64 + 8 * g4;
#pragma unroll
        for (int ks = 0; ks < 2; ++ks) {
            const bf16x8 sf = __builtin_bit_cast(bf16x8, *(const v4u*)(sp + 32 * ks));
#pragma unroll
            for (int it = 0; it < 4; ++it) acc[it][ct] = MFMA16(sf, qf[it][ks], acc[it][ct]);
        }
    }
#pragma unroll
    for (int it = 0; it < 4; ++it) {
        float ss = 0.f;
#pragma unroll
        for (int ct = 0; ct < 8; ++ct) ss += (acc[it][ct][0] * acc[it][ct][0] + acc[it][ct][1] * acc[it][ct][1]) + (acc[it][ct][2] * acc[it][ct][2] + acc[it][ct][3] * acc[it][ct][3]);
        ss += __shfl_xor(ss, 16); ss += __shfl_xor(ss, 32);
        const float rstd = rsqrtf(ss * (1.f / 128.f) + EPS);
        const size_t row = R0 + 16 * it + c16;
        const bf16* gp = z + row * ZLD + ZC_CG + 128 * h + wide_col(g4);
        bf16* yp = y + row * DM + YC_C + 128 * h + wide_col(g4);
#pragma unroll
        for (int ct = 0; ct < 8; ct += 2) {
            v2u o[2], gg[2]; unwiden_pair(*(const v4u*)(gp + 16 * ct), gg[0], gg[1]);
#pragma unroll
            for (int q = 0; q < 2; ++q) { const int c = ct + q;
                const v2u gw = gg[q]; const f32x4 og4 = *(const f32x4*)(outg + 16 * c + 4 * g4);
                o[q].x = pk2(acc[it][c][0] * rstd * og4.x * silu_f(bflo(gw.x)), acc[it][c][1] * rstd * og4.y * silu_f(bfhi(gw.x)));
                o[q].y = pk2(acc[it][c][2] * rstd * og4.z * silu_f(bflo(gw.y)), acc[it][c][3] * rstd * og4.w * silu_f(bfhi(gw.y))); }
            *(v4u*)(yp + 16 * ct) = widen_pair(o[0], o[1]);
        }
    }
    asm volatile("s_waitcnt lgkmcnt(0)" ::: "memory");
}
__device__ __forceinline__ void attn_merge(const bf16* __restrict__ og, const float* __restrict__ lse, bf16* __restrict__ y, int gtid, int ngt) {
    for (int idx = gtid; idx < M * 96; idx += ngt) {
        const int row = idx / 96, cc = idx - row * 96, h = cc >> 4;
        const float l0 = lse[(size_t)row * 6 + h], l1 = lse[((size_t)M + row) * 6 + h], l2 = lse[((size_t)2 * M + row) * 6 + h];
        const float mx = fmaxf(l0, fmaxf(l1, l2));
        float w0 = __expf(l0 - mx), w1 = __expf(l1 - mx), w2 = __expf(l2 - mx);
        const float inv = 1.0f / (w0 + w1 + w2); w0 *= inv; w1 *= inv; w2 *= inv;
        float a[8], b[8], c[8];
        unpack8(*(const v4u*)(og + (size_t)row * 768 + 8 * cc), a);
        unpack8(*(const v4u*)(og + ((size_t)M + row) * 768 + 8 * cc), b);
        unpack8(*(const v4u*)(og + ((size_t)2 * M + row) * 768 + 8 * cc), c);
#pragma unroll
        for (int e = 0; e < 8; ++e) a[e] = w0 * a[e] + w1 * b[e] + w2 * c[e];
        *(v4u*)(y + (size_t)row * DM + YC_B + 8 * cc) = pack8(a);
    }
}

#ifndef DBG_MASK
#define DBG_MASK 0xFFFF
#endif
#define PH(b) if constexpr ((DBG_MASK >> (b)) & 1)
#ifndef PROBE_MASK
#define PROBE_MASK 0
#endif
#if PROBE_MASK
#define REP(b) int nrep_##b = 1 + ((PROBE_MASK >> (b)) & 1); asm volatile("" : "+s"(nrep_##b)); _Pragma("unroll 1") for (int rep_ = 0; rep_ < nrep_##b; ++rep_)
#else
#define REP(b) for (int rep_ = 0; rep_ < 1; ++rep_)
#endif
typedef const __attribute__((address_space(4))) Args* ArgP;
#define PHASE_BEGIN() ArgP ap = (ArgP)__builtin_amdgcn_kernarg_segment_ptr(); asm volatile("" : "+s"(ap)); \
    unsigned char* const ws = ap->ws; int tid = threadIdx.x; asm volatile("" : "+v"(tid)); \
    int lane = tid & 63; const int wave = __builtin_amdgcn_readfirstlane(tid >> 6), G = gridDim.x, bx = blockIdx.x; \
    const int gw = bx * NWAVES + wave, ngw = G * NWAVES, gtid = bx * (NWAVES * 64) + tid, ngt = G * NWAVES * 64; \
    (void)ws; (void)lane; (void)wave; (void)gw; (void)ngw; (void)gtid; (void)ngt; \
    LAS unsigned char* lds = (LAS unsigned char*)lds_raw

#ifdef PROF_SEL
#ifndef PROF_AMP
#define PROF_AMP 4
#endif
#define TS_BEGIN(id) do { if ((id) == PROF_SEL) prof_t0 = __builtin_amdgcn_s_memrealtime(); } while (0)
#define TS_END(id) do { if ((id) == PROF_SEL) { const unsigned long long now_ = __builtin_amdgcn_s_memrealtime(); const unsigned long long dt_ = (now_ - prof_t0) * PROF_AMP; \
    if (dt_ < 100000000ull) while (__builtin_amdgcn_s_memrealtime() - now_ < dt_) __builtin_amdgcn_s_sleep(8); __syncthreads(); } } while (0)
#else
#define TS_BEGIN(id) do { } while (0)
#define TS_END(id) do { } while (0)
#endif
__global__ void __launch_bounds__(NWAVES * 64, 2) hymba_fwd(Args args) {
    extern __shared__ __attribute__((aligned(16))) unsigned char lds_raw[];
    {
        LAS unsigned char* lds0 = (LAS unsigned char*)lds_raw;
        for (int u = threadIdx.x; u < (LDSX_OFF - LDSCTL_OFF) / 4; u += NWAVES * 64) ((LAS unsigned*)(lds0 + LDSCTL_OFF))[u] = 0u;
    }
    __syncthreads();
    XcdBarrier bar = xcd_barrier_post((unsigned*)(args.ws + WS_CTL) + CW_BAR, (volatile LAS unsigned*)((LAS unsigned char*)lds_raw + LDSCTL_OFF) + 8);
#define GRID_BAR() do { XcdBarrier b_ = bar; asm volatile("" : "+s"(b_.bar), "+s"(b_.x)); xcd_barrier(b_); } while (0)
#ifdef PROF_SEL
    unsigned long long prof_t0 = 0ull;
#endif

    TS_BEGIN(0);
    REP(0) PH(0) { PHASE_BEGIN(); prologue(ap, ws, lds, gw, ngw, wave, lane, gtid, ngt); }
    GRID_BAR();
    TS_END(0);

    for (int s = 0; s < 3 * DEPTH; ++s) {
        const int l = s / 3, k = s - 3 * l, f = k >> 1;
        if (s == 0) {
            TS_BEGIN(1);
            PH(1) { PHASE_BEGIN(); conv_phase(ap->in[0], (bf16*)(ws + WS_H), (unsigned long long*)(ws + WS_SS), gw, ngw, lane); }
            GRID_BAR();
            TS_END(1);
        }
        if (k != 1) {
            TS_BEGIN(2);
            REP(2) PH(2) { PHASE_BEGIN();
                const bf16* Bt = (const bf16*)(ws + WS_W + (size_t)l * W_LAYER + (f ? WL_GU1 : WL_GU0));
                const bf16* xa = (s == 0) ? (const bf16*)(ws + WS_H) : (s == 3 * DEPTH - 1) ? (const bf16*)(ws + WS_OG) : (const bf16*)ap->out;
                pg8::Gemm g{xa, Bt, M, 2 * DFF, DM}; pg8::StaticOrder S; S.init(M, 2 * DFF, G, bx);
                pg8::EpiSwiGLU E{(bf16*)(ws + WS_HZ), DFF, (const unsigned long long*)(ws + WS_SS) + (size_t)s * M};
                pg8::gemm_phase<pg8::EpiSwiGLU, pg8::StaticOrder, true, true>(lds, g, S, E); }
        } else {
            TS_BEGIN(4);
            REP(4) PH(4) { PHASE_BEGIN();
                const bf16* Bt = (const bf16*)(ws + WS_W + (size_t)l * W_LAYER + WL_IN);
                pg8::Gemm g{(const bf16*)ap->out, Bt, M, NZ, DM}; pg8::StaticOrder S; S.init(M, NZ, G, bx);
                pg8::EpiZ E{(bf16*)(ws + WS_HZ), (const unsigned long long*)(ws + WS_SS) + (size_t)s * M, ap->in[10] + (size_t)l * 128, ap->in[11] + (size_t)l * 128, ZLD};
                pg8::gemm_phase<pg8::EpiZ, pg8::StaticOrder, true, true>(lds, g, S, E); }
            GRID_BAR();
            TS_END(4);
            TS_BEGIN(5);
            PH(5) { PHASE_BEGIN(); const float* ropec = (const float*)(ws + WS_ROPE); rope_prepass((bf16*)(ws + WS_HZ), ropec, ropec + SEQ * 16, gw, ngw, lane); }
            PH(6) { for (int slab = blockIdx.x; slab < M / 128; slab += gridDim.x) { PHASE_BEGIN();
                LAS float* rtab = (LAS float*)(lds + 131072);
                gla_r_wave(rtab, (const bf16*)ap->out, (const bf16*)(ws + WS_W + (size_t)l * W_LAYER + WL_IN) + (size_t)NZ * DM, (const unsigned long long*)(ws + WS_SS) + (size_t)s * M, slab, wave, lane, lds);
                __syncthreads();
                for (int u = wave; u < 12; u += NWAVES) {
                    asm volatile("" : "+v"(tid)); lane = tid & 63;
                    gla_g1_wave(lds + wave * 16384, (const bf16*)(ws + WS_HZ), rtab + (u / 6) * 1024, ap->in[12] + (size_t)l * 16 * 384, ap->in[13] + (size_t)l * 384,
                                (float*)((char*)ap->out + (size_t)M * DM * 2), (float*)(ws + WS_DEC), (bf16*)(ws + WS_QD), (bf16*)(ws + WS_KD), 2 * slab + u / 6, u % 6, lane); }
                __syncthreads(); } }
            __syncthreads();
            PH(7) { for (int slab = blockIdx.x; slab < M / 128; slab += gridDim.x) { PHASE_BEGIN();
                const bf16* zz = (const bf16*)(ws + WS_HZ); const float* sgw = ap->in[8] + (size_t)l * 4 * 128 * 128; const float* sgb = ap->in[9] + (size_t)l * 512; const float* sgn = ap->in[7] + (size_t)l * 512;
                GmlpIn I; gmlp_load(zz, sgw, sgb, sgn, 4 * slab, tid, wave, lane, I);
#pragma unroll 1
                for (int g = 0; g < 4; ++g) gmlp_unit(lds, zz, sgw, sgb, sgn, (bf16*)(ws + WS_Y), 4 * slab + g, tid, wave, lane, I, g < 3); } }
            GRID_BAR();
            TS_END(5);
            TS_BEGIN(6);
            PH(8) { PHASE_BEGIN(); gla_scan((const float*)((const char*)ap->out + (size_t)M * DM * 2), (const float*)(ws + WS_DEC), (bf16*)(ws + WS_SB), gtid, ngt); }
            REP(12) { PH(12) { PHASE_BEGIN();
                const int vc = (G % 8 == 0) ? (bx % 8) * (G / 8) + bx / 8 : bx;
                attn_phase(lds, (const bf16*)(ws + WS_HZ), (bf16*)(ws + WS_OG), (float*)(ws + WS_LSE), vc, G, tid, wave, lane); } }
            GRID_BAR();
            TS_END(6);
            TS_BEGIN(7);
            REP(9) { PH(9) { for (int slab = blockIdx.x; slab < M / 128; slab += gridDim.x) { PHASE_BEGIN();
                for (int u = wave; u < 12; u += NWAVES) {
                    asm volatile("" : "+v"(tid)); lane = tid & 63;
                    gla_g3_wave(lds + wave * 16384, (const bf16*)(ws + WS_HZ), (const bf16*)(ws + WS_QD), (const bf16*)(ws + WS_KD), (const bf16*)(ws + WS_SB), ap->in[14] + (size_t)l * 128,
                                (bf16*)(ws + WS_Y), 2 * slab + u / 6, u % 6, lane); } } } }
            __syncthreads();
            REP(10) PH(10) { PHASE_BEGIN(); attn_merge((const bf16*)(ws + WS_OG), (const float*)(ws + WS_LSE), (bf16*)(ws + WS_Y), gtid, ngt); }
        }
        GRID_BAR();
        if (k != 1) TS_END(2); else TS_END(7);
        if (k != 1) TS_BEGIN(3); else TS_BEGIN(8);
        PH(3) { PHASE_BEGIN();
            const bool last = (s == 3 * DEPTH - 1), first = (s == 0);
            const void* xin = first ? (const void*)ap->in[0] : last ? (const void*)(ws + WS_OG) : (const void*)ap->out;
            void* xout = (s == 3 * DEPTH - 2) ? (void*)(ws + WS_OG) : (void*)ap->out;
            const unsigned char* wl = ws + WS_W + (size_t)l * W_LAYER;
            const bf16* A = (k == 1) ? (const bf16*)(ws + WS_Y) : (const bf16*)(ws + WS_HZ);
            const bf16* Bt = (const bf16*)(wl + ((k == 1) ? WL_OUT : (f ? WL_D1 : WL_D0)));
            pg8::Gemm g{A, Bt, M, DM, (k == 1) ? DM : DFF}; pg8::StaticOrder S; S.init(M, DM, G, bx, 4);
            pg8::EpiResid E{xin, xout, (unsigned long long*)(ws + WS_SS) + (size_t)(s + 1) * M, first ? 1 : 0, last ? 1 : 0, (k == 1) ? 1.0f : 0.5f};
            pg8::gemm_phase<pg8::EpiResid, pg8::StaticOrder, true, true>(lds, g, S, E); }
        GRID_BAR();
        if (k != 1) TS_END(3); else TS_END(8);
#if defined(PROF_SEL) && PROF_SEL == 99
        if (s == PROF_IDLE_AT) { const unsigned long long now_ = __builtin_amdgcn_s_memrealtime(); while (__builtin_amdgcn_s_memrealtime() - now_ < (unsigned long long)PROF_IDLE_US * 100ull) __builtin_amdgcn_s_sleep(8); __syncthreads(); }
#endif
    }
}

extern "C" void kernel_launch(void* const* d_in, const int* in_sizes, int n_in, void* d_out, int out_size, void* d_ws, size_t ws_size, hipStream_t stream) {
    static int grid = 0;
    if (grid == 0) {
        if (n_in != 16 || in_sizes[0] != M * DM || out_size != M * DM || ws_size < WS_END) { fprintf(stderr, "kernel_launch: shape/workspace mismatch (n_in %d, ws %zu, need %zu)\n", n_in, ws_size, (size_t)WS_END); grid = -1; return; }
        int dev = 0, cus = 0, per_cu = 0;
        if (hipGetDevice(&dev) != hipSuccess || hipDeviceGetAttribute(&cus, hipDeviceAttributeMultiprocessorCount, dev) != hipSuccess) { grid = -1; return; }
        if (hipFuncSetAttribute((const void*)hymba_fwd, hipFuncAttributeMaxDynamicSharedMemorySize, LDS_BYTES) != hipSuccess) { fprintf(stderr, "kernel_launch: hipFuncSetAttribute failed\n"); grid = -1; return; }
        if (hipOccupancyMaxActiveBlocksPerMultiprocessor(&per_cu, (const void*)hymba_fwd, NWAVES * 64, LDS_BYTES) != hipSuccess || per_cu < 1) fprintf(stderr, "kernel_launch: occupancy query says %d\n", per_cu);
        (void)hipGetLastError();
        grid = cus;
    }
    if (grid < 0) return;
    if (hipMemsetAsync((char*)d_ws + WS_CTL, 0, CTL_ZERO_BYTES, stream) != hipSuccess) return;
    Args a{};
    for (int i = 0; i < 16; ++i) a.in[i] = (const float*)d_in[i];
    a.out = (float*)d_out; a.ws = (unsigned char*)d_ws;
    for (int i = 0; i < 16; ++i) a.inv_freq[i] = (float)std::pow(500000.0, -(double)i / 16.0);
    hipLaunchKernelGGL(hymba_fwd, dim3(grid), dim3(NWAVES * 64), LDS_BYTES, stream, a);
}
```
